# Optimizing an MI355X kernel written in HIP

```python
import math
import jax, jax.numpy as jnp
from jax import lax
import numpy as np

D_MODEL = 2048
BATCH = 4
SEQ = 4096
DEPTH = 4
DEC_BATCH = 16
DEC_SEQ = 16
PAST_LEN = 1024

CHUNK = 64
QBLOCK = 128
CONV_W = 3
ROPE_THETA = 10000.0
MIX_WIDTH = D_MODEL
A_WIDTH = D_MODEL // 4
A_HEAD_DIM = 64
A_HEADS = A_WIDTH // A_HEAD_DIM
IDX_HEADS = 16
IDX_DIM = 64
TOPK_MAX = 256
B_WIDTH = D_MODEL // 4
C_WIDTH = D_MODEL // 2
C_V_DIM = 128
C_HEADS = C_WIDTH // C_V_DIM
C_NOPE_DIM = 128
C_ROPE_DIM = 64
C_QK_DIM = C_NOPE_DIM + C_ROPE_DIM
KV_LORA = D_MODEL // 4
D_FF = ((8 * D_MODEL // 3 + 255) // 256) * 256
N_MOD = 6
ALPHA = (2 * DEPTH) ** 0.25
BETA = (8 * DEPTH) ** -0.25
LN_EPS = 1e-5
RMS_EPS = 1e-6
IN_WIDTHS = (A_WIDTH, A_WIDTH, A_WIDTH, IDX_HEADS * IDX_DIM, IDX_DIM, IDX_HEADS,
             B_WIDTH, B_WIDTH, B_WIDTH,
             C_HEADS * C_QK_DIM, KV_LORA, C_ROPE_DIM)
IN_TOTAL = sum(IN_WIDTHS)

kernel_name = 'hybrid_stream_dsa_conv_mla_step'


def layer_norm(z, g, b):
    zf = z.astype(jnp.float32)
    mu = zf.mean(-1, keepdims=True)
    var = jnp.square(zf - mu).mean(-1, keepdims=True)
    return ((zf - mu) * lax.rsqrt(var + LN_EPS) * g.astype(jnp.float32) + b.astype(jnp.float32)).astype(z.dtype)


def rms_norm(z, g):
    zf = z.astype(jnp.float32)
    return (zf * lax.rsqrt(jnp.mean(zf * zf, -1, keepdims=True) + RMS_EPS) * g.astype(jnp.float32)).astype(z.dtype)


def rope(x, pos):
    half = x.shape[-1] // 2
    inv = jnp.power(jnp.float32(ROPE_THETA), -jnp.arange(half, dtype=jnp.float32) / half)
    ang = pos.astype(jnp.float32)[:, None] * inv[None, :]
    cos = jnp.cos(ang)[None, :, None, :]
    sin = jnp.sin(ang)[None, :, None, :]
    x1 = x[..., :half].astype(jnp.float32)
    x2 = x[..., half:].astype(jnp.float32)
    return jnp.concatenate([x1 * cos - x2 * sin, x1 * sin + x2 * cos], axis=-1).astype(x.dtype)


def chunk_visible(q_pos, k_pos):
    return (k_pos[None, :] // CHUNK) <= (q_pos[:, None] // CHUNK)


def causal_dwconv(u, prev, w):
    t = u.shape[1]
    up = jnp.concatenate([prev.astype(u.dtype), u], axis=1)
    y = up[:, 0:t] * w[0]
    for i in range(1, CONV_W):
        y = y + up[:, i:i + t] * w[i]
    return y, up[:, t:]


def extend(past, new):
    return new if past is None else jnp.concatenate([past.astype(new.dtype), new], axis=1)


def sweep_query_blocks(fn, q_arrays, q_pos):
    t = q_pos.shape[0]
    if t <= QBLOCK:
        return fn(*q_arrays, q_pos)
    nb = t // QBLOCK
    blocks = tuple(a.reshape((a.shape[0], nb, QBLOCK) + a.shape[2:]).swapaxes(0, 1) for a in q_arrays)
    out = lax.map(lambda args: fn(*args[0], args[1]), (blocks, q_pos.reshape(nb, QBLOCK)))
    return out.swapaxes(0, 1).reshape((out.shape[1], t) + out.shape[3:])


def dsa_block(q, qi, wi, q_pos, k, v, ki, k_pos, topk):
    vis = chunk_visible(q_pos, k_pos)
    rel = jax.nn.relu(jnp.einsum('bthd,bsd->bths', qi, ki).astype(jnp.float32) * IDX_DIM ** -0.5)
    score = jnp.einsum('bths,bth->bts', rel, wi.astype(jnp.float32))
    score = jnp.where(vis[None], score, -jnp.inf)
    _, idx = lax.top_k(score, topk)
    valid = (k_pos[idx] // CHUNK) <= (q_pos[None, :, None] // CHUNK)
    gather = jax.vmap(lambda rows, ids: rows[ids])
    kg = gather(k, idx)
    vg = gather(v, idx)
    s = jnp.einsum('bthd,btkhd->bthk', q, kg).astype(jnp.float32) * A_HEAD_DIM ** -0.5
    s = jnp.where(valid[:, :, None, :], s, -jnp.inf)
    p = jax.nn.softmax(s, axis=-1).astype(v.dtype)
    return jnp.einsum('bthk,btkhd->bthd', p, vg)


def mla_block(q, q_pos, k, v, k_pos):
    vis = chunk_visible(q_pos, k_pos)
    s = jnp.einsum('bqhd,bkhd->bhqk', q, k).astype(jnp.float32) * C_QK_DIM ** -0.5
    s = jnp.where(vis[None, None], s, -jnp.inf)
    p = jax.nn.softmax(s, axis=-1).astype(v.dtype)
    return jnp.einsum('bhqk,bkhd->bqhd', p, v)


def trunk_layer(x, c, q_pos, past, w_in, w_out, conv_b_w, kv_norm, w_uk, w_uv, w_mod, b_mod,
                ln1_g, ln1_b, ln2_g, ln2_b, w_gu, conv_f_w, w_down):
    bsz, t = x.shape[0], x.shape[1]
    if past is None:
        p_ak = p_av = p_ik = p_lat = p_kr = None
        prev_b = jnp.zeros((bsz, CONV_W - 1, B_WIDTH), x.dtype)
        prev_f = jnp.zeros((bsz, CONV_W - 1, D_FF), x.dtype)
    else:
        p_ak, p_av, p_ik, p_lat, p_kr, prev_b, prev_f = past

    mod = jax.nn.silu(c) @ w_mod + b_mod
    sh1, sc1, g1, sh2, sc2, g2 = [m[:, None, :] for m in jnp.split(mod, N_MOD, axis=-1)]
    h = x * (1 + sc1) + sh1

    parts = jnp.split(h @ w_in, np.cumsum(IN_WIDTHS)[:-1].tolist(), axis=-1)
    qa, ka, va, qi, ki, wi, bg, cg, xb, qc, lat, kr = parts

    qa = rope(qa.reshape(bsz, t, A_HEADS, A_HEAD_DIM), q_pos)
    ka = rope(ka.reshape(bsz, t, A_HEADS, A_HEAD_DIM), q_pos)
    va = va.reshape(bsz, t, A_HEADS, A_HEAD_DIM)
    qi = rope(qi.reshape(bsz, t, IDX_HEADS, IDX_DIM), q_pos)
    ki = rope(ki[:, :, None, :], q_pos)[:, :, 0]
    wi = wi * IDX_HEADS ** -0.5
    k_all, v_all, ki_all = extend(p_ak, ka), extend(p_av, va), extend(p_ik, ki)
    n_keys = k_all.shape[1]
    k_pos = jnp.arange(n_keys, dtype=jnp.int32)
    topk = min(TOPK_MAX, n_keys // 4)
    oa = sweep_query_blocks(
        lambda q_, qi_, wi_, qp: dsa_block(q_, qi_, wi_, qp, k_all, v_all, ki_all, k_pos, topk),
        (qa, qi, wi), q_pos)

    conv_u, new_conv_b = causal_dwconv(cg * xb, prev_b, conv_b_w)
    yb = bg * conv_u

    qc = qc.reshape(bsz, t, C_HEADS, C_QK_DIM)
    qc = jnp.concatenate([qc[..., :C_NOPE_DIM], rope(qc[..., C_NOPE_DIM:], q_pos)], axis=-1)
    lat = rms_norm(lat, kv_norm)
    kr = rope(kr[:, :, None, :], q_pos)[:, :, 0]
    lat_all, kr_all = extend(p_lat, lat), extend(p_kr, kr)
    k_nope = jnp.einsum('bsr,rhd->bshd', lat_all, w_uk.reshape(KV_LORA, C_HEADS, C_NOPE_DIM))
    v_c = jnp.einsum('bsr,rhd->bshd', lat_all, w_uv.reshape(KV_LORA, C_HEADS, C_V_DIM))
    k_c = jnp.concatenate(
        [k_nope, jnp.broadcast_to(kr_all[:, :, None, :], k_nope.shape[:3] + (C_ROPE_DIM,))], axis=-1)
    oc = sweep_query_blocks(lambda q_, qp: mla_block(q_, qp, k_c, v_c, k_pos), (qc,), q_pos)

    mix = jnp.concatenate([oa.reshape(bsz, t, A_WIDTH), yb, oc.reshape(bsz, t, C_WIDTH)], axis=-1) @ w_out
    x = layer_norm(ALPHA * x + (1 + g1) * mix, ln1_g, ln1_b)

    h2 = x * (1 + sc2) + sh2
    gate, up = jnp.split(h2 @ w_gu, 2, axis=-1)
    gate, new_conv_f = causal_dwconv(gate, prev_f, conv_f_w)
    f = (jax.nn.silu(gate) * up) @ w_down
    x = layer_norm(ALPHA * x + (1 + g2) * f, ln2_g, ln2_b)
    return x, (ka, va, ki, lat, kr, new_conv_b, new_conv_f)


def setup_inputs(seed: int = 0) -> dict:
    key = jax.random.key(seed)
    ks = jax.random.split(key, 32)

    def nrm(k, shape, scale):
        return jax.random.normal(k, shape, jnp.float32) * scale

    return {
        'x_prompt': nrm(ks[0], (BATCH, SEQ, D_MODEL), 1.0),
        'x_sample': nrm(ks[1], (DEC_BATCH, DEC_SEQ, D_MODEL), 1.0),
        'c_prompt': nrm(ks[2], (BATCH, D_MODEL), 1.0),
        'c_sample': nrm(ks[3], (DEC_BATCH, D_MODEL), 1.0),
        'cache_a_k': nrm(ks[4], (DEPTH, DEC_BATCH, PAST_LEN, A_HEADS, A_HEAD_DIM), 1.0),
        'cache_a_v': nrm(ks[5], (DEPTH, DEC_BATCH, PAST_LEN, A_HEADS, A_HEAD_DIM), 1.0),
        'cache_idx_k': nrm(ks[6], (DEPTH, DEC_BATCH, PAST_LEN, IDX_DIM), 1.0),
        'cache_mla_latent': nrm(ks[7], (DEPTH, DEC_BATCH, PAST_LEN, KV_LORA), 1.0),
        'cache_mla_krope': nrm(ks[8], (DEPTH, DEC_BATCH, PAST_LEN, C_ROPE_DIM), 1.0),
        'state_conv_b': nrm(ks[9], (DEPTH, DEC_BATCH, CONV_W - 1, B_WIDTH), 1.0),
        'state_conv_ffn': nrm(ks[10], (DEPTH, DEC_BATCH, CONV_W - 1, D_FF), 1.0),
        'w_in': nrm(ks[11], (DEPTH, D_MODEL, IN_TOTAL), D_MODEL ** -0.5),
        'w_out': nrm(ks[12], (DEPTH, MIX_WIDTH, D_MODEL), BETA * MIX_WIDTH ** -0.5),
        'conv_b_w': nrm(ks[13], (DEPTH, CONV_W, B_WIDTH), CONV_W ** -0.5),
        'mla_kv_norm': 1.0 + nrm(ks[14], (DEPTH, KV_LORA), 0.02),
        'mla_w_uk': nrm(ks[15], (DEPTH, KV_LORA, C_HEADS * C_NOPE_DIM), KV_LORA ** -0.5),
        'mla_w_uv': nrm(ks[16], (DEPTH, KV_LORA, C_HEADS * C_V_DIM), KV_LORA ** -0.5),
        'w_mod': nrm(ks[17], (DEPTH, D_MODEL, N_MOD * D_MODEL), 0.1 * D_MODEL ** -0.5),
        'b_mod': nrm(ks[18], (DEPTH, N_MOD * D_MODEL), 0.01),
        'ln1_g': 1.0 + nrm(ks[19], (DEPTH, D_MODEL), 0.02),
        'ln1_b': nrm(ks[20], (DEPTH, D_MODEL), 0.02),
        'ln2_g': 1.0 + nrm(ks[21], (DEPTH, D_MODEL), 0.02),
        'ln2_b': nrm(ks[22], (DEPTH, D_MODEL), 0.02),
        'ffn_w_gu': nrm(ks[23], (DEPTH, D_MODEL, 2 * D_FF), D_MODEL ** -0.5),
        'ffn_conv_w': nrm(ks[24], (DEPTH, CONV_W, D_FF), CONV_W ** -0.5),
        'ffn_w_down': nrm(ks[25], (DEPTH, D_FF, D_MODEL), BETA * D_FF ** -0.5),
    }


def reference(x_prompt, x_sample, c_prompt, c_sample, cache_a_k, cache_a_v, cache_idx_k,
              cache_mla_latent, cache_mla_krope, state_conv_b, state_conv_ffn,
              w_in, w_out, conv_b_w, mla_kv_norm, mla_w_uk, mla_w_uv, w_mod, b_mod,
              ln1_g, ln1_b, ln2_g, ln2_b, ffn_w_gu, ffn_conv_w, ffn_w_down):
    pos_p = jnp.arange(x_prompt.shape[1], dtype=jnp.int32)
    pos_s = cache_a_k.shape[2] + jnp.arange(x_sample.shape[1], dtype=jnp.int32)
    xp, xs = x_prompt, x_sample
    rows_p, rows_s = [], []
    for l in range(DEPTH):
        wl = (w_in[l], w_out[l], conv_b_w[l], mla_kv_norm[l], mla_w_uk[l], mla_w_uv[l],
              w_mod[l], b_mod[l], ln1_g[l], ln1_b[l], ln2_g[l], ln2_b[l],
              ffn_w_gu[l], ffn_conv_w[l], ffn_w_down[l])
        xp, rp = trunk_layer(xp, c_prompt, pos_p, None, *wl)
        past_l = (cache_a_k[l], cache_a_v[l], cache_idx_k[l], cache_mla_latent[l],
                  cache_mla_krope[l], state_conv_b[l], state_conv_ffn[l])
        xs, rs = trunk_layer(xs, c_sample, pos_s, past_l, *wl)
        rows_p.append(rp)
        rows_s.append(rs)
    p_a_k, p_a_v, p_idx_k, p_mla_latent, p_mla_krope, p_conv_b, p_conv_ffn = [jnp.stack(r) for r in zip(*rows_p)]
    s_a_k, s_a_v, s_idx_k, s_mla_latent, s_mla_krope, s_conv_b, s_conv_ffn = [jnp.stack(r) for r in zip(*rows_s)]
    return (xp, xs,
            p_a_k, p_a_v, p_idx_k, p_mla_latent, p_mla_krope, p_conv_b, p_conv_ffn,
            s_a_k, s_a_v, s_idx_k, s_mla_latent, s_mla_krope, s_conv_b, s_conv_ffn)
```

```cpp
#include <hip/hip_runtime.h>
#include <cstdio>
#include <cstdint>

#ifndef MK_MULTI
#define MK_MULTI 0
#endif

namespace pg8 {
#define PG8_LAS __attribute__((address_space(3)))
typedef unsigned short bf16_t;
typedef short bf16x8 __attribute__((ext_vector_type(8)));
typedef float f32x4 __attribute__((ext_vector_type(4)));
typedef unsigned u32x4 __attribute__((ext_vector_type(4)));
constexpr int BM = 256, BK = 64, HALF = 128, HTB = HALF * BK * 2  , STAGE_BYTES = 8 * HTB, NXCD = 8, WGM = 8;

__host__ __device__ __forceinline__ int lds_byte(int r, int c) { const int st = (r >> 4) * 2 + (c >> 5), rr = r & 15, cc = c & 31, ob = rr * 64 + cc * 2; return st * 1024 + (ob ^ (((ob >> 9) & 1) << 5)); }
__host__ __device__ __forceinline__ void stage_rc(int b, int& R, int& C) { const int st = b / 1024, sb = b % 1024, swz = sb ^ (((sb >> 9) & 1) << 5); R = (st >> 1) * 16 + swz / 64; C = (st & 1) * 32 + (swz % 64) / 2; }
__host__ __device__ __forceinline__ int perm32(int rho) { const int n = rho >> 4, i = rho & 15; return 8 * (i >> 2) + 4 * n + (i & 3); }

struct Unit { int pm, pn; };
struct Gemm { const bf16_t* A; const bf16_t* Bt; int M, N, K; };

struct StaticOrder {
    int nM, nN, nwg, G, c;
    __host__ __device__ void init(int M, int N, int G_, int c_) { nM = M / BM; nN = N / BM; nwg = nM * nN; G = G_; c = c_; }
    __host__ __device__ bool next(int i, Unit& u) const {
        const long L = (long)i * G + c; if (L >= nwg) return false;
        int wgid = (int)L; { const int q = nwg / NXCD, r = nwg % NXCD, xcd = wgid % NXCD, off = wgid / NXCD; wgid = (xcd < r ? xcd * (q + 1) : r * (q + 1) + (xcd - r) * q) + off; }
        const int nig = WGM * nN, gid = wgid / nig, fm = gid * WGM, gsz = (nM - fm) < WGM ? (nM - fm) : WGM;
        u.pm = fm + ((wgid % nig) % gsz); u.pn = (wgid % nig) / gsz; return true;
    }
    __device__ __forceinline__ void a_ready(const Unit&) const {}
    __device__ __forceinline__ void done(const Unit&) const {}
};

__device__ __forceinline__ unsigned cvt_pk_bf16(float lo, float hi) { unsigned r; asm volatile("v_cvt_pk_bf16_f32 %0, %1, %2" : "=v"(r) : "v"(lo), "v"(hi)); return r; }

struct EpiStoreBf16 {
    static constexpr bool PERM = true, AFTER_DRAIN = false;
    bf16_t* O; int ldc;
    __device__ __forceinline__ void operator()(const f32x4 (&acc)[2][2][4][2], const Unit& u, int wr, int wc, int fr, int fq) const {
        const int row0 = u.pm * BM + wr * 64 + fr; const int col0 = u.pn * BM + wc * 32 + 8 * fq;
#pragma unroll
        for (int ai = 0; ai < 2; ++ai)
#pragma unroll
            for (int m = 0; m < 4; ++m) { bf16_t* rowp = O + (size_t)(row0 + ai * HALF + m * 16) * ldc + col0;
#pragma unroll
                for (int bj = 0; bj < 2; ++bj) { const f32x4 v0 = acc[ai][bj][m][0], v1 = acc[ai][bj][m][1];
                    u32x4 w; w.x = cvt_pk_bf16(v0[0], v0[1]); w.y = cvt_pk_bf16(v0[2], v0[3]); w.z = cvt_pk_bf16(v1[0], v1[1]); w.w = cvt_pk_bf16(v1[2], v1[3]);
                    *(u32x4*)(rowp + bj * HALF) = w; } }
    }
};
template <class Epi, class Sched, bool ALIGN_EPI = false, bool SP2 = false>
__device__ __forceinline__ void gemm_phase(PG8_LAS unsigned char* lds, const Gemm g, const Sched& S, const Epi& E) {
    int tid_ = threadIdx.x; asm volatile("" : "+v"(tid_));
    const int tid = tid_, wid = __builtin_amdgcn_readfirstlane(tid >> 6), lane = tid & 63, wr = wid >> 2, wc = wid & 3, fr = lane & 15, fq = lane >> 4;
    const int K = g.K, nt = K / BK;
    unsigned voffA[2], voffB[2];
#pragma unroll
    for (int i = 0; i < 2; ++i) { int R, C; stage_rc(tid * 16 + i * 8192, R, C); const int Rb = Epi::PERM ? ((R & ~31) + perm32(R & 31)) : R;
        voffA[i] = (unsigned)(R * K + C) * 2u; voffB[i] = (unsigned)(Rb * K + C) * 2u; }
    const size_t kstep = (size_t)(BK * 2);
    const size_t hstep = (size_t)HALF * K * 2;
    const size_t tstep = 2 * hstep;
    const unsigned ldsw = (unsigned)wid * 1024u;
    const int aoff = lds_byte(wr * 64 + fr, fq * 8), boff = lds_byte(wc * 32 + fr, fq * 8);
#define PG8_SA(b, h) (((b) * 2 + (h)) * HTB)
#define PG8_SB(b, h) ((4 + (b) * 2 + (h)) * HTB)
#define PG8_STAGE(bufoff, gbase, voff) do { _Pragma("unroll") for (int _i = 0; _i < 2; ++_i) \
        __builtin_amdgcn_global_load_lds((const unsigned*)((const char*)(gbase) + (voff)[_i]), (PG8_LAS unsigned*)(lds + (bufoff) + ldsw + _i * 8192), 16, 0, 0); } while (0)
#define PG8_LDA(dst, b, h) do { _Pragma("unroll") for (int m = 0; m < 4; ++m) _Pragma("unroll") for (int k = 0; k < 2; ++k) dst[m][k] = *(const PG8_LAS bf16x8*)(lds + PG8_SA(b, h) + aoff + m * 2048 + k * 1024); } while (0)
#define PG8_LDB(dst, b, h) do { _Pragma("unroll") for (int n = 0; n < 2; ++n) _Pragma("unroll") for (int k = 0; k < 2; ++k) dst[n][k] = *(const PG8_LAS bf16x8*)(lds + PG8_SB(b, h) + boff + n * 2048 + k * 1024); } while (0)
#define PG8_MMA(ai, bj, At, Bt) do { __builtin_amdgcn_s_setprio(1); _Pragma("unroll") for (int m = 0; m < 4; ++m) _Pragma("unroll") for (int n = 0; n < 2; ++n) _Pragma("unroll") for (int k = 0; k < 2; ++k) \
        acc[ai][bj][m][n] = __builtin_amdgcn_mfma_f32_16x16x32_bf16(Bt[n][k], At[m][k], acc[ai][bj][m][n], 0, 0, 0); __builtin_amdgcn_s_setprio(0); } while (0)
#define PG8_WAIT_V(n) asm volatile("s_waitcnt vmcnt(" #n ")" ::: "memory")
#define PG8_WAIT_L(n) asm volatile("s_waitcnt lgkmcnt(" #n ")" ::: "memory")
#define PG8_BAR __builtin_amdgcn_s_barrier()
#define PG8_SCHED __builtin_amdgcn_sched_barrier(0)
    Unit cur, nxt; int ui = 0;
    if (!S.next(0, cur)) return;
    f32x4 acc[2][2][4][2];
#pragma unroll
    for (int a = 0; a < 2; ++a)
#pragma unroll
        for (int b = 0; b < 2; ++b)
#pragma unroll
            for (int m = 0; m < 4; ++m)
#pragma unroll
                for (int n = 0; n < 2; ++n) acc[a][b][m][n] = (f32x4){0.f, 0.f, 0.f, 0.f};
    bf16x8 At[4][2], B0[2][2], B1[2][2];
    const char* cA = (const char*)g.A + (size_t)cur.pm * tstep; const char* cB = (const char*)g.Bt + (size_t)cur.pn * tstep;
    S.a_ready(cur);
    if constexpr (SP2) {
        PG8_STAGE(PG8_SB(0, 0), cB, voffB); PG8_STAGE(PG8_SB(0, 1), cB + hstep, voffB); PG8_STAGE(PG8_SA(0, 0), cA, voffA); PG8_STAGE(PG8_SA(0, 1), cA + hstep, voffA);
        if (wr == 1) PG8_BAR;
        PG8_WAIT_V(2); PG8_BAR;
        PG8_STAGE(PG8_SB(1, 0), cB + kstep, voffB); PG8_STAGE(PG8_SA(1, 0), cA + kstep, voffA); PG8_STAGE(PG8_SB(1, 1), cB + hstep + kstep, voffB);
        PG8_WAIT_V(6); PG8_BAR;
    } else {
        PG8_STAGE(PG8_SB(0, 0), cB, voffB); PG8_STAGE(PG8_SA(0, 0), cA, voffA); PG8_STAGE(PG8_SB(0, 1), cB + hstep, voffB); PG8_STAGE(PG8_SA(0, 1), cA + hstep, voffA);
        if (wr == 1) PG8_BAR;
        PG8_WAIT_V(4); PG8_BAR;
        PG8_STAGE(PG8_SB(1, 0), cB + kstep, voffB); PG8_STAGE(PG8_SA(1, 0), cA + kstep, voffA); PG8_STAGE(PG8_SB(1, 1), cB + hstep + kstep, voffB);
        PG8_WAIT_V(6); PG8_BAR;
    }
    for (;;) {
        const bool has_next = S.next(ui + 1, nxt);
        const char* nA = has_next ? (const char*)g.A + (size_t)nxt.pm * tstep : cA; const char* nB = has_next ? (const char*)g.Bt + (size_t)nxt.pn * tstep : cB;
        for (int t = 0; t < nt; t += 2) {
            const bool last = (t == nt - 2);
            const char* a1 = cA + (size_t)(t + 1) * kstep;
            const char* a2 = last ? nA : cA + (size_t)(t + 2) * kstep; const char* b2 = last ? nB : cB + (size_t)(t + 2) * kstep;
            const char* a3 = a2 + kstep; const char* b3 = b2 + kstep;
            if (last && has_next) S.a_ready(nxt);
            if constexpr (SP2) {
            PG8_LDB(B0, 0, 0); PG8_LDB(B1, 0, 1); PG8_SCHED; PG8_LDA(At, 0, 0); PG8_STAGE(PG8_SA(1, 1), a1 + hstep, voffA);
            PG8_WAIT_V(8); PG8_WAIT_L(0); PG8_BAR; PG8_MMA(0, 0, At, B0); PG8_MMA(0, 1, At, B1); PG8_BAR; PG8_SCHED;
            PG8_LDA(At, 0, 1); PG8_STAGE(PG8_SB(0, 0), b2, voffB); PG8_STAGE(PG8_SB(0, 1), b2 + hstep, voffB); PG8_STAGE(PG8_SA(0, 0), a2, voffA);
            PG8_WAIT_V(8); PG8_WAIT_L(0); PG8_BAR; PG8_MMA(1, 0, At, B0); PG8_MMA(1, 1, At, B1); PG8_BAR; PG8_SCHED;
            PG8_LDB(B0, 1, 0); PG8_LDB(B1, 1, 1); PG8_SCHED; PG8_LDA(At, 1, 0); PG8_STAGE(PG8_SA(0, 1), a2 + hstep, voffA);
            PG8_WAIT_V(8); PG8_WAIT_L(0); PG8_BAR; PG8_MMA(0, 0, At, B0); PG8_MMA(0, 1, At, B1); PG8_BAR; PG8_SCHED;
            PG8_LDA(At, 1, 1); PG8_STAGE(PG8_SB(1, 0), b3, voffB); PG8_STAGE(PG8_SB(1, 1), b3 + hstep, voffB); PG8_STAGE(PG8_SA(1, 0), a3, voffA);
            PG8_WAIT_V(8); PG8_WAIT_L(0); PG8_BAR; PG8_MMA(1, 0, At, B0); PG8_MMA(1, 1, At, B1); PG8_BAR; PG8_SCHED;
            } else {
            PG8_LDB(B0, 0, 0); PG8_SCHED; PG8_LDA(At, 0, 0); PG8_STAGE(PG8_SA(1, 1), a1 + hstep, voffA);
            PG8_WAIT_L(8); PG8_BAR; PG8_WAIT_L(0); PG8_MMA(0, 0, At, B0); PG8_BAR; PG8_SCHED;
            PG8_LDB(B1, 0, 1); PG8_STAGE(PG8_SB(0, 0), b2, voffB);
            PG8_BAR; PG8_WAIT_L(0); PG8_MMA(0, 1, At, B1); PG8_BAR;
            PG8_LDA(At, 0, 1); PG8_STAGE(PG8_SA(0, 0), a2, voffA);
            PG8_BAR; PG8_WAIT_L(0); PG8_MMA(1, 0, At, B0); PG8_BAR; PG8_SCHED;
            PG8_STAGE(PG8_SB(0, 1), b2 + hstep, voffB);
            PG8_WAIT_V(6); PG8_BAR; PG8_MMA(1, 1, At, B1); PG8_BAR;
            PG8_LDB(B0, 1, 0); PG8_SCHED; PG8_LDA(At, 1, 0); PG8_STAGE(PG8_SA(0, 1), a2 + hstep, voffA);
            PG8_WAIT_L(8); PG8_BAR; PG8_WAIT_L(0); PG8_MMA(0, 0, At, B0); PG8_BAR; PG8_SCHED;
            PG8_LDB(B1, 1, 1); PG8_STAGE(PG8_SB(1, 0), b3, voffB);
            PG8_BAR; PG8_WAIT_L(0); PG8_MMA(0, 1, At, B1); PG8_BAR;
            PG8_LDA(At, 1, 1); PG8_STAGE(PG8_SA(1, 0), a3, voffA);
            PG8_BAR; PG8_WAIT_L(0); PG8_MMA(1, 0, At, B0); PG8_BAR; PG8_SCHED;
            PG8_STAGE(PG8_SB(1, 1), b3 + hstep, voffB);
            PG8_WAIT_V(6); PG8_BAR; PG8_MMA(1, 1, At, B1); PG8_BAR;
            }
        }
        if constexpr (ALIGN_EPI) { if (wr == 0) PG8_BAR; }
        if constexpr (!Epi::AFTER_DRAIN) { E(acc, cur, wr, wc, fr, fq); S.done(cur); }
        if (!has_next) break;
#pragma unroll
        for (int a = 0; a < 2; ++a)
#pragma unroll
            for (int b = 0; b < 2; ++b)
#pragma unroll
                for (int m = 0; m < 4; ++m)
#pragma unroll
                    for (int n = 0; n < 2; ++n) acc[a][b][m][n] = (f32x4){0.f, 0.f, 0.f, 0.f};
        cur = nxt; cA = nA; cB = nB; ++ui;
        if constexpr (ALIGN_EPI) { if (wr == 1) PG8_BAR; }
    }
    PG8_WAIT_V(0);
    if constexpr (!ALIGN_EPI) { if (wr == 0) PG8_BAR; }
    PG8_BAR;
    if constexpr (Epi::AFTER_DRAIN) { E.fused(acc, cur, wr, wc, fr, fq, lds, wid, lane); S.done(cur); }
#undef PG8_SA
#undef PG8_SB
#undef PG8_STAGE
#undef PG8_LDA
#undef PG8_LDB
#undef PG8_MMA
#undef PG8_WAIT_V
#undef PG8_WAIT_L
#undef PG8_BAR
#undef PG8_SCHED
}
}
#define GAS __attribute__((address_space(1)))
#define LAS __attribute__((address_space(3)))
typedef unsigned short bf16;
typedef unsigned v4u __attribute__((ext_vector_type(4)));
typedef float f32x4 __attribute__((ext_vector_type(4)));
typedef short bf16x8 __attribute__((ext_vector_type(8)));
typedef GAS unsigned gu32;
typedef GAS unsigned long long gu64;
#define RLX_AGENT __ATOMIC_RELAXED, __HIP_MEMORY_SCOPE_AGENT
#define LDS_WAIT() asm volatile("s_waitcnt lgkmcnt(0)" ::: "memory")
#define VM_WAIT() asm volatile("s_waitcnt vmcnt(0)" ::: "memory")
__device__ __forceinline__ unsigned long long rt() { return __builtin_amdgcn_s_memrealtime(); }
__device__ __forceinline__ unsigned f2bf(float f) { unsigned u = __builtin_bit_cast(unsigned, f); return (u + 0x7fffu + ((u >> 16) & 1u)) >> 16; }
__device__ __forceinline__ unsigned pk2(float lo, float hi) { return f2bf(lo) | (f2bf(hi) << 16); }
#define XB_TMO      128
#define XB_XCNT(j)  (256  + 64 * (j))
#define XB_XSUB(j)  (1280 + 64 * (j))
#define XB_XGEN(j)  (2304 + 64 * (j))
#define XB_TOP      3328
#define XB_TOPGEN   3392
#define XCD_BAR_WORDS 3456
#define XB_SPIN_CAP (1u << 18)

__device__ __forceinline__ unsigned xb_ld(unsigned* p)              { return __hip_atomic_load(p, __ATOMIC_RELAXED, __HIP_MEMORY_SCOPE_AGENT); }
__device__ __forceinline__ unsigned xb_add(unsigned* p, unsigned v) { return __hip_atomic_fetch_add(p, v, __ATOMIC_RELAXED, __HIP_MEMORY_SCOPE_AGENT); }
__device__ __forceinline__ unsigned xb_xcc_id() { return (unsigned)__builtin_amdgcn_s_getreg((3 << 11) | 20) & 0xFu; }
#define XB_SPIN(cond, bar) do { unsigned _sp = 0; while (cond) { __builtin_amdgcn_s_sleep(1); \
    if ((++_sp & 255u) == 0u) { if (xb_ld(&(bar)[XB_TMO])) break; if (_sp > XB_SPIN_CAP) { atomicAdd(&(bar)[XB_TMO], 1u); break; } } } } while (0)

struct XcdBarrier {
    unsigned* bar; unsigned x;
    volatile LAS unsigned* st;
};

__device__ __forceinline__ XcdBarrier xcd_barrier_post(unsigned* bar, volatile LAS unsigned* st) {
    XcdBarrier b; b.bar = bar; b.x = xb_xcc_id(); b.st = st;
    if (threadIdx.x == 0) (void)xb_add(&bar[XB_XCNT(b.x)], 1u);
    return b;
}
__device__ __forceinline__ void xcd_barrier_complete(unsigned* bar, unsigned x, unsigned& nloc, unsigned& nx) {
    const unsigned G = gridDim.x * gridDim.y * gridDim.z;
    unsigned sum, cnt, mine, sp = 0u;
    for (;;) {
        sum = 0u; cnt = 0u; mine = 0u;
#pragma unroll
        for (unsigned j = 0; j < 16; ++j) { const unsigned c = xb_ld(&bar[XB_XCNT(j)]); sum += c; cnt += (c > 0u) ? 1u : 0u; mine = (j == x) ? c : mine; }
        if (sum == G) break;
        __builtin_amdgcn_s_sleep(1);
        if ((++sp & 255u) == 0u) { if (xb_ld(&bar[XB_TMO])) break; if (sp > XB_SPIN_CAP) { atomicAdd(&bar[XB_TMO], 1u); break; } }
    }
    nloc = mine > 0u ? mine : 1u; nx = cnt > 0u ? cnt : 1u;
}

__device__ __forceinline__ void xcd_barrier(const XcdBarrier& b) {
    asm volatile("s_waitcnt vmcnt(0)" ::: "memory");
    __syncthreads();
    if (threadIdx.x == 0) {
        unsigned* bar = b.bar;
        __builtin_amdgcn_s_waitcnt(0);
        unsigned nloc = b.st[0], nx = b.st[1];
        if (nloc == 0u) { xcd_barrier_complete(bar, b.x, nloc, nx); b.st[0] = nloc; b.st[1] = nx; }
        const unsigned old = xb_add(&bar[XB_XSUB(b.x)], 1u);
        const unsigned gen = old / nloc;
        if (old + 1u == (gen + 1u) * nloc) {
            __builtin_amdgcn_fence(__ATOMIC_RELEASE, "agent");
            asm volatile("s_waitcnt vmcnt(0)" ::: "memory");
            const unsigned og = xb_add(&bar[XB_TOP], 1u);
            const unsigned tg = og / nx;
            if (og + 1u == (tg + 1u) * nx) xb_add(&bar[XB_TOPGEN], 1u);
            else XB_SPIN(xb_ld(&bar[XB_TOPGEN]) == tg, bar);
            __builtin_amdgcn_fence(__ATOMIC_ACQUIRE, "agent");
            xb_add(&bar[XB_XGEN(b.x)], 1u);
            asm volatile("s_waitcnt vmcnt(0)" ::: "memory");
        } else {
            XB_SPIN(xb_ld(&bar[XB_XGEN(b.x)]) == gen, bar);
            __builtin_amdgcn_fence(__ATOMIC_ACQUIRE, "agent");
            asm volatile("s_waitcnt vmcnt(0)" ::: "memory");
        }
    }
    __syncthreads();
}

typedef unsigned short bf16;
typedef float f32x2 __attribute__((ext_vector_type(2)));
typedef float f32x4 __attribute__((ext_vector_type(4)));
typedef float f32x16 __attribute__((ext_vector_type(16)));
typedef short bf16x8 __attribute__((ext_vector_type(8)));
typedef unsigned u32x2 __attribute__((ext_vector_type(2)));
typedef unsigned u32x4 __attribute__((ext_vector_type(4)));

constexpr int NL = 4, D = 2048, SEQ = 4096, NBP = 4, MP = 16384, NBS = 16, TS = 16, MS = 256, M = 16640, PAST = 1024, SKEYS = 1040;
constexpr int NIN = 6288, NINP = 6400, DFF = 5632, NGU = 11264, NMOD = 12288, NCOND = 20, KROWS = 33024;
constexpr int C_QA = 0, C_KA = 512, C_VA = 1024, C_QI = 1536, C_KI = 2560, C_WI = 2624, C_BG = 2640, C_CG = 3152, C_XB = 3664, C_QC = 4176, C_LAT = 5712, C_KR = 6224;
constexpr float ALPHA_RES = 1.681792830507429f;
constexpr float LN_EPS = 1e-5f, RMS_EPS = 1e-6f;
constexpr float LOG2E = 1.4426950408889634f;
constexpr float QS_A = 0.125f * LOG2E;
constexpr float QS_C = 0.07216878364870322f * LOG2E;
constexpr float WI_SCALE = 0.25f * 0.125f;

constexpr size_t O_Y = 0, O_PAK = 34078720, O_PAV = 67633152, O_PIK = 101187584, O_PLAT = 105381888, O_PKR = 138936320, O_PCB = 143130624, O_PCF = 143147008,
                 O_SAK = 143327232, O_SAV = 143851520, O_SIK = 144375808, O_SLAT = 144441344, O_SKR = 144965632, O_SCB = 145031168, O_SCF = 145096704, O_END = 145817600;

constexpr size_t MiB = 1u << 20;
constexpr size_t WS_CTL = 0, CTL_ZERO_BYTES = 1 * MiB;
constexpr size_t WS_ROPE = 1 * MiB;
constexpr size_t WS_MOD = 2 * MiB;
constexpr size_t WS_WI = 6 * MiB;
constexpr size_t WS_W = 8 * MiB, W_LAYER = 101 * MiB;
constexpr size_t WO_IN = 0, WO_OUT = 25 * MiB, WO_GU = 33 * MiB, WO_DN = 77 * MiB, WO_UK = 99 * MiB, WO_UV = 100 * MiB;
constexpr size_t WS_H = 412 * MiB;
constexpr size_t WS_T = 477 * MiB;
constexpr size_t WS_MIX = 542 * MiB;
constexpr size_t WS_ACT = 607 * MiB;
constexpr size_t WS_PROJ = 786 * MiB;
constexpr size_t WS_QA = 990 * MiB;
constexpr size_t WS_KA = 1007 * MiB;
constexpr size_t WS_VAT = 1040 * MiB;
constexpr size_t WS_QI = 1073 * MiB;
constexpr size_t WS_KI = 1106 * MiB;
constexpr size_t WS_QC = 1111 * MiB;
constexpr size_t WS_LAT = 1160 * MiB;
constexpr size_t WS_KR = 1193 * MiB;
constexpr size_t WS_KN = 1198 * MiB;
constexpr size_t WS_VCT = 1263 * MiB;
constexpr size_t WS_SEL = 1328 * MiB;
constexpr size_t WS_GU = 786 * MiB;
constexpr size_t WS_END = 1337 * MiB;
static_assert(WS_GU + (size_t)M * NGU * 2 <= WS_LAT, "GU overlay must stay clear of buffers that are live later");
static_assert(WS_PROJ + (size_t)M * NINP * 2 <= WS_QA && WS_KA + (size_t)KROWS * 512 * 2 <= WS_VAT && WS_VAT + (size_t)KROWS * 512 * 2 <= WS_QI && WS_QI + (size_t)M * 1024 * 2 <= WS_KI, "ws map 1");
static_assert(WS_KI + (size_t)KROWS * 64 * 2 <= WS_QC && WS_QC + (size_t)M * 1536 * 2 <= WS_LAT && WS_LAT + (size_t)KROWS * 512 * 2 <= WS_KR && WS_KR + (size_t)KROWS * 64 * 2 <= WS_KN, "ws map 2");
static_assert(WS_KN + (size_t)KROWS * 1024 * 2 <= WS_VCT && WS_VCT + (size_t)KROWS * 1024 * 2 <= WS_SEL && WS_SEL + (size_t)M * 512 <= WS_END, "ws map 3");
static_assert(WS_ACT + (size_t)M * DFF * 2 <= WS_PROJ && WS_MIX + (size_t)M * D * 2 <= WS_ACT && WS_T + (size_t)M * D * 2 <= WS_MIX && WS_H + (size_t)M * D * 2 <= WS_T && WS_W + 4 * W_LAYER <= WS_H, "ws map 4");
static_assert(WS_QA + (size_t)M * 512 * 2 <= WS_KA && WS_WI + (size_t)M * 16 * 4 <= WS_W && WS_MOD + (size_t)NL * NCOND * NMOD * 4 <= WS_WI, "ws map 5");

constexpr int CW_BAR = 4096;
constexpr int LDS_RING = 131072, LDS_HIST = 131072, LDS_CTL = 139264, LDS_MISC = LDS_CTL + 320, LDS_BYTES = 143360;

__device__ __forceinline__ float bflo(unsigned w) { return __uint_as_float(w << 16); }
__device__ __forceinline__ float bfhi(unsigned w) { return __uint_as_float(w & 0xffff0000u); }
__device__ __forceinline__ unsigned cvtpk(float lo, float hi) { unsigned r; asm volatile("v_cvt_pk_bf16_f32 %0, %1, %2" : "=v"(r) : "v"(lo), "v"(hi)); return r; }
__device__ __forceinline__ void unpack8(const u32x4 w, float (&f)[8]) { f[0] = bflo(w.x); f[1] = bfhi(w.x); f[2] = bflo(w.y); f[3] = bfhi(w.y); f[4] = bflo(w.z); f[5] = bfhi(w.z); f[6] = bflo(w.w); f[7] = bfhi(w.w); }
__device__ __forceinline__ u32x4 pack8(const float (&f)[8]) { u32x4 w; w.x = cvtpk(f[0], f[1]); w.y = cvtpk(f[2], f[3]); w.z = cvtpk(f[4], f[5]); w.w = cvtpk(f[6], f[7]); return w; }
__device__ __forceinline__ u32x4 ld16(const void* p) { return *(const u32x4*)p; }
__device__ __forceinline__ void st16(void* p, u32x4 v) { *(u32x4*)p = v; }
__device__ __forceinline__ void ld8f(const float* p, float (&f)[8]) { const f32x4 a = *(const f32x4*)p, b = *(const f32x4*)(p + 4); f[0] = a.x; f[1] = a.y; f[2] = a.z; f[3] = a.w; f[4] = b.x; f[5] = b.y; f[6] = b.z; f[7] = b.w; }
__device__ __forceinline__ void st8f(float* p, const float (&f)[8]) { *(f32x4*)p = (f32x4){f[0], f[1], f[2], f[3]}; *(f32x4*)(p + 4) = (f32x4){f[4], f[5], f[6], f[7]}; }
__device__ __forceinline__ u32x4 shx4(u32x4 w, int m) { u32x4 o; o.x = __shfl_xor(w.x, m); o.y = __shfl_xor(w.y, m); o.z = __shfl_xor(w.z, m); o.w = __shfl_xor(w.w, m); return o; }
__device__ __forceinline__ float wave_sum(float v) {
#pragma unroll
    for (int o = 1; o < 64; o <<= 1) v += __shfl_xor(v, o);
    return v;
}
__device__ __forceinline__ float wave_max(float v) {
#pragma unroll
    for (int o = 1; o < 64; o <<= 1) v = fmaxf(v, __shfl_xor(v, o));
    return v;
}
__device__ __forceinline__ int cond_idx(int r) { return r < MP ? (r >> 12) : 4 + ((r - MP) >> 4); }
#define LDS_WAIT() asm volatile("s_waitcnt lgkmcnt(0)" ::: "memory")

struct Args { const float* in[26]; float* out; unsigned char* ws; int ph_lo, ph_hi; };
static_assert(sizeof(Args) == 26 * 8 + 8 + 8 + 8, "Args has no padding");

__device__ __forceinline__ void p0_transpose_item(const float* W, int K, int N, int nblk, bf16* WT, LAS float* scr, int item, int lane) {
    const int kb = item / nblk, nb = item % nblk, k0 = 64 * kb, n0 = 32 * nb;
    const int n = n0 + (lane & 31); const bool ok = n < N;
#pragma unroll 8
    for (int i = 0; i < 32; ++i) { const int kk = 2 * i + (lane >> 5); scr[kk * 33 + (lane & 31)] = ok ? W[(size_t)(k0 + kk) * N + n] : 0.f; }
    LDS_WAIT(); asm volatile("" ::: "memory");
    const int c = lane & 7;
#pragma unroll
    for (int j = 0; j < 4; ++j) { const int nn = (lane >> 3) + 8 * j; const LAS float* s = scr + (8 * c) * 33 + nn;
        u32x4 o; o.x = cvtpk(s[0 * 33], s[1 * 33]); o.y = cvtpk(s[2 * 33], s[3 * 33]); o.z = cvtpk(s[4 * 33], s[5 * 33]); o.w = cvtpk(s[6 * 33], s[7 * 33]);
        *(u32x4*)(WT + (size_t)(n0 + nn) * K + k0 + 8 * c) = o; }
    LDS_WAIT(); asm volatile("" ::: "memory");
}

__device__ __forceinline__ void p0a_prologue(const Args& a, LAS unsigned char* lds, int tid, int lane, int wave, int vcu, int G) {
    unsigned char* ws = a.ws;
    {
        f32x2* rope = (f32x2*)(ws + WS_ROPE);
        for (int e = (vcu * 8 + wave) * 64 + lane; e < 4096 * 32; e += G * 512) {
            const int pos = e >> 5, i = e & 31;
            double inv = 1.0; for (int q = 0; q < i; ++q) inv *= 0.74989420933245582730;
            const float ang = (float)pos * (float)inv;
            double x = (double)ang * 0.15915494309189533577; x -= __builtin_rint(x);
            const float xf = (float)x;
            rope[e] = (f32x2){__builtin_amdgcn_cosf(xf), __builtin_amdgcn_sinf(xf)};
        }
    }
    {
        LAS float* tab = (LAS float*)lds;
        LAS float* red = (LAS float*)(lds + 81920);
        float* MOD = (float*)(ws + WS_MOD);
        for (int it = vcu; it < 768; it += G) {
            const int l = it / 192, strip = it % 192, col = strip * 64 + lane;
            const float* W = a.in[17] + (size_t)l * D * NMOD;
            float acc[20];
#pragma unroll
            for (int m = 0; m < 20; ++m) acc[m] = 0.f;
            for (int half = 0; half < 2; ++half) {
                __syncthreads();
                for (int e = tid; e < 20 * 1024; e += 512) { const int m = e >> 10, k = (e & 1023) + half * 1024;
                    const float c = (m < 4) ? a.in[2][m * D + k] : a.in[3][(m - 4) * D + k]; tab[e] = c / (1.f + __expf(-c)); }
                __syncthreads();
                const int k0 = wave * 128;
                for (int kk = 0; kk < 128; kk += 16) {
                    float w[16];
#pragma unroll
                    for (int j = 0; j < 16; ++j) w[j] = W[(size_t)(half * 1024 + k0 + kk + j) * NMOD + col];
#pragma unroll
                    for (int m = 0; m < 20; ++m) {
#pragma unroll
                        for (int j4 = 0; j4 < 4; ++j4) { const f32x4 t = *(const LAS f32x4*)(tab + m * 1024 + k0 + kk + 4 * j4);
                            acc[m] += t.x * w[4 * j4] + t.y * w[4 * j4 + 1] + t.z * w[4 * j4 + 2] + t.w * w[4 * j4 + 3]; }
                    }
                }
            }
#pragma unroll
            for (int m = 0; m < 20; ++m) red[(wave * 20 + m) * 64 + lane] = acc[m];
            __syncthreads();
            for (int e = tid; e < 20 * 64; e += 512) { const int m = e >> 6, ln = e & 63; float s = 0.f;
#pragma unroll
                for (int w8 = 0; w8 < 8; ++w8) s += red[(w8 * 20 + m) * 64 + ln];
                MOD[((size_t)l * NCOND + m) * NMOD + strip * 64 + ln] = s + a.in[18][(size_t)l * NMOD + strip * 64 + ln]; }
        }
        __syncthreads();
    }
    {
        LAS float* scr = (LAS float*)(lds + wave * 16384);
        const int gw = vcu * 8 + wave, NGW = G * 8;
        constexpr int I_IN = 32 * 200, I_OUT = 32 * 64, I_GU = 32 * 352, I_DN = 88 * 64, I_UK = 8 * 32, I_UV = 8 * 32, I_L = I_IN + I_OUT + I_GU + I_DN + I_UK + I_UV;
        for (int it = gw; it < NL * I_L; it += NGW) {
            const int l = it / I_L; int r = it % I_L;
            unsigned char* wl = ws + WS_W + (size_t)l * W_LAYER;
            if (r < I_IN) { p0_transpose_item(a.in[11] + (size_t)l * D * NIN, D, NIN, 200, (bf16*)(wl + WO_IN), scr, r, lane); continue; } r -= I_IN;
            if (r < I_OUT) { p0_transpose_item(a.in[12] + (size_t)l * D * D, D, D, 64, (bf16*)(wl + WO_OUT), scr, r, lane); continue; } r -= I_OUT;
            if (r < I_GU) { p0_transpose_item(a.in[23] + (size_t)l * D * NGU, D, NGU, 352, (bf16*)(wl + WO_GU), scr, r, lane); continue; } r -= I_GU;
            if (r < I_DN) { p0_transpose_item(a.in[25] + (size_t)l * DFF * D, DFF, D, 64, (bf16*)(wl + WO_DN), scr, r, lane); continue; } r -= I_DN;
            if (r < I_UK) { p0_transpose_item(a.in[15] + (size_t)l * 512 * 1024, 512, 1024, 32, (bf16*)(wl + WO_UK), scr, r, lane); continue; } r -= I_UK;
            p0_transpose_item(a.in[16] + (size_t)l * 512 * 1024, 512, 1024, 32, (bf16*)(wl + WO_UV), scr, r, lane);
        }
    }
}

__device__ __forceinline__ void modulate_row(const float* xrow, const float* sc, const float* sh, bf16* hrow, int lane) {
#pragma unroll
    for (int j = 0; j < 8; ++j) { const int col = 4 * lane + 256 * j;
        const f32x4 x = *(const f32x4*)(xrow + col), s = *(const f32x4*)(sc + col), h = *(const f32x4*)(sh + col);
        const f32x4 o = x * (1.f + s) + h; u32x2 w; w.x = cvtpk(o.x, o.y); w.y = cvtpk(o.z, o.w); *(u32x2*)(hrow + col) = w; }
}
__device__ __forceinline__ void p0b_h0(const Args& a, int lane, int gw, int NGW) {
    const float* MOD = (const float*)(a.ws + WS_MOD); bf16* H = (bf16*)(a.ws + WS_H);
    for (int r = gw; r < M; r += NGW) {
        const float* xrow = r < MP ? a.in[0] + (size_t)r * D : a.in[1] + (size_t)(r - MP) * D;
        const float* mod = MOD + (size_t)cond_idx(r) * NMOD;
        modulate_row(xrow, mod + D, mod, H + (size_t)r * D, lane);
    }
}

__device__ __forceinline__ void rope8(const float (&own)[8], const float (&oth)[8], const float (&cs)[16], float sgn, float (&o)[8]) {
#pragma unroll
    for (int i = 0; i < 8; ++i) o[i] = own[i] * cs[2 * i] + sgn * (oth[i] * cs[2 * i + 1]);
}

__device__ __forceinline__ void pb_token_row(const Args& a, int l, int r, int lane) {
    unsigned char* ws = a.ws;
    const bf16* P = (const bf16*)(ws + WS_PROJ) + (size_t)r * NINP;
    const bool smp = r >= MP;
    int b, t, pos, krow, T;
    if (!smp) { b = r >> 12; t = r & 4095; pos = t; krow = r; T = SEQ; }
    else { const int rs = r - MP; b = rs >> 4; t = rs & 15; pos = PAST + t; krow = MP + b * SKEYS + PAST + t; T = TS; }
    const int j = lane & 7, jm = j & 3; const float sgn = (j < 4) ? -1.f : 1.f;
    float cs[16];
    { const float* cp = (const float*)(ws + WS_ROPE) + ((size_t)pos * 32 + 8 * jm) * 2; ld8f(cp, *(float(*)[8])&cs[0]); ld8f(cp + 8, *(float(*)[8])&cs[8]); }
    float* out = a.out;
    const size_t orow = smp ? (size_t)l * MS + (r - MP) : (size_t)l * MP + r;
    float x[8], y[8], z[8];
    { const u32x4 w = ld16(P + C_QA + 8 * lane); const u32x4 o = shx4(w, 4); unpack8(w, x); unpack8(o, y); rope8(x, y, cs, sgn, z);
#pragma unroll
      for (int i = 0; i < 8; ++i) z[i] *= QS_A;
      st16((bf16*)(ws + WS_QA) + (size_t)r * 512 + 8 * lane, pack8(z)); }
    { const u32x4 w = ld16(P + C_KA + 8 * lane); const u32x4 o = shx4(w, 4); unpack8(w, x); unpack8(o, y); rope8(x, y, cs, sgn, z);
      st8f(out + (smp ? O_SAK : O_PAK) + orow * 512 + 8 * lane, z);
      st16((bf16*)(ws + WS_KA) + (size_t)krow * 512 + 8 * lane, pack8(z)); }
    { const u32x4 w = ld16(P + C_VA + 8 * lane); unpack8(w, x); st8f(out + (smp ? O_SAV : O_PAV) + orow * 512 + 8 * lane, x); }
#pragma unroll
    for (int s = 0; s < 2; ++s) { const u32x4 w = ld16(P + C_QI + 512 * s + 8 * lane); const u32x4 o = shx4(w, 4); unpack8(w, x); unpack8(o, y); rope8(x, y, cs, sgn, z);
      st16((bf16*)(ws + WS_QI) + (size_t)r * 1024 + 512 * s + 8 * lane, pack8(z)); }
    { u32x4 w = (u32x4){0u, 0u, 0u, 0u}; if (lane < 10) w = ld16(P + C_KI + 8 * lane); const u32x4 o = shx4(w, 4); unpack8(w, x); unpack8(o, y);
      if (lane < 8) { rope8(x, y, cs, sgn, z); st8f(out + (smp ? O_SIK : O_PIK) + orow * 64 + 8 * lane, z); st16((bf16*)(ws + WS_KI) + (size_t)krow * 64 + 8 * lane, pack8(z)); }
      else if (lane < 10) {
#pragma unroll
          for (int i = 0; i < 8; ++i) z[i] = x[i] * WI_SCALE;
          st8f((float*)(ws + WS_WI) + (size_t)r * 16 + 8 * (lane - 8), z); } }
    { const int c = 8 * lane; float bgv[8], u0[8], u1[8], u2[8], w0[8], w1[8], w2[8];
      unpack8(ld16(P + C_BG + c), bgv); unpack8(ld16(P + C_CG + c), x); unpack8(ld16(P + C_XB + c), y);
#pragma unroll
      for (int i = 0; i < 8; ++i) u0[i] = x[i] * y[i];
      const float* st = a.in[9] + ((size_t)(l * NBS + b) * 2) * 512 + c;
      if (t >= 1) { unpack8(ld16(P - NINP + C_CG + c), x); unpack8(ld16(P - NINP + C_XB + c), y);
#pragma unroll
          for (int i = 0; i < 8; ++i) u1[i] = x[i] * y[i]; }
      else if (smp) ld8f(st + 512, u1);
      else {
#pragma unroll
          for (int i = 0; i < 8; ++i) u1[i] = 0.f; }
      if (t >= 2) { unpack8(ld16(P - 2 * NINP + C_CG + c), x); unpack8(ld16(P - 2 * NINP + C_XB + c), y);
#pragma unroll
          for (int i = 0; i < 8; ++i) u2[i] = x[i] * y[i]; }
      else if (smp) ld8f(st + (size_t)t * 512, u2);
      else {
#pragma unroll
          for (int i = 0; i < 8; ++i) u2[i] = 0.f; }
      const float* cw = a.in[13] + (size_t)l * 3 * 512 + c; ld8f(cw, w0); ld8f(cw + 512, w1); ld8f(cw + 1024, w2);
#pragma unroll
      for (int i = 0; i < 8; ++i) z[i] = bgv[i] * (u2[i] * w0[i] + u1[i] * w1[i] + u0[i] * w2[i]);
      st16((bf16*)(ws + WS_MIX) + (size_t)r * D + 512 + c, pack8(z));
      if (t >= T - 2) { float* so = out + (smp ? O_SCB + ((size_t)(l * NBS + b) * 2 + (t - (T - 2))) * 512 : O_PCB + ((size_t)(l * NBP + b) * 2 + (t - (T - 2))) * 512) + c; st8f(so, u0); } }
#pragma unroll
    for (int s = 0; s < 3; ++s) { const int g = 64 * s + lane; const u32x4 w = ld16(P + C_QC + 8 * g); const u32x4 o = shx4(w, 4); unpack8(w, x); unpack8(o, y);
      if ((g % 24) >= 16) rope8(x, y, cs, sgn, z);
      else {
#pragma unroll
          for (int i = 0; i < 8; ++i) z[i] = x[i]; }
#pragma unroll
      for (int i = 0; i < 8; ++i) z[i] *= QS_C;
      st16((bf16*)(ws + WS_QC) + (size_t)r * 1536 + 8 * g, pack8(z)); }
    { unpack8(ld16(P + C_LAT + 8 * lane), x); float ss = 0.f;
#pragma unroll
      for (int i = 0; i < 8; ++i) ss += x[i] * x[i];
      ss = wave_sum(ss); const float rs = 1.0f / sqrtf(ss * (1.f / 512.f) + RMS_EPS);
      ld8f(a.in[14] + (size_t)l * 512 + 8 * lane, y);
#pragma unroll
      for (int i = 0; i < 8; ++i) z[i] = x[i] * rs * y[i];
      st8f(out + (smp ? O_SLAT : O_PLAT) + orow * 512 + 8 * lane, z);
      st16((bf16*)(ws + WS_LAT) + (size_t)krow * 512 + 8 * lane, pack8(z)); }
    { u32x4 w = (u32x4){0u, 0u, 0u, 0u}; if (lane < 8) w = ld16(P + C_KR + 8 * lane); const u32x4 o = shx4(w, 4); unpack8(w, x); unpack8(o, y);
      if (lane < 8) { rope8(x, y, cs, sgn, z); st8f(out + (smp ? O_SKR : O_PKR) + orow * 64 + 8 * lane, z); st16((bf16*)(ws + WS_KR) + (size_t)krow * 64 + 8 * lane, pack8(z)); } }
}

__device__ __forceinline__ void pb_cache_row(const Args& a, int l, int cr, int lane) {
    unsigned char* ws = a.ws; const int b = cr >> 10, s = cr & 1023; const size_t krow = (size_t)MP + b * SKEYS + s; const size_t src = (size_t)(l * NBS + b) * PAST + s;
    float x[8];
    ld8f(a.in[4] + src * 512 + 8 * lane, x); st16((bf16*)(ws + WS_KA) + krow * 512 + 8 * lane, pack8(x));
    ld8f(a.in[7] + src * 512 + 8 * lane, x); st16((bf16*)(ws + WS_LAT) + krow * 512 + 8 * lane, pack8(x));
    if (lane < 8) { ld8f(a.in[6] + src * 64 + 8 * lane, x); st16((bf16*)(ws + WS_KI) + krow * 64 + 8 * lane, pack8(x)); }
    else if (lane < 16) { ld8f(a.in[8] + src * 64 + 8 * (lane - 8), x); st16((bf16*)(ws + WS_KR) + krow * 64 + 8 * (lane - 8), pack8(x)); }
}

__device__ __forceinline__ void pb_vat_job(const Args& a, int l, int job, int lane) {
    unsigned char* ws = a.ws; const int rb = job >> 3, h = job & 7; const int krow0 = rb * 64; const int colv = h * 64 + lane;
    const bf16* PROJ = (const bf16*)(ws + WS_PROJ);
    unsigned pk[32];
#pragma unroll
    for (int i2 = 0; i2 < 32; ++i2) {
        float v[2];
#pragma unroll
        for (int e = 0; e < 2; ++e) { const int krow = krow0 + 2 * i2 + e;
            if (krow < MP) v[e] = bflo((unsigned)PROJ[(size_t)krow * NINP + C_VA + colv]);
            else { const int ks = krow - MP, bb = ks / SKEYS, s = ks - bb * SKEYS;
                if (s < PAST) v[e] = a.in[5][((size_t)(l * NBS + bb) * PAST + s) * 512 + colv];
                else v[e] = bflo((unsigned)PROJ[(size_t)(MP + bb * TS + (s - PAST)) * NINP + C_VA + colv]); } }
        pk[i2] = cvtpk(v[0], v[1]);
    }
    bf16* dst = (bf16*)(ws + WS_VAT) + (size_t)colv * KROWS + krow0;
#pragma unroll
    for (int q = 0; q < 8; ++q) st16(dst + 8 * q, (u32x4){pk[4 * q], pk[4 * q + 1], pk[4 * q + 2], pk[4 * q + 3]});
}


__device__ __forceinline__ void radix_scan(const LAS unsigned* hist, unsigned need, int lane, unsigned& Tout, unsigned& above_out) {
    const u32x4 v = *(const LAS u32x4*)(hist + 4 * lane);
    const unsigned s = v.x + v.y + v.z + v.w;
    unsigned suf = s;
#pragma unroll
    for (int o = 1; o < 64; o <<= 1) { const unsigned t = __shfl_down(suf, o); suf += (lane + o < 64) ? t : 0u; }
    const unsigned above = suf - s;
    const bool hit = (above < need) && (above + s >= need);
    const unsigned long long bm = __ballot(hit);
    const int L = bm ? (int)__builtin_ctzll(bm) : 0;
    unsigned c = above, Tl, Al;
    if (c + v.w >= need) { Tl = 3u; Al = c; }
    else { c += v.w; if (c + v.z >= need) { Tl = 2u; Al = c; } else { c += v.z; if (c + v.y >= need) { Tl = 1u; Al = c; } else { c += v.y; Tl = 0u; Al = c; } } }
    Tout = (unsigned)__builtin_amdgcn_readlane((int)Tl, L) + 4u * (unsigned)L;
    above_out = (unsigned)__builtin_amdgcn_readlane((int)Al, L);
}

__device__ __forceinline__ void pd_query(const Args& a, LAS unsigned* keys, LAS unsigned* hist, int q, int lane) {
    unsigned char* ws = a.ws;
    unsigned long long* SEL = (unsigned long long*)(ws + WS_SEL) + (size_t)q * 64;
    int nsteps, nvalid; size_t krow0;
    if (q < MP) { const int t = q & 4095; nsteps = (t >> 6) + 1; nvalid = nsteps * 64; krow0 = (size_t)(q & ~4095); }
    else { const int b = (q - MP) >> 4; nsteps = 17; nvalid = SKEYS; krow0 = (size_t)MP + (size_t)b * SKEYS; }
    if (nsteps <= 4) { SEL[lane] = (lane < nsteps) ? ~0ull : 0ull; return; }
    const int kc = lane & 15, g = lane >> 4;
    bf16x8 af[2];
    { const bf16* qp = (const bf16*)(ws + WS_QI) + (size_t)q * 1024 + kc * 64 + 8 * g; af[0] = *(const bf16x8*)qp; af[1] = *(const bf16x8*)(qp + 32); }
    const f32x4 wv = *(const f32x4*)((const float*)(ws + WS_WI) + (size_t)q * 16 + 4 * g);
    const bf16* kp = (const bf16*)(ws + WS_KI) + (krow0 + kc) * 64 + 8 * g;
    bf16x8 bcur[8], bnxt[8];
#pragma unroll
    for (int grp = 0; grp < 4; ++grp) { bcur[2 * grp] = *(const bf16x8*)(kp + (size_t)(16 * grp) * 64); bcur[2 * grp + 1] = *(const bf16x8*)(kp + (size_t)(16 * grp) * 64 + 32); }
    for (int st = 0; st < nsteps; ++st) {
        kp += 64 * 64;
        if (st + 1 < nsteps) {
#pragma unroll
            for (int grp = 0; grp < 4; ++grp) { bnxt[2 * grp] = *(const bf16x8*)(kp + (size_t)(16 * grp) * 64); bnxt[2 * grp + 1] = *(const bf16x8*)(kp + (size_t)(16 * grp) * 64 + 32); }
        }
        float mine = 0.f;
#pragma unroll
        for (int grp = 0; grp < 4; ++grp) {
            f32x4 acc = (f32x4){0.f, 0.f, 0.f, 0.f};
            acc = __builtin_amdgcn_mfma_f32_16x16x32_bf16(af[0], bcur[2 * grp], acc, 0, 0, 0);
            acc = __builtin_amdgcn_mfma_f32_16x16x32_bf16(af[1], bcur[2 * grp + 1], acc, 0, 0, 0);
            float p = 0.f;
            p = fmaf(fmaxf(acc.x, 0.f), wv.x, p); p = fmaf(fmaxf(acc.y, 0.f), wv.y, p); p = fmaf(fmaxf(acc.z, 0.f), wv.z, p); p = fmaf(fmaxf(acc.w, 0.f), wv.w, p);
            p += __shfl_xor(p, 16); p += __shfl_xor(p, 32);
            mine = (g == grp) ? p : mine;
        }
        const unsigned u = __float_as_uint(mine);
        const unsigned ok = u ^ ((unsigned)((int)u >> 31) | 0x80000000u);
        keys[64 * st + lane] = (64 * st + lane < nvalid) ? ok : 0u;
#pragma unroll
        for (int i = 0; i < 8; ++i) bcur[i] = bnxt[i];
    }
    unsigned prefix = 0u, need = 256u;
#pragma unroll
    for (int pass = 0; pass < 4; ++pass) {
        const int sh = 24 - 8 * pass;
        hist[4 * lane] = 0u; hist[4 * lane + 1] = 0u; hist[4 * lane + 2] = 0u; hist[4 * lane + 3] = 0u;
        for (int st = 0; st < nsteps; ++st) { const unsigned k = keys[64 * st + lane];
            const bool match = (pass == 0) ? true : ((k >> (sh + 8)) == prefix);
            if (match) __hip_atomic_fetch_add(hist + ((k >> sh) & 0xffu), 1u, __ATOMIC_RELAXED, __HIP_MEMORY_SCOPE_WORKGROUP); }
        unsigned T, ab; radix_scan(hist, need, lane, T, ab);
        prefix = (prefix << 8) | T; need -= ab;
    }
    const unsigned tkey = prefix, take_eq = need;
    unsigned long long mymask = 0ull; unsigned run = 0u;
    const unsigned long long lt = (lane == 0) ? 0ull : (~0ull >> (64 - lane));
    for (int st = 0; st < nsteps; ++st) { const unsigned k = keys[64 * st + lane];
        const bool gt = k > tkey, eq = k == tkey;
        const unsigned long long em = __ballot(eq);
        const unsigned rank = run + (unsigned)__builtin_popcountll(em & lt);
        const bool sel = gt || (eq && rank < take_eq);
        run += (unsigned)__builtin_popcountll(em);
        const unsigned long long sm = __ballot(sel);
        mymask = (lane == st) ? sm : mymask;
    }
    SEL[lane] = mymask;
}

template <int DQK, int DK1, int DV, bool MASKED>
__device__ __forceinline__ void attn_unit(LAS unsigned char* lds, const bf16* Q, int qpitch, const bf16* K1, int k1p, const bf16* K2, int k2p, const bf16* Vt, int vp,
                                          const unsigned long long* SEL, bf16* O, int opitch, int qb, int tid) {
    constexpr int KP = DQK * 2 + 16, VP = 144, KBYTES = 64 * KP, VBYTES = DV * VP, BUF = KBYTES + VBYTES;
    constexpr int C1 = DK1 / 8, C2 = (DQK - DK1) / 8, NK1 = 64 * C1 / 512, NK2 = 64 * C2 / 512, NVC = DV * 8 / 512, NDS = DQK / 16, NDB = DV / 32;
    static_assert(64 * C1 % 512 == 0 && 64 * C2 % 512 == 0 && DV * 8 % 512 == 0 && 2 * BUF <= LDS_RING, "attention tile staging");
    const int lane = tid & 63, wid = __builtin_amdgcn_readfirstlane(tid >> 6), rho = lane & 31, hi = lane >> 5;
    const int prho = (rho & ~12) | ((rho & 8) >> 1) | ((rho & 4) << 1);
    const int NT = 4 * qb + 4, cw = 4 * qb + (wid >> 1);
    bf16x8 qf[NDS];
    { const bf16* qp = Q + (size_t)(32 * wid + rho) * qpitch + 8 * hi;
#pragma unroll
      for (int ds = 0; ds < NDS; ++ds) qf[ds] = *(const bf16x8*)(qp + 16 * ds); }
    const unsigned long long* selp = MASKED ? SEL + (size_t)(32 * wid + rho) * 64 : nullptr;
    const __amdgpu_buffer_rsrc_t r1 = __builtin_amdgcn_make_buffer_rsrc((void*)K1, 0, 0x7fffffff, 0x00020000);
    const __amdgpu_buffer_rsrc_t r2 = __builtin_amdgcn_make_buffer_rsrc((void*)(C2 ? K2 : K1), 0, 0x7fffffff, 0x00020000);
    const __amdgpu_buffer_rsrc_t rv = __builtin_amdgcn_make_buffer_rsrc((void*)Vt, 0, 0x7fffffff, 0x00020000);
    int ko1[NK1], kl1[NK1], ko2[NK2 ? NK2 : 1], kl2[NK2 ? NK2 : 1], vo[NVC], vl[NVC];
#pragma unroll
    for (int i = 0; i < NK1; ++i) { const int cid = tid + 512 * i, row = cid / C1, ch = cid % C1; ko1[i] = (row * k1p + 8 * ch) * 2; kl1[i] = row * KP + ch * 16; }
#pragma unroll
    for (int i = 0; i < NK2; ++i) { const int cid = tid + 512 * i, row = cid / (C2 ? C2 : 1), ch = cid % (C2 ? C2 : 1); ko2[i] = (row * k2p + 8 * ch) * 2; kl2[i] = row * KP + (C1 + ch) * 16; }
#pragma unroll
    for (int i = 0; i < NVC; ++i) { const int cid = tid + 512 * i, d = cid >> 3, ch = cid & 7; vo[i] = (d * vp + 8 * ch) * 2; vl[i] = KBYTES + d * VP + ch * 16; }
    u32x4 kreg1[NK1], kreg2[NK2 ? NK2 : 1], vreg[NVC];
#define AT_LOAD(t) do { \
        _Pragma("unroll") for (int i = 0; i < NK1; ++i) kreg1[i] = __builtin_amdgcn_raw_buffer_load_b128(r1, ko1[i], (t) * 64 * k1p * 2, 0); \
        _Pragma("unroll") for (int i = 0; i < NK2; ++i) kreg2[i] = __builtin_amdgcn_raw_buffer_load_b128(r2, ko2[i], (t) * 64 * k2p * 2, 0); \
        _Pragma("unroll") for (int i = 0; i < NVC; ++i) vreg[i] = __builtin_amdgcn_raw_buffer_load_b128(rv, vo[i], (t) * 128, 0); } while (0)
#define AT_STORE(buf) do { \
        _Pragma("unroll") for (int i = 0; i < NK1; ++i) *(LAS u32x4*)(lds + (buf) * BUF + kl1[i]) = kreg1[i]; \
        _Pragma("unroll") for (int i = 0; i < NK2; ++i) *(LAS u32x4*)(lds + (buf) * BUF + kl2[i]) = kreg2[i]; \
        _Pragma("unroll") for (int i = 0; i < NVC; ++i) *(LAS u32x4*)(lds + (buf) * BUF + vl[i]) = vreg[i]; } while (0)
    f32x16 o[NDB];
#pragma unroll
    for (int db = 0; db < NDB; ++db)
#pragma unroll
        for (int r = 0; r < 16; ++r) o[db][r] = 0.f;
    float m = -1e30f, l = 0.f;
    __syncthreads();
    AT_LOAD(0); AT_STORE(0);
    __syncthreads();
    for (int t = 0; t < NT; ++t) {
        const int buf = t & 1;
        if (t + 1 < NT) AT_LOAD(t + 1);
        if (t <= cw) {
            const LAS unsigned char* kb = lds + buf * BUF; const LAS unsigned char* vb = kb + KBYTES;
            unsigned long long sw = 0ull; if (MASKED) sw = selp[t];
#pragma unroll
            for (int kbk = 0; kbk < 2; ++kbk) {
                f32x16 s0;
#pragma unroll
                for (int r = 0; r < 16; ++r) s0[r] = 0.f;
                {
                    constexpr int PF = (NDS < 4) ? NDS : 4;
                    const LAS unsigned char* kr = kb + (32 * kbk + prho) * KP + 16 * hi;
                    bf16x8 af[PF];
#pragma unroll
                    for (int i = 0; i < PF; ++i) af[i] = *(const LAS bf16x8*)(kr + 32 * i);
#pragma unroll
                    for (int ds = 0; ds < NDS; ++ds) {
                        const bf16x8 a0 = af[ds % PF];
                        asm volatile("" ::: "memory");
                        if (ds + PF < NDS) af[ds % PF] = *(const LAS bf16x8*)(kr + 32 * (ds + PF));
                        s0 = __builtin_amdgcn_mfma_f32_32x32x16_bf16(a0, qf[ds], s0, 0, 0, 0);
                    }
                }
                if (MASKED) {
                    const unsigned w0 = (unsigned)(sw >> (32 * kbk)) >> (8 * hi);
#pragma unroll
                    for (int r = 0; r < 16; ++r) { const unsigned bit = 1u << (16 * (r >> 3) + (r & 7)); s0[r] = (w0 & bit) ? s0[r] : -INFINITY; }
                }
                float mx = s0[0];
#pragma unroll
                for (int r = 1; r < 16; ++r) mx = fmaxf(mx, s0[r]);
                mx = fmaxf(mx, __shfl_xor(mx, 32));
                if (__any(mx > m)) {
                    const float mn = fmaxf(m, mx), alpha = __builtin_amdgcn_exp2f(m - mn); m = mn; l *= alpha;
#pragma unroll
                    for (int db = 0; db < NDB; ++db)
#pragma unroll
                        for (int r = 0; r < 16; ++r) o[db][r] *= alpha;
                }
                float ps = 0.f;
#pragma unroll
                for (int r = 0; r < 16; ++r) { s0[r] = __builtin_amdgcn_exp2f(s0[r] - m); ps += s0[r]; }
                l += ps;
                bf16x8 pf[2];
#pragma unroll
                for (int s = 0; s < 2; ++s) { u32x4 p0;
                    p0.x = cvtpk(s0[8 * s], s0[8 * s + 1]); p0.y = cvtpk(s0[8 * s + 2], s0[8 * s + 3]); p0.z = cvtpk(s0[8 * s + 4], s0[8 * s + 5]); p0.w = cvtpk(s0[8 * s + 6], s0[8 * s + 7]);
                    pf[s] = __builtin_bit_cast(bf16x8, p0); }
#pragma unroll
                for (int db = 0; db < NDB; ++db) {
                    const bf16x8 vf0 = *(const LAS bf16x8*)(vb + (32 * db + rho) * VP + (32 * kbk + 8 * hi) * 2);
                    const bf16x8 vf1 = *(const LAS bf16x8*)(vb + (32 * db + rho) * VP + (32 * kbk + 16 + 8 * hi) * 2);
                    asm volatile("" ::: "memory");
                    o[db] = __builtin_amdgcn_mfma_f32_32x32x16_bf16(vf0, pf[0], o[db], 0, 0, 0);
                    o[db] = __builtin_amdgcn_mfma_f32_32x32x16_bf16(vf1, pf[1], o[db], 0, 0, 0);
                }
            }
        }
        if (t + 1 < NT) AT_STORE(buf ^ 1);
        __syncthreads();
    }
#undef AT_LOAD
#undef AT_STORE
    const float lt = l + __shfl_xor(l, 32); const float inv = 1.0f / lt;
    bf16* op = O + (size_t)(32 * wid + rho) * opitch + 4 * hi;
#pragma unroll
    for (int db = 0; db < NDB; ++db)
#pragma unroll
        for (int g4 = 0; g4 < 4; ++g4) { u32x2 w; w.x = cvtpk(o[db][4 * g4] * inv, o[db][4 * g4 + 1] * inv); w.y = cvtpk(o[db][4 * g4 + 2] * inv, o[db][4 * g4 + 3] * inv);
            *(u32x2*)(op + 32 * db + 8 * g4) = w; }
}

template <int DQK, int DK1, int DV, bool MASKED>
__device__ __forceinline__ void sattn_unit(LAS float* pl, const bf16* q, const bf16* K1, int k1p, const bf16* K2, int k2p, const bf16* Vt, int vp, const unsigned long long* sel, bf16* o, int lane) {
    float mx = -INFINITY;
    for (int i = 0; i < 17; ++i) {
        const int s = lane + 64 * i; const bool valid = s < SKEYS; const int sc = valid ? s : 0;
        float dot = 0.f;
        const bf16* k1 = K1 + (size_t)sc * k1p;
#pragma unroll 4
        for (int ch = 0; ch < DK1 / 8; ++ch) { float qv[8], kv[8]; unpack8(ld16(q + 8 * ch), qv); unpack8(ld16(k1 + 8 * ch), kv);
#pragma unroll
            for (int e = 0; e < 8; ++e) dot = fmaf(qv[e], kv[e], dot); }
        if (DQK > DK1) { const bf16* k2 = K2 + (size_t)sc * k2p;
#pragma unroll 4
            for (int ch = 0; ch < (DQK - DK1) / 8; ++ch) { float qv[8], kv[8]; unpack8(ld16(q + DK1 + 8 * ch), qv); unpack8(ld16(k2 + 8 * ch), kv);
#pragma unroll
                for (int e = 0; e < 8; ++e) dot = fmaf(qv[e], kv[e], dot); } }
        bool on = valid;
        if (MASKED) on = on && ((sel[sc >> 6] >> (sc & 63)) & 1ull);
        const float v = on ? dot : -INFINITY;
        if (valid) pl[s] = v;
        mx = fmaxf(mx, v);
    }
    mx = wave_max(mx);
    LDS_WAIT();
    float ls = 0.f;
    for (int i = 0; i < 17; ++i) { const int s = lane + 64 * i; if (s < SKEYS) { const float p = __builtin_amdgcn_exp2f(pl[s] - mx); pl[s] = p; ls += p; } }
    ls = wave_sum(ls);
    LDS_WAIT();
    const float inv = 1.0f / ls;
#pragma unroll
    for (int dd = 0; dd < DV / 64; ++dd) {
        const int d = lane + 64 * dd; const bf16* vr = Vt + (size_t)d * vp; float acc = 0.f;
#pragma unroll 2
        for (int c8 = 0; c8 < SKEYS / 8; ++c8) { float vv[8]; unpack8(ld16(vr + 8 * c8), vv); const f32x4 p0 = *(const LAS f32x4*)(pl + 8 * c8), p1 = *(const LAS f32x4*)(pl + 8 * c8 + 4);
            acc += vv[0] * p0.x + vv[1] * p0.y + vv[2] * p0.z + vv[3] * p0.w + vv[4] * p1.x + vv[5] * p1.y + vv[6] * p1.z + vv[7] * p1.w; }
        o[d] = (bf16)(cvtpk(acc * inv, 0.f) & 0xffffu);
    }
    LDS_WAIT();
}

__device__ __forceinline__ void ln_row(const float* xin, const bf16* trow, const float* gate, const float* lng, const float* lnb, float* xout, const float* sc, const float* sh, bf16* hrow, int lane) {
    f32x4 y[8]; float s = 0.f;
#pragma unroll
    for (int j = 0; j < 8; ++j) { const int col = 4 * lane + 256 * j; const f32x4 x = *(const f32x4*)(xin + col), g = *(const f32x4*)(gate + col); const u32x2 tw = *(const u32x2*)(trow + col);
        const f32x4 tv = (f32x4){bflo(tw.x), bfhi(tw.x), bflo(tw.y), bfhi(tw.y)};
        y[j] = x * ALPHA_RES + (1.f + g) * tv; s += (y[j].x + y[j].y) + (y[j].z + y[j].w); }
    const float mean = wave_sum(s) * (1.f / D); float s2 = 0.f;
#pragma unroll
    for (int j = 0; j < 8; ++j) { y[j] = y[j] - mean; s2 += (y[j].x * y[j].x + y[j].y * y[j].y) + (y[j].z * y[j].z + y[j].w * y[j].w); }
    const float rstd = 1.0f / sqrtf(wave_sum(s2) * (1.f / D) + LN_EPS);
#pragma unroll
    for (int j = 0; j < 8; ++j) { const int col = 4 * lane + 256 * j; const f32x4 g = *(const f32x4*)(lng + col), b = *(const f32x4*)(lnb + col);
        const f32x4 xn = y[j] * rstd * g + b; *(f32x4*)(xout + col) = xn;
        if (sc) { const f32x4 c = *(const f32x4*)(sc + col), h = *(const f32x4*)(sh + col); const f32x4 o = xn * (1.f + c) + h; u32x2 w; w.x = cvtpk(o.x, o.y); w.y = cvtpk(o.z, o.w); *(u32x2*)(hrow + col) = w; } }
}

__device__ __forceinline__ void pi_row(const Args& a, int l, int r, int lane) {
    unsigned char* ws = a.ws;
    const bf16* G0 = (const bf16*)(ws + WS_GU) + (size_t)r * NGU;
    const bool smp = r >= MP; int b, t, T;
    if (!smp) { b = r >> 12; t = r & 4095; T = SEQ; } else { const int rs = r - MP; b = rs >> 4; t = rs & 15; T = TS; }
    const float* st = a.in[10] + ((size_t)(l * NBS + b) * 2) * DFF;
    const float* cw = a.in[24] + (size_t)l * 3 * DFF;
    bf16* arow = (bf16*)(ws + WS_ACT) + (size_t)r * DFF;
    float* so = (t >= T - 2) ? a.out + (smp ? O_SCF + ((size_t)(l * NBS + b) * 2 + (t - (T - 2))) * DFF : O_PCF + ((size_t)(l * NBP + b) * 2 + (t - (T - 2))) * DFF) : nullptr;
    for (int s = 0; s < 11; ++s) {
        const int c = 8 * (lane + 64 * s);
        float g0[8], g1[8], g2[8], up[8], w0[8], w1[8], w2[8], z[8];
        unpack8(ld16(G0 + c), g0); unpack8(ld16(G0 + DFF + c), up);
        if (t >= 1) unpack8(ld16(G0 - NGU + c), g1); else if (smp) ld8f(st + DFF + c, g1); else {
#pragma unroll
            for (int i = 0; i < 8; ++i) g1[i] = 0.f; }
        if (t >= 2) unpack8(ld16(G0 - 2 * NGU + c), g2); else if (smp) ld8f(st + (size_t)t * DFF + c, g2); else {
#pragma unroll
            for (int i = 0; i < 8; ++i) g2[i] = 0.f; }
        ld8f(cw + c, w0); ld8f(cw + DFF + c, w1); ld8f(cw + 2 * DFF + c, w2);
#pragma unroll
        for (int i = 0; i < 8; ++i) { const float gc = g2[i] * w0[i] + g1[i] * w1[i] + g0[i] * w2[i]; z[i] = gc / (1.f + __expf(-gc)) * up[i]; }
        st16(arow + c, pack8(z));
        if (so) st8f(so + c, g0);
    }
}

constexpr int N_PHASES = 2 + 10 * NL;
#ifndef MK_PHMASK
#define MK_PHMASK 0xFFFFu
#endif
#define EN(k) (((MK_PHMASK) >> (k)) & 1u)
__global__ void __launch_bounds__(512, 2) mk_fwd(Args args) {
    extern __shared__ __attribute__((aligned(16))) unsigned char lds_raw[];
    LAS unsigned char* lds = (LAS unsigned char*)lds_raw;
    const int tid = threadIdx.x, lane = tid & 63, wave = __builtin_amdgcn_readfirstlane(tid >> 6);
    const int G = gridDim.x, bx = blockIdx.x; const int vcu = (G % 8 == 0) ? (bx % 8) * (G / 8) + bx / 8 : bx;
    const int gw = vcu * 8 + wave, NGW = G * 8;
    for (int u = tid; u < (LDS_BYTES - LDS_CTL) / 4; u += 512) ((LAS unsigned*)(lds + LDS_CTL))[u] = 0u;
    __syncthreads();
#if !MK_MULTI
    XcdBarrier bar = xcd_barrier_post((unsigned*)(args.ws + WS_CTL) + CW_BAR, (volatile LAS unsigned*)(lds + LDS_MISC) + 8);
#define GRID_BAR() xcd_barrier(bar)
#else
#define GRID_BAR() do { } while (0)
#endif
    const int lo = args.ph_lo, hi = args.ph_hi;
#define IN(k) (lo <= (k) && (k) < hi)
#define SEAM(k) do { if (IN(k) && IN((k) + 1)) GRID_BAR(); } while (0)
#define GEMM_PHASE(Ap, Bp, Mv, Nv, Kv, Op, ldcv) do { pg8::Gemm g_{(const bf16*)(Ap), (const bf16*)(Bp), (Mv), (Nv), (Kv)}; pg8::StaticOrder S_; S_.init((Mv), (Nv), G, bx); \
        pg8::EpiStoreBf16 E_{(bf16*)(Op), (ldcv)}; pg8::gemm_phase<pg8::EpiStoreBf16, pg8::StaticOrder, true, true>(lds, g_, S_, E_); } while (0)
#define FRESH() int tid_p = tid; asm volatile("" : "+v"(tid_p)); const int lane_p = tid_p & 63; (void)lane_p
    unsigned char* ws = args.ws;
    const float* MOD = (const float*)(ws + WS_MOD);
    float* X = args.out + O_Y;

    if (EN(0) && IN(0)) p0a_prologue(args, lds, tid, lane, wave, vcu, G);
    SEAM(0);
    if (EN(1) && IN(1)) p0b_h0(args, lane, gw, NGW);
    SEAM(1);
    for (int l = 0; l < NL; ++l) {
        const int pb = 2 + 10 * l;
        unsigned char* wl = ws + WS_W + (size_t)l * W_LAYER;
        if (EN(2) && IN(pb)) GEMM_PHASE(ws + WS_H, wl + WO_IN, M, NINP, D, ws + WS_PROJ, NINP);
        SEAM(pb);
        if (EN(3) && IN(pb + 1)) { FRESH();
            for (int r = gw; r < M; r += NGW) pb_token_row(args, l, r, lane_p);
            for (int cr = gw; cr < NBS * PAST; cr += NGW) pb_cache_row(args, l, cr, lane_p);
            for (int jv = gw; jv < (KROWS / 64) * 8; jv += NGW) pb_vat_job(args, l, jv, lane_p);
        }
        SEAM(pb + 1);
        if (IN(pb + 2)) {
            if (EN(4)) { GEMM_PHASE(ws + WS_LAT, wl + WO_UK, KROWS, 1024, 512, ws + WS_KN, 1024);
            GEMM_PHASE(wl + WO_UV, ws + WS_LAT, 1024, KROWS, 512, ws + WS_VCT, KROWS); }
            if (EN(5)) { FRESH();
            LAS unsigned* keys = (LAS unsigned*)(lds + wave * 16384); LAS unsigned* hist = (LAS unsigned*)(lds + LDS_HIST + wave * 1024);
            for (int i = gw; i < MP / 2; i += NGW) { const int b = i >> 11, p = i & 2047;
                pd_query(args, keys, hist, b * SEQ + p, lane_p); pd_query(args, keys, hist, b * SEQ + (SEQ - 1 - p), lane_p); }
            for (int i = gw; i < MS * 8; i += NGW) if ((i & 7) == 0) pd_query(args, keys, hist, MP + (i >> 3), lane_p); }
        }
        SEAM(pb + 2);
        if (IN(pb + 3)) { FRESH();
            const bf16* QC = (const bf16*)(ws + WS_QC); const bf16* KN = (const bf16*)(ws + WS_KN); const bf16* KR = (const bf16*)(ws + WS_KR); const bf16* VCT = (const bf16*)(ws + WS_VCT);
            const bf16* QA = (const bf16*)(ws + WS_QA); const bf16* KA = (const bf16*)(ws + WS_KA); const bf16* VAT = (const bf16*)(ws + WS_VAT);
            const unsigned long long* SEL = (const unsigned long long*)(ws + WS_SEL); bf16* MIX = (bf16*)(ws + WS_MIX);
            if (EN(6)) for (int u = vcu; u < 256; u += G) { const int bh = u >> 3, s = u & 7, b = bh >> 3, h = bh & 7;
                for (int k = 0; k < 2; ++k) { const int qb = k ? 15 - s : s; const size_t row0 = (size_t)b * SEQ + 256 * qb;
                    attn_unit<192, 128, 128, false>(lds, QC + row0 * 1536 + h * 192, 1536, KN + (size_t)b * SEQ * 1024 + h * 128, 1024, KR + (size_t)b * SEQ * 64, 64,
                                                    VCT + (size_t)(h * 128) * KROWS + (size_t)b * SEQ, KROWS, nullptr, MIX + row0 * D + 1024 + h * 128, D, qb, tid_p); } }
            if (EN(7)) for (int u = vcu; u < 256; u += G) { const int bh = u >> 3, s = u & 7, b = bh >> 3, h = bh & 7;
                for (int k = 0; k < 2; ++k) { const int qb = k ? 15 - s : s; const size_t row0 = (size_t)b * SEQ + 256 * qb;
                    attn_unit<64, 64, 64, true>(lds, QA + row0 * 512 + h * 64, 512, KA + (size_t)b * SEQ * 512 + h * 64, 512, nullptr, 0,
                                                VAT + (size_t)(h * 64) * KROWS + (size_t)b * SEQ, KROWS, SEL + row0 * 64, MIX + row0 * D + h * 64, D, qb, tid_p); } }
            __syncthreads();
            LAS float* pl = (LAS float*)(lds + wave * 4352);
            if (EN(8)) for (int i = gw; i < NBS * 8 * TS; i += NGW) { const int b = i >> 7, h = (i >> 4) & 7, qq = i & 15; const size_t r = (size_t)MP + b * TS + qq, kr0 = (size_t)MP + (size_t)b * SKEYS;
                sattn_unit<192, 128, 128, false>(pl, QC + r * 1536 + h * 192, KN + kr0 * 1024 + h * 128, 1024, KR + kr0 * 64, 64, VCT + (size_t)(h * 128) * KROWS + kr0, KROWS, nullptr, MIX + r * D + 1024 + h * 128, lane_p);
                sattn_unit<64, 64, 64, true>(pl, QA + r * 512 + h * 64, KA + kr0 * 512 + h * 64, 512, nullptr, 0, VAT + (size_t)(h * 64) * KROWS + kr0, KROWS, SEL + r * 64, MIX + r * D + h * 64, lane_p); }
        }
        SEAM(pb + 3);
        if (EN(9) && IN(pb + 4)) GEMM_PHASE(ws + WS_MIX, wl + WO_OUT, M, D, D, ws + WS_T, D);
        SEAM(pb + 4);
        if (EN(10) && IN(pb + 5)) { FRESH();
            for (int r = gw; r < M; r += NGW) { const float* mod = MOD + ((size_t)l * NCOND + cond_idx(r)) * NMOD;
                const float* xin = (l == 0) ? (r < MP ? args.in[0] + (size_t)r * D : args.in[1] + (size_t)(r - MP) * D) : X + (size_t)r * D;
                ln_row(xin, (const bf16*)(ws + WS_T) + (size_t)r * D, mod + 2 * D, args.in[19] + (size_t)l * D, args.in[20] + (size_t)l * D, X + (size_t)r * D, mod + 4 * D, mod + 3 * D, (bf16*)(ws + WS_H) + (size_t)r * D, lane_p); }
        }
        SEAM(pb + 5);
        if (EN(11) && IN(pb + 6)) GEMM_PHASE(ws + WS_H, wl + WO_GU, M, NGU, D, ws + WS_GU, NGU);
        SEAM(pb + 6);
        if (EN(12) && IN(pb + 7)) { FRESH(); for (int r = gw; r < M; r += NGW) pi_row(args, l, r, lane_p); }
        SEAM(pb + 7);
        if (EN(13) && IN(pb + 8)) GEMM_PHASE(ws + WS_ACT, wl + WO_DN, M, D, DFF, ws + WS_T, D);
        SEAM(pb + 8);
        if (EN(14) && IN(pb + 9)) { FRESH();
            for (int r = gw; r < M; r += NGW) { const int m = cond_idx(r); const float* mod = MOD + ((size_t)l * NCOND + m) * NMOD; const float* modn = MOD + ((size_t)(l + 1 < NL ? l + 1 : l) * NCOND + m) * NMOD;
                ln_row(X + (size_t)r * D, (const bf16*)(ws + WS_T) + (size_t)r * D, mod + 5 * D, args.in[21] + (size_t)l * D, args.in[22] + (size_t)l * D, X + (size_t)r * D, (l + 1 < NL) ? modn + D : nullptr, modn, (bf16*)(ws + WS_H) + (size_t)r * D, lane_p); }
        }
        SEAM(pb + 9);
    }
#undef IN
#undef SEAM
#undef GEMM_PHASE
#undef GRID_BAR
}

extern "C" void kernel_launch(void* const* d_in, const int* in_sizes, int n_in, void* d_out, int out_size, void* d_ws, size_t ws_size, hipStream_t stream) {
    static int grid = 0;
    if (grid == 0) {
        if (n_in != 26 || (size_t)out_size != O_END || ws_size < WS_END || in_sizes[0] != MP * D || in_sizes[11] != NL * D * NIN) {
            fprintf(stderr, "kernel_launch: unexpected shapes (n_in %d, out %d, ws %zu); nothing launched\n", n_in, out_size, ws_size); grid = -1; return; }
        int dev = 0, cus = 0, per_cu = 0;
        if (hipGetDevice(&dev) != hipSuccess || hipDeviceGetAttribute(&cus, hipDeviceAttributeMultiprocessorCount, dev) != hipSuccess) { grid = -1; return; }
        if (hipFuncSetAttribute((const void*)mk_fwd, hipFuncAttributeMaxDynamicSharedMemorySize, LDS_BYTES) != hipSuccess) { fprintf(stderr, "kernel_launch: hipFuncSetAttribute failed\n"); grid = -1; return; }
        if (hipOccupancyMaxActiveBlocksPerMultiprocessor(&per_cu, (const void*)mk_fwd, 512, LDS_BYTES) != hipSuccess || per_cu < 1) fprintf(stderr, "kernel_launch: occupancy query reports %d\n", per_cu);
        (void)hipGetLastError();
        grid = cus;
    }
    if (grid < 0) return;
    if (hipMemsetAsync((char*)d_ws + WS_CTL, 0, CTL_ZERO_BYTES, stream) != hipSuccess) { fprintf(stderr, "kernel_launch: memset failed\n"); return; }
    Args a{};
    for (int i = 0; i < 26; ++i) a.in[i] = (const float*)d_in[i];
    a.out = (float*)d_out; a.ws = (unsigned char*)d_ws;
#if !MK_MULTI
    a.ph_lo = 0; a.ph_hi = N_PHASES;
    hipLaunchKernelGGL(mk_fwd, dim3(grid), dim3(512), LDS_BYTES, stream, a);
#else
    for (int p = 0; p < N_PHASES; ++p) { a.ph_lo = p; a.ph_hi = p + 1; hipLaunchKernelGGL(mk_fwd, dim3(grid), dim3(512), LDS_BYTES, stream, a); }
#endif
    const hipError_t le = hipPeekAtLastError();
    if (le != hipSuccess) fprintf(stderr, "kernel_launch: launch failed: %s\n", hipGetErrorName(le));
}
```

```cpp
#include <hip/hip_runtime.h>
#include <cstdio>
#include <cstdint>

#ifndef MK_MULTI
#define MK_MULTI 0
#endif

__device__ __forceinline__ int pg8_fresh_lane() { int l; asm volatile("v_mbcnt_lo_u32_b32 %0, -1, 0\n\tv_mbcnt_hi_u32_b32 %0, -1, %0" : "=v"(l)); return l; }
namespace pg8 {
#define PG8_LAS __attribute__((address_space(3)))
typedef unsigned short bf16_t;
typedef short bf16x8 __attribute__((ext_vector_type(8)));
typedef float f32x4 __attribute__((ext_vector_type(4)));
typedef unsigned u32x4 __attribute__((ext_vector_type(4)));
constexpr int BM = 256, BK = 64, HALF = 128, HTB = HALF * BK * 2  , STAGE_BYTES = 8 * HTB, NXCD = 8, WGM = 8;

__host__ __device__ __forceinline__ int lds_byte(int r, int c) { const int st = (r >> 4) * 2 + (c >> 5), rr = r & 15, cc = c & 31, ob = rr * 64 + cc * 2; return st * 1024 + (ob ^ (((ob >> 9) & 1) << 5)); }
__host__ __device__ __forceinline__ void stage_rc(int b, int& R, int& C) { const int st = b / 1024, sb = b % 1024, swz = sb ^ (((sb >> 9) & 1) << 5); R = (st >> 1) * 16 + swz / 64; C = (st & 1) * 32 + (swz % 64) / 2; }
__host__ __device__ __forceinline__ int perm32(int rho) { const int n = rho >> 4, i = rho & 15; return 8 * (i >> 2) + 4 * n + (i & 3); }

struct Unit { int pm, pn; };
struct Gemm { const bf16_t* A; const bf16_t* Bt; int M, N, K, ld; };

struct StaticOrder {
    int nM, nN, nwg, G, c;
    __host__ __device__ void init(int M, int N, int G_, int c_) { nM = M / BM; nN = N / BM; nwg = nM * nN; G = G_; c = c_; }
    __host__ __device__ bool next(int i, Unit& u) const {
        const long L = (long)i * G + c; if (L >= nwg) return false;
        int wgid = (int)L; { const int q = nwg / NXCD, r = nwg % NXCD, xcd = wgid % NXCD, off = wgid / NXCD; wgid = (xcd < r ? xcd * (q + 1) : r * (q + 1) + (xcd - r) * q) + off; }
        const int nig = WGM * nN, gid = wgid / nig, fm = gid * WGM, gsz = (nM - fm) < WGM ? (nM - fm) : WGM;
        u.pm = fm + ((wgid % nig) % gsz); u.pn = (wgid % nig) / gsz; return true;
    }
    __device__ __forceinline__ void a_ready(const Unit&) const {}
    __device__ __forceinline__ void done(const Unit&) const {}
};

__device__ __forceinline__ unsigned cvt_pk_bf16(float lo, float hi) { unsigned r; asm volatile("v_cvt_pk_bf16_f32 %0, %1, %2" : "=v"(r) : "v"(lo), "v"(hi)); return r; }

struct EpiStoreBf16 {
    static constexpr bool PERM = true, AFTER_DRAIN = false;
    bf16_t* O; int ldc;
    __device__ __forceinline__ void operator()(const f32x4 (&acc)[2][2][4][2], const Unit& u, int wr, int wc, int fr, int fq) const {
        const int row0 = u.pm * BM + wr * 64 + fr; const int col0 = u.pn * BM + wc * 32 + 8 * fq;
#pragma unroll
        for (int ai = 0; ai < 2; ++ai)
#pragma unroll
            for (int m = 0; m < 4; ++m) { bf16_t* rowp = O + (size_t)(row0 + ai * HALF + m * 16) * ldc + col0;
#pragma unroll
                for (int bj = 0; bj < 2; ++bj) { const f32x4 v0 = acc[ai][bj][m][0], v1 = acc[ai][bj][m][1];
                    u32x4 w; w.x = cvt_pk_bf16(v0[0], v0[1]); w.y = cvt_pk_bf16(v0[2], v0[3]); w.z = cvt_pk_bf16(v1[0], v1[1]); w.w = cvt_pk_bf16(v1[2], v1[3]);
                    *(u32x4*)(rowp + bj * HALF) = w; } }
    }
};
struct SplitOrder {
    int P, nwg, G, c;
    __host__ __device__ void init(int P_, int N, int G_, int c_) { P = P_; nwg = P_ * (N / BM); G = G_; c = c_; }
    __host__ __device__ bool next(int i, Unit& u) const { const long L = (long)i * G + c; if (L >= nwg) return false; u.pm = (int)(L % P); u.pn = (int)(L / P); return true; }
    __device__ __forceinline__ void a_ready(const Unit&) const {}
    __device__ __forceinline__ void done(const Unit&) const {}
};
struct EpiSlabF32 {
    static constexpr bool PERM = false, AFTER_DRAIN = false;
    float* S; int N;
    __device__ __forceinline__ void operator()(const f32x4 (&acc)[2][2][4][2], const Unit& u, int wr, int wc, int fr, int fq) const {
        const int row0 = wr * 64 + fr, col0 = u.pn * BM + wc * 32 + 4 * fq;
#pragma unroll
        for (int ai = 0; ai < 2; ++ai)
#pragma unroll
            for (int m = 0; m < 4; ++m) { float* rowp = S + ((size_t)u.pm * BM + row0 + ai * HALF + m * 16) * N + col0;
#pragma unroll
                for (int bj = 0; bj < 2; ++bj)
#pragma unroll
                    for (int n = 0; n < 2; ++n) *(f32x4*)(rowp + bj * HALF + n * 16) = acc[ai][bj][m][n]; }
    }
};

struct EpiAct {
    static constexpr bool PERM = true, AFTER_DRAIN = false;
    bf16_t* ACT; int dff;
    float* GH;
    float* G01;
    const float* cw;
    PG8_LAS float* halo;
    __device__ __forceinline__ void operator()(const f32x4 (&acc)[2][2][4][2], const Unit& u, int wr, int wc, int fr, int fq) const {
        const int chl = wc * 32 + 8 * fq, ch = u.pn * 128 + chl;
#pragma unroll
        for (int ai = 0; ai < 2; ++ai) if (fr >= 14) {
#pragma unroll
            for (int n = 0; n < 2; ++n) { *(PG8_LAS f32x4*)(halo + ((2 * ai + wr) * 2 + (fr - 14)) * 128 + chl + 4 * n) = acc[ai][0][3][n];
                if (ai == 1 && wr == 1) *(f32x4*)(GH + ((u.pm * 2 + (fr - 14)) * dff + ch + 4 * n)) = acc[ai][0][3][n]; } }
        asm volatile("s_waitcnt lgkmcnt(0)" ::: "memory"); __builtin_amdgcn_s_barrier(); asm volatile("" ::: "memory");
#pragma unroll
        for (int n = 0; n < 2; ++n) {
            const f32x4 w0 = *(const f32x4*)(cw + ch + 4 * n), w1 = *(const f32x4*)(cw + dff + ch + 4 * n), w2 = *(const f32x4*)(cw + 2 * dff + ch + 4 * n);
#pragma unroll
            for (int ai = 0; ai < 2; ++ai) {
                const int grp = 2 * ai + wr;
                f32x4 h14 = (f32x4){0.f, 0.f, 0.f, 0.f}, h15 = h14;
                if (grp > 0) { h14 = *(const PG8_LAS f32x4*)(halo + ((grp - 1) * 2 + 0) * 128 + chl + 4 * n); h15 = *(const PG8_LAS f32x4*)(halo + ((grp - 1) * 2 + 1) * 128 + chl + 4 * n); }
#pragma unroll
                for (int m = 0; m < 4; ++m) {
                    const f32x4 cur = acc[ai][0][m][n], upv = acc[ai][1][m][n]; f32x4 z;
#pragma unroll
                    for (int j = 0; j < 4; ++j) {
                        float t1, t2;
                        if (m > 0) { const int pv = __float_as_int(acc[ai][0][m - 1][n][j]);
                            t1 = __int_as_float(__builtin_amdgcn_update_dpp(pv, pv, 0x121, 0xf, 0xf, false)); t2 = __int_as_float(__builtin_amdgcn_update_dpp(pv, pv, 0x122, 0xf, 0xf, false)); }
                        else { t1 = h15[j]; t2 = (fr == 0) ? h14[j] : h15[j]; }
                        const int cv = __float_as_int(cur[j]);
                        const float g1 = __int_as_float(__builtin_amdgcn_update_dpp(__float_as_int(t1), cv, 0x111, 0xf, 0xf, false));
                        const float g2 = __int_as_float(__builtin_amdgcn_update_dpp(__float_as_int(t2), cv, 0x112, 0xf, 0xf, false));
                        const float gc = g2 * w0[j] + g1 * w1[j] + cur[j] * w2[j];
                        z[j] = gc * __builtin_amdgcn_rcpf(1.f + __expf(-gc)) * upv[j];
                    }
                    const int row = u.pm * BM + ai * HALF + wr * 64 + m * 16 + fr;
                    if (grp == 0 && m == 0 && fr < 2) {
                        *(f32x4*)(G01 + (((u.pm * 2 + fr) * 2 + 0) * dff + ch + 4 * n)) = cur;
                        *(f32x4*)(G01 + (((u.pm * 2 + fr) * 2 + 1) * dff + ch + 4 * n)) = upv;
                    } else {
                        unsigned w[2]; w[0] = cvt_pk_bf16(z[0], z[1]); w[1] = cvt_pk_bf16(z[2], z[3]);
                        *(unsigned long long*)(ACT + (size_t)row * dff + ch + 4 * n) = (unsigned long long)w[0] | ((unsigned long long)w[1] << 32);
                    }
                }
            }
        }
    }
};

struct EpiResid {
    static constexpr bool PERM = true, AFTER_DRAIN = false;
    bf16_t* X; int ldc; const float* gate_base; int gate_stride; float alpha;
    __device__ __forceinline__ void operator()(const f32x4 (&acc)[2][2][4][2], const Unit& u, int wr, int wc, int fr, int fq) const {
        const int row0 = u.pm * BM + wr * 64 + fr, col0 = u.pn * BM + wc * 32 + 8 * fq;
        const float* gp = gate_base + (size_t)(u.pm >> 4) * gate_stride + col0;
        f32x4 gv[2][2];
#pragma unroll
        for (int bj = 0; bj < 2; ++bj)
#pragma unroll
            for (int n = 0; n < 2; ++n) gv[bj][n] = *(const f32x4*)(gp + bj * HALF + 4 * n) + 1.f;
#pragma unroll
        for (int ai = 0; ai < 2; ++ai)
#pragma unroll
            for (int m = 0; m < 4; ++m) { bf16_t* rowp = X + (size_t)(row0 + ai * HALF + m * 16) * ldc + col0;
#pragma unroll
                for (int bj = 0; bj < 2; ++bj) { const u32x4 xw = *(const u32x4*)(rowp + bj * HALF);
                    const f32x4 x0 = (f32x4){__uint_as_float(xw.x << 16), __uint_as_float(xw.x & 0xffff0000u), __uint_as_float(xw.y << 16), __uint_as_float(xw.y & 0xffff0000u)};
                    const f32x4 x1 = (f32x4){__uint_as_float(xw.z << 16), __uint_as_float(xw.z & 0xffff0000u), __uint_as_float(xw.w << 16), __uint_as_float(xw.w & 0xffff0000u)};
                    const f32x4 v0 = x0 * alpha + gv[bj][0] * acc[ai][bj][m][0], v1 = x1 * alpha + gv[bj][1] * acc[ai][bj][m][1];
                    u32x4 w; w.x = cvt_pk_bf16(v0[0], v0[1]); w.y = cvt_pk_bf16(v0[2], v0[3]); w.z = cvt_pk_bf16(v1[0], v1[1]); w.w = cvt_pk_bf16(v1[2], v1[3]);
                    *(u32x4*)(rowp + bj * HALF) = w; } }
    }
};

struct EpiProj {
    static constexpr bool PERM = true, AFTER_DRAIN = false;
    bf16_t* PROJ; int ldp; bf16_t* QA; bf16_t* QI; bf16_t* QC; bf16_t* KA; bf16_t* KI; bf16_t* KR; float* WI; const float* rope; float qs_a, qs_c, wi_scale;
    float* o_ak; float* o_av; float* o_ik; float* o_kr;
    __device__ __forceinline__ void rope4(const f32x4& v0, const f32x4& v1, const f32x4& cs0, const f32x4& cs1, float sc, f32x4& lo, f32x4& hi) const {
        lo[0] = (v0[0] * cs0[0] - v0[1] * cs0[1]) * sc; hi[0] = (v0[0] * cs0[1] + v0[1] * cs0[0]) * sc;
        lo[1] = (v0[2] * cs0[2] - v0[3] * cs0[3]) * sc; hi[1] = (v0[2] * cs0[3] + v0[3] * cs0[2]) * sc;
        lo[2] = (v1[0] * cs1[0] - v1[1] * cs1[1]) * sc; hi[2] = (v1[0] * cs1[1] + v1[1] * cs1[0]) * sc;
        lo[3] = (v1[2] * cs1[2] - v1[3] * cs1[3]) * sc; hi[3] = (v1[2] * cs1[3] + v1[3] * cs1[2]) * sc; }
    static __device__ __forceinline__ void st4bf(bf16_t* p, const f32x4& v) { *(unsigned long long*)p = (unsigned long long)cvt_pk_bf16(v[0], v[1]) | ((unsigned long long)cvt_pk_bf16(v[2], v[3]) << 32); }
    __device__ __forceinline__ void operator()(const f32x4 (&acc)[2][2][4][2], const Unit& u, int wr, int wc, int fr, int fq) const {
        const int row0 = u.pm * BM + wr * 64 + fr, pn = u.pn;
        const int i0 = 16 * (wc & 1) + 4 * fq;
        if (pn >= 14 && pn < 24) {
            const int col0 = pn * BM + wc * 32 + 8 * fq;
#pragma unroll
            for (int ai = 0; ai < 2; ++ai)
#pragma unroll
                for (int m = 0; m < 4; ++m) { const int row = row0 + ai * HALF + m * 16; bf16_t* rowp = PROJ + (size_t)row * ldp + col0;
#pragma unroll
                    for (int bj = 0; bj < 2; ++bj) { const f32x4 v0 = acc[ai][bj][m][0], v1 = acc[ai][bj][m][1];
                        u32x4 w; w.x = cvt_pk_bf16(v0[0], v0[1]); w.y = cvt_pk_bf16(v0[2], v0[3]); w.z = cvt_pk_bf16(v1[0], v1[1]); w.w = cvt_pk_bf16(v1[2], v1[3]);
                        *(u32x4*)(rowp + bj * HALF) = w;
                        if (pn < 16) { float* op = o_av + (size_t)row * 512 + (pn - 14) * BM + bj * HALF + wc * 32 + 8 * fq; __builtin_nontemporal_store(v0, (f32x4*)op); __builtin_nontemporal_store(v1, (f32x4*)(op + 4)); } } }
        } else if (pn >= 6 && pn < 10) {
            const int d0 = wc * 32 + 8 * fq;
#pragma unroll
            for (int ai = 0; ai < 2; ++ai)
#pragma unroll
                for (int m = 0; m < 4; ++m) { bf16_t* rowp = QC + (size_t)(row0 + ai * HALF + m * 16) * 1536 + (2 * (pn - 6)) * 192 + d0;
#pragma unroll
                    for (int bj = 0; bj < 2; ++bj) { const f32x4 v0 = acc[ai][bj][m][0] * qs_c, v1 = acc[ai][bj][m][1] * qs_c;
                        u32x4 w; w.x = cvt_pk_bf16(v0[0], v0[1]); w.y = cvt_pk_bf16(v0[2], v0[3]); w.z = cvt_pk_bf16(v1[0], v1[1]); w.w = cvt_pk_bf16(v1[2], v1[3]);
                        *(u32x4*)(rowp + bj * 192) = w; } }
        } else if (pn == 24) {
#pragma unroll
            for (int ai = 0; ai < 2; ++ai)
#pragma unroll
                for (int m = 0; m < 4; ++m) { const int row = row0 + ai * HALF + m * 16; const float* cp = rope + ((size_t)(row & 4095) * 32 + i0) * 2;
                    const f32x4 cs0 = *(const f32x4*)cp, cs1 = *(const f32x4*)(cp + 4);
                    { f32x4 lo, hi; rope4(acc[ai][0][m][0], acc[ai][0][m][1], cs0, cs1, 1.f, lo, hi);
                      float* op = ((wc >> 1) ? o_kr : o_ik) + (size_t)row * 64 + i0; __builtin_nontemporal_store(lo, (f32x4*)op); __builtin_nontemporal_store(hi, (f32x4*)(op + 32));
                      bf16_t* kp = ((wc >> 1) ? KR : KI) + (size_t)row * 64 + i0; st4bf(kp, lo); st4bf(kp + 32, hi); }
                    if (wc == 0 && fq < 2) { float* wp = WI + (size_t)row * 16 + 8 * fq; *(f32x4*)wp = acc[ai][1][m][0] * wi_scale; *(f32x4*)(wp + 4) = acc[ai][1][m][1] * wi_scale; } }
        } else {
            bf16_t* dst; int pitch, hbase, hstride, coff; float sc;
            if (pn < 2) { dst = QA; pitch = 512; hbase = 4 * pn; hstride = 64; coff = 0; sc = qs_a; }
            else if (pn < 6) { dst = QI; pitch = 1024; hbase = 4 * (pn - 2); hstride = 64; coff = 0; sc = 1.f; }
            else if (pn < 12) { dst = QC; pitch = 1536; hbase = 4 * (pn - 10); hstride = 192; coff = 128; sc = qs_c; }
            else { dst = KA; pitch = 512; hbase = 4 * (pn - 12); hstride = 64; coff = 0; sc = 1.f; }
#pragma unroll
            for (int ai = 0; ai < 2; ++ai)
#pragma unroll
                for (int m = 0; m < 4; ++m) { const int row = row0 + ai * HALF + m * 16; const float* cp = rope + ((size_t)(row & 4095) * 32 + i0) * 2;
                    const f32x4 cs0 = *(const f32x4*)cp, cs1 = *(const f32x4*)(cp + 4);
#pragma unroll
                    for (int bj = 0; bj < 2; ++bj) { f32x4 lo, hi; rope4(acc[ai][bj][m][0], acc[ai][bj][m][1], cs0, cs1, sc, lo, hi);
                        const int hc = (hbase + 2 * bj + (wc >> 1)) * hstride + coff + i0;
                        bf16_t* hp = dst + (size_t)row * pitch + hc; st4bf(hp, lo); st4bf(hp + 32, hi);
                        if (pn >= 12) { float* op = o_ak + (size_t)row * 512 + hc; __builtin_nontemporal_store(lo, (f32x4*)op); __builtin_nontemporal_store(hi, (f32x4*)(op + 32)); } } }
        }
    }
};

template <class Epi, class Sched, bool ALIGN_EPI = false, bool SP2 = false, bool SPLITK = false>
__device__ __forceinline__ void gemm_phase(PG8_LAS unsigned char* lds, const Gemm g, const Sched& S, const Epi& E, const int wave_s) {
    int tid_ = wave_s * 64 + pg8_fresh_lane();
    const int tid = tid_, wid = __builtin_amdgcn_readfirstlane(tid >> 6), lane = tid & 63, wr = wid >> 2, wc = wid & 3, fr = lane & 15, fq = lane >> 4;
    const int K = g.ld, nt = g.K / BK;
    unsigned voffA[2], voffB[2];
#pragma unroll
    for (int i = 0; i < 2; ++i) { int R, C; stage_rc(tid * 16 + i * 8192, R, C); const int Rb = Epi::PERM ? ((R & ~31) + perm32(R & 31)) : R;
        voffA[i] = (unsigned)(R * K + C) * 2u; voffB[i] = (unsigned)(Rb * K + C) * 2u; }
    const size_t kstep = (size_t)(BK * 2);
    const size_t hstep = (size_t)HALF * K * 2;
    const size_t tstep = 2 * hstep;
    const unsigned ldsw = (unsigned)wid * 1024u;
    const int aoff = lds_byte(wr * 64 + fr, fq * 8), boff = lds_byte(wc * 32 + fr, fq * 8);
#define PG8_SA(b, h) (((b) * 2 + (h)) * HTB)
#define PG8_SB(b, h) ((4 + (b) * 2 + (h)) * HTB)
#define PG8_STAGE(bufoff, gbase, voff) do { _Pragma("unroll") for (int _i = 0; _i < 2; ++_i) \
        __builtin_amdgcn_global_load_lds((const unsigned*)((const char*)(gbase) + (voff)[_i]), (PG8_LAS unsigned*)(lds + (bufoff) + ldsw + _i * 8192), 16, 0, 0); } while (0)
#define PG8_LDA(dst, b, h) do { _Pragma("unroll") for (int m = 0; m < 4; ++m) _Pragma("unroll") for (int k = 0; k < 2; ++k) dst[m][k] = *(const PG8_LAS bf16x8*)(lds + PG8_SA(b, h) + aoff + m * 2048 + k * 1024); } while (0)
#define PG8_LDB(dst, b, h) do { _Pragma("unroll") for (int n = 0; n < 2; ++n) _Pragma("unroll") for (int k = 0; k < 2; ++k) dst[n][k] = *(const PG8_LAS bf16x8*)(lds + PG8_SB(b, h) + boff + n * 2048 + k * 1024); } while (0)
#define PG8_MMA(ai, bj, At, Bt) do { __builtin_amdgcn_s_setprio(1); _Pragma("unroll") for (int m = 0; m < 4; ++m) _Pragma("unroll") for (int n = 0; n < 2; ++n) _Pragma("unroll") for (int k = 0; k < 2; ++k) \
        acc[ai][bj][m][n] = __builtin_amdgcn_mfma_f32_16x16x32_bf16(Bt[n][k], At[m][k], acc[ai][bj][m][n], 0, 0, 0); __builtin_amdgcn_s_setprio(0); } while (0)
#define PG8_WAIT_V(n) asm volatile("s_waitcnt vmcnt(" #n ")" ::: "memory")
#define PG8_WAIT_L(n) asm volatile("s_waitcnt lgkmcnt(" #n ")" ::: "memory")
#define PG8_BAR __builtin_amdgcn_s_barrier()
#define PG8_SCHED __builtin_amdgcn_sched_barrier(0)
    Unit cur, nxt; int ui = 0;
    if (!S.next(0, cur)) return;
    f32x4 acc[2][2][4][2];
#pragma unroll
    for (int a = 0; a < 2; ++a)
#pragma unroll
        for (int b = 0; b < 2; ++b)
#pragma unroll
            for (int m = 0; m < 4; ++m)
#pragma unroll
                for (int n = 0; n < 2; ++n) acc[a][b][m][n] = (f32x4){0.f, 0.f, 0.f, 0.f};
    bf16x8 At[4][2], B0[2][2], B1[2][2];
    const size_t kpart = (size_t)g.K * 2;
    const char* cA = SPLITK ? (const char*)g.A + (size_t)cur.pm * kpart : (const char*)g.A + (size_t)cur.pm * tstep; const char* cB = (const char*)g.Bt + (size_t)cur.pn * tstep + (SPLITK ? (size_t)cur.pm * kpart : (size_t)0);
    S.a_ready(cur);
    if constexpr (SP2) {
        PG8_STAGE(PG8_SB(0, 0), cB, voffB); PG8_STAGE(PG8_SB(0, 1), cB + hstep, voffB); PG8_STAGE(PG8_SA(0, 0), cA, voffA); PG8_STAGE(PG8_SA(0, 1), cA + hstep, voffA);
        if (wr == 1) PG8_BAR;
        PG8_WAIT_V(2); PG8_BAR;
        PG8_STAGE(PG8_SB(1, 0), cB + kstep, voffB); PG8_STAGE(PG8_SA(1, 0), cA + kstep, voffA); PG8_STAGE(PG8_SB(1, 1), cB + hstep + kstep, voffB);
        PG8_WAIT_V(6); PG8_BAR;
    } else {
        PG8_STAGE(PG8_SB(0, 0), cB, voffB); PG8_STAGE(PG8_SA(0, 0), cA, voffA); PG8_STAGE(PG8_SB(0, 1), cB + hstep, voffB); PG8_STAGE(PG8_SA(0, 1), cA + hstep, voffA);
        if (wr == 1) PG8_BAR;
        PG8_WAIT_V(4); PG8_BAR;
        PG8_STAGE(PG8_SB(1, 0), cB + kstep, voffB); PG8_STAGE(PG8_SA(1, 0), cA + kstep, voffA); PG8_STAGE(PG8_SB(1, 1), cB + hstep + kstep, voffB);
        PG8_WAIT_V(6); PG8_BAR;
    }
    for (;;) {
        const bool has_next = S.next(ui + 1, nxt);
        const char* nA = has_next ? (SPLITK ? (const char*)g.A + (size_t)nxt.pm * kpart : (const char*)g.A + (size_t)nxt.pm * tstep) : cA; const char* nB = has_next ? (const char*)g.Bt + (size_t)nxt.pn * tstep + (SPLITK ? (size_t)nxt.pm * kpart : (size_t)0) : cB;
        for (int t = 0; t < nt; t += 2) {
            const bool last = (t == nt - 2);
            const char* a1 = cA + (size_t)(t + 1) * kstep;
            const char* a2 = last ? nA : cA + (size_t)(t + 2) * kstep; const char* b2 = last ? nB : cB + (size_t)(t + 2) * kstep;
            const char* a3 = a2 + kstep; const char* b3 = b2 + kstep;
            if (last && has_next) S.a_ready(nxt);
            if constexpr (SP2) {
            PG8_LDB(B0, 0, 0); PG8_LDB(B1, 0, 1); PG8_SCHED; PG8_LDA(At, 0, 0); PG8_STAGE(PG8_SA(1, 1), a1 + hstep, voffA);
            PG8_WAIT_V(8); PG8_WAIT_L(0); PG8_BAR; PG8_MMA(0, 0, At, B0); PG8_MMA(0, 1, At, B1); PG8_BAR; PG8_SCHED;
            PG8_LDA(At, 0, 1); PG8_STAGE(PG8_SB(0, 0), b2, voffB); PG8_STAGE(PG8_SB(0, 1), b2 + hstep, voffB); PG8_STAGE(PG8_SA(0, 0), a2, voffA);
            PG8_WAIT_V(8); PG8_WAIT_L(0); PG8_BAR; PG8_MMA(1, 0, At, B0); PG8_MMA(1, 1, At, B1); PG8_BAR; PG8_SCHED;
            PG8_LDB(B0, 1, 0); PG8_LDB(B1, 1, 1); PG8_SCHED; PG8_LDA(At, 1, 0); PG8_STAGE(PG8_SA(0, 1), a2 + hstep, voffA);
            PG8_WAIT_V(8); PG8_WAIT_L(0); PG8_BAR; PG8_MMA(0, 0, At, B0); PG8_MMA(0, 1, At, B1); PG8_BAR; PG8_SCHED;
            PG8_LDA(At, 1, 1); PG8_STAGE(PG8_SB(1, 0), b3, voffB); PG8_STAGE(PG8_SB(1, 1), b3 + hstep, voffB); PG8_STAGE(PG8_SA(1, 0), a3, voffA);
            PG8_WAIT_V(8); PG8_WAIT_L(0); PG8_BAR; PG8_MMA(1, 0, At, B0); PG8_MMA(1, 1, At, B1); PG8_BAR; PG8_SCHED;
            } else {
            PG8_LDB(B0, 0, 0); PG8_SCHED; PG8_LDA(At, 0, 0); PG8_STAGE(PG8_SA(1, 1), a1 + hstep, voffA);
            PG8_WAIT_L(8); PG8_BAR; PG8_WAIT_L(0); PG8_MMA(0, 0, At, B0); PG8_BAR; PG8_SCHED;
            PG8_LDB(B1, 0, 1); PG8_STAGE(PG8_SB(0, 0), b2, voffB);
            PG8_BAR; PG8_WAIT_L(0); PG8_MMA(0, 1, At, B1); PG8_BAR;
            PG8_LDA(At, 0, 1); PG8_STAGE(PG8_SA(0, 0), a2, voffA);
            PG8_BAR; PG8_WAIT_L(0); PG8_MMA(1, 0, At, B0); PG8_BAR; PG8_SCHED;
            PG8_STAGE(PG8_SB(0, 1), b2 + hstep, voffB);
            PG8_WAIT_V(6); PG8_BAR; PG8_MMA(1, 1, At, B1); PG8_BAR;
            PG8_LDB(B0, 1, 0); PG8_SCHED; PG8_LDA(At, 1, 0); PG8_STAGE(PG8_SA(0, 1), a2 + hstep, voffA);
            PG8_WAIT_L(8); PG8_BAR; PG8_WAIT_L(0); PG8_MMA(0, 0, At, B0); PG8_BAR; PG8_SCHED;
            PG8_LDB(B1, 1, 1); PG8_STAGE(PG8_SB(1, 0), b3, voffB);
            PG8_BAR; PG8_WAIT_L(0); PG8_MMA(0, 1, At, B1); PG8_BAR;
            PG8_LDA(At, 1, 1); PG8_STAGE(PG8_SA(1, 0), a3, voffA);
            PG8_BAR; PG8_WAIT_L(0); PG8_MMA(1, 0, At, B0); PG8_BAR; PG8_SCHED;
            PG8_STAGE(PG8_SB(1, 1), b3 + hstep, voffB);
            PG8_WAIT_V(6); PG8_BAR; PG8_MMA(1, 1, At, B1); PG8_BAR;
            }
        }
        if constexpr (ALIGN_EPI) { if (wr == 0) PG8_BAR; }
        if constexpr (!Epi::AFTER_DRAIN) { E(acc, cur, wr, wc, fr, fq); S.done(cur); }
        if (!has_next) break;
#pragma unroll
        for (int a = 0; a < 2; ++a)
#pragma unroll
            for (int b = 0; b < 2; ++b)
#pragma unroll
                for (int m = 0; m < 4; ++m)
#pragma unroll
                    for (int n = 0; n < 2; ++n) acc[a][b][m][n] = (f32x4){0.f, 0.f, 0.f, 0.f};
        cur = nxt; cA = nA; cB = nB; ++ui;
        if constexpr (ALIGN_EPI) { if (wr == 1) PG8_BAR; }
    }
    PG8_WAIT_V(0);
    if constexpr (!ALIGN_EPI) { if (wr == 0) PG8_BAR; }
    PG8_BAR;
    if constexpr (Epi::AFTER_DRAIN) { E.fused(acc, cur, wr, wc, fr, fq, lds, wid, lane); S.done(cur); }
#undef PG8_SA
#undef PG8_SB
#undef PG8_STAGE
#undef PG8_LDA
#undef PG8_LDB
#undef PG8_MMA
#undef PG8_WAIT_V
#undef PG8_WAIT_L
#undef PG8_BAR
#undef PG8_SCHED
}
}
#define GAS __attribute__((address_space(1)))
#define LAS __attribute__((address_space(3)))
typedef unsigned short bf16;
typedef unsigned v4u __attribute__((ext_vector_type(4)));
typedef float f32x4 __attribute__((ext_vector_type(4)));
typedef short bf16x8 __attribute__((ext_vector_type(8)));
typedef GAS unsigned gu32;
typedef GAS unsigned long long gu64;
#define RLX_AGENT __ATOMIC_RELAXED, __HIP_MEMORY_SCOPE_AGENT
#define LDS_WAIT() asm volatile("s_waitcnt lgkmcnt(0)" ::: "memory")
#define VM_WAIT() asm volatile("s_waitcnt vmcnt(0)" ::: "memory")
__device__ __forceinline__ unsigned long long rt() { return __builtin_amdgcn_s_memrealtime(); }
__device__ __forceinline__ unsigned f2bf(float f) { unsigned u = __builtin_bit_cast(unsigned, f); return (u + 0x7fffu + ((u >> 16) & 1u)) >> 16; }
__device__ __forceinline__ unsigned pk2(float lo, float hi) { return f2bf(lo) | (f2bf(hi) << 16); }

__device__ __forceinline__ int fresh_lane() { int l; asm volatile("v_mbcnt_lo_u32_b32 %0, -1, 0\n\tv_mbcnt_hi_u32_b32 %0, -1, %0" : "=v"(l)); return l; }
#define XB_TMO      128
#define XB_XCNT(j)  (256  + 64 * (j))
#define XB_XSUB(j)  (1280 + 64 * (j))
#define XB_XGEN(j)  (2304 + 64 * (j))
#define XB_TOP      3328
#define XB_TOPGEN   3392
#define XCD_BAR_WORDS 3456
#define XB_SPIN_CAP (1u << 18)

__device__ __forceinline__ unsigned xb_ld(unsigned* p)              { return __hip_atomic_load(p, __ATOMIC_RELAXED, __HIP_MEMORY_SCOPE_AGENT); }
__device__ __forceinline__ unsigned xb_add(unsigned* p, unsigned v) { return __hip_atomic_fetch_add(p, v, __ATOMIC_RELAXED, __HIP_MEMORY_SCOPE_AGENT); }
__device__ __forceinline__ unsigned xb_xcc_id() { return (unsigned)__builtin_amdgcn_s_getreg((3 << 11) | 20) & 0xFu; }
#define XB_SPIN(cond, bar) do { unsigned _sp = 0; while (cond) { __builtin_amdgcn_s_sleep(1); \
    if ((++_sp & 255u) == 0u) { if (xb_ld(&(bar)[XB_TMO])) break; if (_sp > XB_SPIN_CAP) { atomicAdd(&(bar)[XB_TMO], 1u); break; } } } } while (0)

struct XcdBarrier {
    unsigned* bar; unsigned x;
    volatile LAS unsigned* st;
};

__device__ __forceinline__ XcdBarrier xcd_barrier_post(unsigned* bar, volatile LAS unsigned* st) {
    XcdBarrier b; b.bar = bar; b.x = xb_xcc_id(); b.st = st;
    if (threadIdx.x == 0) (void)xb_add(&bar[XB_XCNT(b.x)], 1u);
    return b;
}
__device__ __forceinline__ void xcd_barrier_complete(unsigned* bar, unsigned x, unsigned& nloc, unsigned& nx) {
    const unsigned G = gridDim.x * gridDim.y * gridDim.z;
    unsigned sum, cnt, mine, sp = 0u;
    for (;;) {
        sum = 0u; cnt = 0u; mine = 0u;
#pragma unroll
        for (unsigned j = 0; j < 16; ++j) { const unsigned c = xb_ld(&bar[XB_XCNT(j)]); sum += c; cnt += (c > 0u) ? 1u : 0u; mine = (j == x) ? c : mine; }
        if (sum == G) break;
        __builtin_amdgcn_s_sleep(1);
        if ((++sp & 255u) == 0u) { if (xb_ld(&bar[XB_TMO])) break; if (sp > XB_SPIN_CAP) { atomicAdd(&bar[XB_TMO], 1u); break; } }
    }
    nloc = mine > 0u ? mine : 1u; nx = cnt > 0u ? cnt : 1u;
}

__device__ __forceinline__ void xcd_barrier(const XcdBarrier& b, const int wave_s) {
    asm volatile("s_waitcnt vmcnt(0)" ::: "memory");
    __syncthreads();
    if (wave_s == 0 && pg8_fresh_lane() == 0) {
        unsigned* bar = b.bar;
        __builtin_amdgcn_s_waitcnt(0);
        unsigned nloc = b.st[0], nx = b.st[1];
        if (nloc == 0u) { xcd_barrier_complete(bar, b.x, nloc, nx); b.st[0] = nloc; b.st[1] = nx; }
        const unsigned old = xb_add(&bar[XB_XSUB(b.x)], 1u);
        const unsigned gen = old / nloc;
        if (old + 1u == (gen + 1u) * nloc) {
            __builtin_amdgcn_fence(__ATOMIC_RELEASE, "agent");
            asm volatile("s_waitcnt vmcnt(0)" ::: "memory");
            const unsigned og = xb_add(&bar[XB_TOP], 1u);
            const unsigned tg = og / nx;
            if (og + 1u == (tg + 1u) * nx) xb_add(&bar[XB_TOPGEN], 1u);
            else XB_SPIN(xb_ld(&bar[XB_TOPGEN]) == tg, bar);
            __builtin_amdgcn_fence(__ATOMIC_ACQUIRE, "agent");
            xb_add(&bar[XB_XGEN(b.x)], 1u);
            asm volatile("s_waitcnt vmcnt(0)" ::: "memory");
        } else {
            XB_SPIN(xb_ld(&bar[XB_XGEN(b.x)]) == gen, bar);
            __builtin_amdgcn_fence(__ATOMIC_ACQUIRE, "agent");
            asm volatile("s_waitcnt vmcnt(0)" ::: "memory");
        }
    }
    __syncthreads();
}

typedef unsigned short bf16;
typedef float f32x2 __attribute__((ext_vector_type(2)));
typedef float f32x4 __attribute__((ext_vector_type(4)));
typedef float f32x16 __attribute__((ext_vector_type(16)));
typedef short bf16x8 __attribute__((ext_vector_type(8)));
typedef unsigned u32x2 __attribute__((ext_vector_type(2)));
typedef unsigned u32x4 __attribute__((ext_vector_type(4)));

constexpr int NL = 4, D = 2048, SEQ = 4096, NBP = 4, MP = 16384, NBS = 16, TS = 16, MS = 256, M = 16640, PAST = 1024, SKEYS = 1040;
constexpr int NIN = 6288, NINP = 6400, DFF = 5632, NGU = 11264, NMOD = 12288, NCOND = 20, KROWS = 33024;
constexpr int C_QA = 0, C_QI = 512, C_QCN = 1536, C_QCR = 2560, C_KA = 3072, C_VA = 3584, C_BG = 4096, C_CG = 4608, C_XB = 5120, C_LAT = 5632, C_KI = 6144, C_KR = 6208, C_WI = 6272;
__host__ __device__ __forceinline__ int win_il(int d) { return d < 32 ? 2 * d : 2 * (d - 32) + 1; }
__host__ __device__ __forceinline__ int win_row(int n) {
    if (n < 512) return (n & ~63) + win_il(n & 63);
    if (n < 1024) { const int i = n - 512; return C_KA + (i & ~63) + win_il(i & 63); }
    if (n < 1536) return C_VA + (n - 1024);
    if (n < 2560) { const int i = n - 1536; return C_QI + (i & ~63) + win_il(i & 63); }
    if (n < 2624) return C_KI + win_il(n - 2560);
    if (n < 2640) return C_WI + (n - 2624);
    if (n < 3152) return C_BG + (n - 2640);
    if (n < 3664) return C_CG + (n - 3152);
    if (n < 4176) return C_XB + (n - 3664);
    if (n < 5712) { const int i = n - 4176, h = i / 192, o = i - h * 192; return o < 128 ? C_QCN + h * 128 + o : C_QCR + h * 64 + win_il(o - 128); }
    if (n < 6224) return C_LAT + (n - 5712);
    if (n < 6288) return C_KR + win_il(n - 6224);
    return n;
}
constexpr float ALPHA_RES = 1.681792830507429f;
constexpr float LN_EPS = 1e-5f, RMS_EPS = 1e-6f;
constexpr float LOG2E = 1.4426950408889634f;
constexpr float QS_A = 0.125f * LOG2E;
constexpr float QS_C = 0.07216878364870322f * LOG2E;
constexpr float WI_SCALE = 0.25f * 0.125f;

constexpr size_t O_Y = 0, O_PAK = 34078720, O_PAV = 67633152, O_PIK = 101187584, O_PLAT = 105381888, O_PKR = 138936320, O_PCB = 143130624, O_PCF = 143147008,
                 O_SAK = 143327232, O_SAV = 143851520, O_SIK = 144375808, O_SLAT = 144441344, O_SKR = 144965632, O_SCB = 145031168, O_SCF = 145096704, O_END = 145817600;

constexpr size_t MiB = 1u << 20;
constexpr size_t WS_CTL = 0, CTL_ZERO_BYTES = 1 * MiB;
constexpr size_t WS_ROPE = 1 * MiB;
constexpr size_t WS_MOD = 2 * MiB;
constexpr size_t WS_WI = 6 * MiB;
constexpr size_t WS_W = 8 * MiB, W_LAYER = 101 * MiB;
constexpr size_t WO_IN = 0, WO_OUT = 25 * MiB, WO_GU = 33 * MiB, WO_DN = 77 * MiB, WO_UK = 99 * MiB, WO_UV = 100 * MiB;
constexpr size_t WS_H = 412 * MiB;
constexpr size_t WS_T = 477 * MiB;
constexpr size_t WS_MIX = 542 * MiB;
constexpr size_t WS_ACT = 607 * MiB;
constexpr size_t WS_PROJ = 786 * MiB;
constexpr size_t WS_QA = 990 * MiB;
constexpr size_t WS_KA = 1007 * MiB;
constexpr size_t WS_VAT = 1040 * MiB;
constexpr size_t WS_QI = 1073 * MiB;
constexpr size_t WS_KI = 1106 * MiB;
constexpr size_t WS_QC = 1111 * MiB;
constexpr size_t WS_LAT = 1160 * MiB;
constexpr size_t WS_KR = 1193 * MiB;
constexpr size_t WS_KN = 1198 * MiB;
constexpr size_t WS_VCT = 1263 * MiB;
constexpr size_t WS_SEL = 1328 * MiB;
constexpr size_t WS_GU = 786 * MiB;
constexpr size_t WS_SLAB = 1337 * MiB;
constexpr size_t WS_X = 1387 * MiB;
constexpr size_t WS_GH = 1452 * MiB;
constexpr size_t WS_G01 = 1455 * MiB;
constexpr size_t WS_END = 1461 * MiB;
static_assert(WS_GH + (size_t)64 * 2 * DFF * 4 <= WS_G01 && WS_G01 + (size_t)64 * 4 * DFF * 4 <= WS_END, "ws map 6");
constexpr int LDS_HALO = 131072;
constexpr int SP_A = 4, SP_F = 4, SP_H = 4, SP_J = 11;
static_assert(WS_GU + (size_t)M * NGU * 2 <= WS_LAT, "GU overlay must stay clear of buffers that are live later");
static_assert(WS_PROJ + (size_t)M * NINP * 2 <= WS_QA && WS_KA + (size_t)KROWS * 512 * 2 <= WS_VAT && WS_VAT + (size_t)KROWS * 512 * 2 <= WS_QI && WS_QI + (size_t)M * 1024 * 2 <= WS_KI, "ws map 1");
static_assert(WS_KI + (size_t)KROWS * 64 * 2 <= WS_QC && WS_QC + (size_t)M * 1536 * 2 <= WS_LAT && WS_LAT + (size_t)KROWS * 512 * 2 <= WS_KR && WS_KR + (size_t)KROWS * 64 * 2 <= WS_KN, "ws map 2");
static_assert(WS_KN + (size_t)KROWS * 1024 * 2 <= WS_VCT && WS_VCT + (size_t)KROWS * 1024 * 2 <= WS_SEL && WS_SEL + (size_t)M * 512 <= WS_END, "ws map 3");
static_assert(WS_ACT + (size_t)M * DFF * 2 <= WS_PROJ && WS_MIX + (size_t)M * D * 2 <= WS_ACT && WS_T + (size_t)M * D * 2 <= WS_MIX && WS_H + (size_t)M * D * 2 <= WS_T && WS_W + 4 * W_LAYER <= WS_H, "ws map 4");
static_assert(WS_QA + (size_t)M * 512 * 2 <= WS_KA && WS_WI + (size_t)M * 16 * 4 <= WS_W && WS_MOD + (size_t)NL * NCOND * NMOD * 4 <= WS_WI, "ws map 5");

constexpr int CW_TICKET = 1024;
constexpr int CW_BAR = 4096;
constexpr int LDS_RING = 131072, LDS_CTL = 155648, LDS_MISC = LDS_CTL + 320, LDS_BYTES = 163840;

#ifndef MK_REP
#define MK_REP 0u
#endif
__device__ __forceinline__ float bflo(unsigned w) { return __uint_as_float(w << 16); }
__device__ __forceinline__ float bfhi(unsigned w) { return __uint_as_float(w & 0xffff0000u); }
typedef __bf16 bf16x2_t __attribute__((ext_vector_type(2)));
__device__ __forceinline__ unsigned cvtpk(float lo, float hi) { const f32x2 v = {lo, hi}; const bf16x2_t b = __builtin_convertvector(v, bf16x2_t); return __builtin_bit_cast(unsigned, b); }
__device__ __forceinline__ void unpack8(const u32x4 w, float (&f)[8]) { f[0] = bflo(w.x); f[1] = bfhi(w.x); f[2] = bflo(w.y); f[3] = bfhi(w.y); f[4] = bflo(w.z); f[5] = bfhi(w.z); f[6] = bflo(w.w); f[7] = bfhi(w.w); }
__device__ __forceinline__ u32x4 pack8(const float (&f)[8]) { u32x4 w; w.x = cvtpk(f[0], f[1]); w.y = cvtpk(f[2], f[3]); w.z = cvtpk(f[4], f[5]); w.w = cvtpk(f[6], f[7]); return w; }
__device__ __forceinline__ u32x4 ld16(const void* p) { return *(const u32x4*)p; }
__device__ __forceinline__ void st16(void* p, u32x4 v) { *(u32x4*)p = v; }
__device__ __forceinline__ void ld8f(const float* p, float (&f)[8]) { const f32x4 a = *(const f32x4*)p, b = *(const f32x4*)(p + 4); f[0] = a.x; f[1] = a.y; f[2] = a.z; f[3] = a.w; f[4] = b.x; f[5] = b.y; f[6] = b.z; f[7] = b.w; }
__device__ __forceinline__ void st8f(float* p, const float (&f)[8]) { *(f32x4*)p = (f32x4){f[0], f[1], f[2], f[3]}; *(f32x4*)(p + 4) = (f32x4){f[4], f[5], f[6], f[7]}; }
__device__ __forceinline__ void st8f_nt(float* p, const float (&f)[8]) { __builtin_nontemporal_store((f32x4){f[0], f[1], f[2], f[3]}, (f32x4*)p); __builtin_nontemporal_store((f32x4){f[4], f[5], f[6], f[7]}, (f32x4*)(p + 4)); }
__device__ __forceinline__ void ld8f_nt(const float* p, float (&f)[8]) { const f32x4 a = __builtin_nontemporal_load((const f32x4*)p), b = __builtin_nontemporal_load((const f32x4*)(p + 4)); f[0] = a.x; f[1] = a.y; f[2] = a.z; f[3] = a.w; f[4] = b.x; f[5] = b.y; f[6] = b.z; f[7] = b.w; }
__device__ __forceinline__ u32x4 shx4(u32x4 w, int m) { u32x4 o; o.x = __shfl_xor(w.x, m); o.y = __shfl_xor(w.y, m); o.z = __shfl_xor(w.z, m); o.w = __shfl_xor(w.w, m); return o; }
__device__ __forceinline__ float wave_sum(float v) {
#pragma unroll
    for (int o = 1; o < 64; o <<= 1) v += __shfl_xor(v, o);
    return v;
}
__device__ __forceinline__ float wave_max(float v) {
#pragma unroll
    for (int o = 1; o < 64; o <<= 1) v = fmaxf(v, __shfl_xor(v, o));
    return v;
}
__device__ __forceinline__ int cond_idx(int r) { return r < MP ? (r >> 12) : 4 + ((r - MP) >> 4); }
template <int P> __device__ __forceinline__ void slab_ld8(const float* S, int N, int rs, int col, float (&f)[8]) {
    ld8f(S + (size_t)rs * N + col, f);
#pragma unroll
    for (int p = 1; p < P; ++p) { float t[8]; ld8f(S + ((size_t)p * 256 + rs) * N + col, t);
#pragma unroll
        for (int i = 0; i < 8; ++i) f[i] += t[i]; }
}
#define LDS_WAIT() asm volatile("s_waitcnt lgkmcnt(0)" ::: "memory")

struct Args { const float* in[26]; float* out; unsigned char* ws; int ph_lo, ph_hi; };
static_assert(sizeof(Args) == 26 * 8 + 8 + 8 + 8, "Args has no padding");

template <int MODE = 0  > __device__ __forceinline__ void p0_transpose_item(const float* W, int K, int N, int nblk, bf16* WT, LAS float* scr, int item, int lane) {
    const int kb = item / nblk, nb = item % nblk, k0 = 64 * kb, n0 = 32 * nb;
    constexpr bool GU = MODE == 1;
    const int r0 = GU ? ((n0 < DFF) ? 256 * (n0 / 128) + n0 % 128 : 256 * ((n0 - DFF) / 128) + 128 + (n0 - DFF) % 128) : n0;
    const int k8 = lane >> 3, n4 = lane & 7; const bool ok = n0 + 4 * n4 < N;
    f32x4 wv[8];
#pragma unroll
    for (int i = 0; i < 8; ++i) wv[i] = ok ? __builtin_nontemporal_load((const f32x4*)(W + (size_t)(k0 + 8 * i + k8) * N + n0 + 4 * n4)) : (f32x4){0.f, 0.f, 0.f, 0.f};
#pragma unroll
    for (int i = 0; i < 8; ++i) { LAS float* d = scr + (8 * i + k8) * 33 + 4 * n4; d[0] = wv[i].x; d[1] = wv[i].y; d[2] = wv[i].z; d[3] = wv[i].w; }
    LDS_WAIT(); asm volatile("" ::: "memory");
    const int c = lane & 7;
#pragma unroll
    for (int j = 0; j < 4; ++j) { const int nn = (lane >> 3) + 8 * j; const LAS float* s = scr + (8 * c) * 33 + nn;
        u32x4 o; o.x = cvtpk(s[0 * 33], s[1 * 33]); o.y = cvtpk(s[2 * 33], s[3 * 33]); o.z = cvtpk(s[4 * 33], s[5 * 33]); o.w = cvtpk(s[6 * 33], s[7 * 33]);
        const int rowd = (MODE == 2) ? win_row(n0 + nn) : r0 + nn;
        *(u32x4*)(WT + (size_t)rowd * K + k0 + 8 * c) = o; }
    LDS_WAIT(); asm volatile("" ::: "memory");
}

struct TItem { const float* W; bf16* WT; int K, N, nblk, mode, r; };
__device__ __forceinline__ void p0_tload(const TItem& t, int lane, f32x4 (&wv)[8]) {
    const int kb = t.r / t.nblk, nb = t.r - kb * t.nblk, k0 = 64 * kb, n0 = 32 * nb, k8 = lane >> 3, n4 = lane & 7;
    const int col = (n0 + 4 * n4 < t.N) ? n0 + 4 * n4 : 0;
#pragma unroll
    for (int i = 0; i < 8; ++i) wv[i] = __builtin_nontemporal_load((const f32x4*)(t.W + (size_t)(k0 + 8 * i + k8) * t.N + col));
}
__device__ __forceinline__ void p0_tstore(const TItem& t, int lane, const f32x4 (&wv)[8], LAS float* scr) {
    const int kb = t.r / t.nblk, nb = t.r - kb * t.nblk, k0 = 64 * kb, n0 = 32 * nb, k8 = lane >> 3, n4 = lane & 7; const bool ok = n0 + 4 * n4 < t.N;
    const int r0 = (t.mode == 1) ? ((n0 < DFF) ? 256 * (n0 / 128) + n0 % 128 : 256 * ((n0 - DFF) / 128) + 128 + (n0 - DFF) % 128) : n0;
#pragma unroll
    for (int i = 0; i < 8; ++i) { LAS float* d = scr + (8 * i + k8) * 33 + 4 * n4; d[0] = ok ? wv[i].x : 0.f; d[1] = ok ? wv[i].y : 0.f; d[2] = ok ? wv[i].z : 0.f; d[3] = ok ? wv[i].w : 0.f; }
    LDS_WAIT(); asm volatile("" ::: "memory");
    const int c = lane & 7;
#pragma unroll
    for (int j = 0; j < 4; ++j) { const int nn = (lane >> 3) + 8 * j; const LAS float* s = scr + (8 * c) * 33 + nn;
        u32x4 o; o.x = cvtpk(s[0 * 33], s[1 * 33]); o.y = cvtpk(s[2 * 33], s[3 * 33]); o.z = cvtpk(s[4 * 33], s[5 * 33]); o.w = cvtpk(s[6 * 33], s[7 * 33]);
        const int rowd = (t.mode == 2) ? win_row(n0 + nn) : r0 + nn;
        *(u32x4*)(t.WT + (size_t)rowd * t.K + k0 + 8 * c) = o; }
    LDS_WAIT(); asm volatile("" ::: "memory");
}
__device__ __forceinline__ TItem p0_decode(const Args& a, int it) {
    constexpr int I_IN = 32 * 200, I_OUT = 32 * 64, I_GU = 32 * 352, I_DN = 88 * 64, I_UK = 8 * 32, I_UV = 8 * 32, I_L = I_IN + I_OUT + I_GU + I_DN + I_UK + I_UV;
    const int l = it / I_L; int r = it - l * I_L; unsigned char* wl = a.ws + WS_W + (size_t)l * W_LAYER;
    if (r < I_IN) return TItem{a.in[11] + (size_t)l * D * NIN, (bf16*)(wl + WO_IN), D, NIN, 200, 2, r}; r -= I_IN;
    if (r < I_OUT) return TItem{a.in[12] + (size_t)l * D * D, (bf16*)(wl + WO_OUT), D, D, 64, 0, r}; r -= I_OUT;
    if (r < I_GU) return TItem{a.in[23] + (size_t)l * D * NGU, (bf16*)(wl + WO_GU), D, NGU, 352, 1, r}; r -= I_GU;
    if (r < I_DN) return TItem{a.in[25] + (size_t)l * DFF * D, (bf16*)(wl + WO_DN), DFF, D, 64, 0, r}; r -= I_DN;
    if (r < I_UK) return TItem{a.in[15] + (size_t)l * 512 * 1024, (bf16*)(wl + WO_UK), 512, 1024, 32, 0, r}; r -= I_UK;
    return TItem{a.in[16] + (size_t)l * 512 * 1024, (bf16*)(wl + WO_UV), 512, 1024, 32, 0, r};
}

__device__ __forceinline__ void p0a_prologue(const Args& a, LAS unsigned char* lds, int tid, int lane, int wave, int vcu, int G) {
    unsigned char* ws = a.ws;
    {
        f32x2* rope = (f32x2*)(ws + WS_ROPE);
        for (int e = (vcu * 8 + wave) * 64 + lane; e < 4096 * 32; e += G * 512) {
            const int pos = e >> 5, i = e & 31;
            double inv = 1.0; for (int q = 0; q < i; ++q) inv *= 0.74989420933245582730;
            const float ang = (float)pos * (float)inv;
            double x = (double)ang * 0.15915494309189533577; x -= __builtin_rint(x);
            const float xf = (float)x;
            rope[e] = (f32x2){__builtin_amdgcn_cosf(xf), __builtin_amdgcn_sinf(xf)};
        }
    }
    {
        LAS float* tab = (LAS float*)lds;
        LAS float* red = (LAS float*)(lds + 81920);
        LAS float* part = (LAS float*)(lds + 122880);
        float* MOD = (float*)(ws + WS_MOD);
        const int nq = (vcu < 768) ? (768 - vcu + G - 1) / G : 0, g = lane >> 4, c4 = (lane & 15) * 4;
        for (int qb = 0; qb < nq; qb += 3) {
            for (int half = 0; half < 2; ++half) {
                __syncthreads();
                for (int e = tid; e < 20 * 1024; e += 512) { const int m = e >> 10, k = (e & 1023) + half * 1024;
                    const float c = (m < 4) ? a.in[2][m * D + k] : a.in[3][(m - 4) * D + k]; tab[e] = c / (1.f + __expf(-c)); }
                __syncthreads();
                for (int qi = 0; qi < 3 && qb + qi < nq; ++qi) {
                    const int it = vcu + (qb + qi) * G, l = it / 192, strip = it % 192, k0 = wave * 128;
                    const __amdgpu_buffer_rsrc_t rw = __builtin_amdgcn_make_buffer_rsrc((void*)(a.in[17] + (size_t)l * D * NMOD + (size_t)(half * 1024 + k0) * NMOD + strip * 64), 0, 0x7fffffff, 0x00020000);
                    const int wvo = (8 * g * NMOD + c4) * 4;
                    f32x4 acc[20];
#pragma unroll
                    for (int m = 0; m < 20; ++m) acc[m] = (f32x4){0.f, 0.f, 0.f, 0.f};
                    u32x4 wa[8], wb[8];
#define P0_WLD(dst, step) do { _Pragma("unroll") for (int i = 0; i < 8; ++i) dst[i] = __builtin_amdgcn_raw_buffer_load_b128(rw, wvo, ((step) * 32 + i) * (NMOD * 4), 0); } while (0)
#define P0_WF(v) ((f32x4){__uint_as_float((v).x), __uint_as_float((v).y), __uint_as_float((v).z), __uint_as_float((v).w)})
#define P0_WFMA(src, step) do { _Pragma("unroll") for (int m = 0; m < 20; ++m) { const LAS float* tp = tab + m * 1024 + k0 + (step) * 32 + 8 * g; const f32x4 t0 = *(const LAS f32x4*)tp, t1 = *(const LAS f32x4*)(tp + 4); \
                            acc[m] += t0.x * P0_WF(src[0]) + t0.y * P0_WF(src[1]) + t0.z * P0_WF(src[2]) + t0.w * P0_WF(src[3]) + t1.x * P0_WF(src[4]) + t1.y * P0_WF(src[5]) + t1.z * P0_WF(src[6]) + t1.w * P0_WF(src[7]); } } while (0)
                    P0_WLD(wa, 0);
#pragma unroll 1
                    for (int st = 0; st < 4; st += 2) {
                        P0_WLD(wb, st + 1);
                        P0_WFMA(wa, st);
                        P0_WLD(wa, (st + 2 < 4 ? st + 2 : st));
                        P0_WFMA(wb, st + 1);
                    }
#undef P0_WLD
#undef P0_WF
#undef P0_WFMA
#pragma unroll
                    for (int m = 0; m < 20; ++m) {
#pragma unroll
                        for (int e = 0; e < 4; ++e) { float v = acc[m][e]; v += __shfl_xor(v, 16); v += __shfl_xor(v, 32); acc[m][e] = v; }
                        if (g == 0) *(LAS f32x4*)(red + (wave * 20 + m) * 64 + c4) = acc[m]; }
                    __syncthreads();
                    for (int e = tid; e < 20 * 64; e += 512) { const int m = e >> 6, ln = e & 63; float sum = 0.f;
#pragma unroll
                        for (int w8 = 0; w8 < 8; ++w8) sum += red[(w8 * 20 + m) * 64 + ln];
                        if (half == 0) part[qi * 1280 + e] = sum;
                        else MOD[((size_t)l * NCOND + m) * NMOD + strip * 64 + ln] = sum + part[qi * 1280 + e] + a.in[18][(size_t)l * NMOD + strip * 64 + ln]; }
                    __syncthreads();
                }
            }
        }
        __syncthreads();
    }
    {
        LAS float* scr = (LAS float*)(lds + wave * 16384);
        const int gw = vcu * 8 + wave, NGW = G * 8;
        constexpr int I_TOT = NL * (32 * 200 + 32 * 64 + 32 * 352 + 88 * 64 + 8 * 32 + 8 * 32);
        if (gw < I_TOT) {
            f32x4 wa[8], wb[8];
            p0_tload(p0_decode(a, gw), lane, wa);
            for (int it = gw; it < I_TOT; it += 2 * NGW) {
                const int i1 = it + NGW, i2 = it + 2 * NGW; const bool h1 = i1 < I_TOT;
                const TItem t0 = p0_decode(a, it), t1 = p0_decode(a, h1 ? i1 : it), t2 = p0_decode(a, i2 < I_TOT ? i2 : it);
                p0_tload(t1, lane, wb);
                p0_tstore(t0, lane, wa, scr);
                p0_tload(t2, lane, wa);
                if (h1) p0_tstore(t1, lane, wb, scr);
            }
        }
    }
}

__device__ __forceinline__ void modulate_row(const float* xrow, const float* sc, const float* sh, bf16* hrow, bf16* xbrow, int lane) {
#pragma unroll
    for (int j = 0; j < 8; ++j) { const int col = 4 * lane + 256 * j;
        const f32x4 x = __builtin_nontemporal_load((const f32x4*)(xrow + col)), s = *(const f32x4*)(sc + col), h = *(const f32x4*)(sh + col);
        const f32x4 o = x * (1.f + s) + h; u32x2 w; w.x = cvtpk(o.x, o.y); w.y = cvtpk(o.z, o.w); *(u32x2*)(hrow + col) = w;
        u32x2 xw; xw.x = cvtpk(x.x, x.y); xw.y = cvtpk(x.z, x.w); *(u32x2*)(xbrow + col) = xw; }
}
__device__ __forceinline__ void p0b_h0(const Args& a, int lane, int gw, int NGW) {
    const float* MOD = (const float*)(a.ws + WS_MOD); bf16* H = (bf16*)(a.ws + WS_H); bf16* XB = (bf16*)(a.ws + WS_X);
    for (int r = gw; r < M; r += NGW) {
        const float* xrow = r < MP ? a.in[0] + (size_t)r * D : a.in[1] + (size_t)(r - MP) * D;
        const float* mod = MOD + (size_t)cond_idx(r) * NMOD;
        modulate_row(xrow, mod + D, mod, H + (size_t)r * D, XB + (size_t)r * D, lane);
    }
}

__device__ __forceinline__ void rope8(const float (&own)[8], const float (&oth)[8], const float (&cs)[16], float sgn, float (&o)[8]) {
#pragma unroll
    for (int i = 0; i < 8; ++i) o[i] = own[i] * cs[2 * i] + sgn * (oth[i] * cs[2 * i + 1]);
}

__device__ __forceinline__ void shf8(const float (&x)[8], float (&y)[8]) {
#pragma unroll
    for (int i = 0; i < 8; ++i) y[i] = __shfl_xor(x[i], 4);
}
__device__ __forceinline__ void pb_token_row(const Args& a, int l, int r, int lane, unsigned parts) {
    unsigned char* ws = a.ws;
    const bf16* P = (const bf16*)(ws + WS_PROJ) + (size_t)r * NINP;
    const float* SA = (const float*)(ws + WS_SLAB);
    const bool smp = r >= MP; const int rs = r - MP;
    int b, t, pos, krow, T;
    if (!smp) { b = r >> 12; t = r & 4095; pos = t; krow = r; T = SEQ; }
    else { b = rs >> 4; t = rs & 15; pos = PAST + t; krow = MP + b * SKEYS + PAST + t; T = TS; }
    u32x4 L[18];
    if (!smp) { const bf16* P1 = (t >= 1) ? P - NINP : P; const bf16* P2 = (t >= 2) ? P - 2 * NINP : P;
        L[6] = ld16(P + C_BG + 8 * lane); L[7] = ld16(P + C_CG + 8 * lane); L[8] = ld16(P + C_XB + 8 * lane);
        L[9] = ld16(P1 + C_CG + 8 * lane); L[10] = ld16(P1 + C_XB + 8 * lane); L[11] = ld16(P2 + C_CG + 8 * lane); L[12] = ld16(P2 + C_XB + 8 * lane);
        L[16] = ld16(P + C_LAT + 8 * lane); }
#define PB_LD8(k, dr, col, dst) do { if (!smp) unpack8(L[k], dst); else slab_ld8<SP_A>(SA, NINP, rs + (dr), (col), dst); } while (0)
    float* out = a.out;
    const size_t orow = smp ? (size_t)l * MS + rs : (size_t)l * MP + r;
    float x[8], y[8], z[8];
    const int i0 = 4 * (lane & 7);
    float cq[8]; ld8f((const float*)(ws + WS_ROPE) + ((size_t)pos * 32 + i0) * 2, cq);
#define PB_QROPE(scale, lo, hi) do { _Pragma("unroll") for (int k = 0; k < 4; ++k) { lo[k] = (x[2 * k] * cq[2 * k] - x[2 * k + 1] * cq[2 * k + 1]) * (scale); hi[k] = (x[2 * k] * cq[2 * k + 1] + x[2 * k + 1] * cq[2 * k]) * (scale); } } while (0)
#define PB_ST4(ptr, v) do { u32x2 w_; w_.x = cvtpk(v[0], v[1]); w_.y = cvtpk(v[2], v[3]); *(u32x2*)(ptr) = w_; } while (0)
    if (parts & 1u) { float lo[4], hi4[4]; PB_LD8(0, 0, C_QA + 8 * lane, x); PB_QROPE(QS_A, lo, hi4);
      bf16* qd = (bf16*)(ws + WS_QA) + (size_t)r * 512 + (lane >> 3) * 64 + i0; PB_ST4(qd, lo); PB_ST4(qd + 32, hi4); }
    if (parts & 2u) { float lo[4], hi4[4]; PB_LD8(1, 0, C_KA + 8 * lane, x); PB_QROPE(1.f, lo, hi4);
      float* od = out + O_SAK + orow * 512 + (lane >> 3) * 64 + i0; *(f32x4*)od = (f32x4){lo[0], lo[1], lo[2], lo[3]}; *(f32x4*)(od + 32) = (f32x4){hi4[0], hi4[1], hi4[2], hi4[3]};
      bf16* kd = (bf16*)(ws + WS_KA) + (size_t)krow * 512 + (lane >> 3) * 64 + i0; PB_ST4(kd, lo); PB_ST4(kd + 32, hi4); }
    if (parts & 4u) { PB_LD8(2, 0, C_VA + 8 * lane, x); st8f_nt(out + (smp ? O_SAV : O_PAV) + orow * 512 + 8 * lane, x); }
    if (parts & 8u)
#pragma unroll
    for (int s = 0; s < 2; ++s) { float lo[4], hi4[4]; PB_LD8(3 + s, 0, C_QI + 512 * s + 8 * lane, x); PB_QROPE(1.f, lo, hi4);
      bf16* qd = (bf16*)(ws + WS_QI) + (size_t)r * 1024 + 512 * s + (lane >> 3) * 64 + i0; PB_ST4(qd, lo); PB_ST4(qd + 32, hi4); }
    if (parts & 16u) {
      if (lane < 8) { float lo[4], hi4[4]; PB_LD8(5, 0, C_KI + 8 * lane, x); PB_QROPE(1.f, lo, hi4);
          float* od = out + O_SIK + orow * 64 + i0; *(f32x4*)od = (f32x4){lo[0], lo[1], lo[2], lo[3]}; *(f32x4*)(od + 32) = (f32x4){hi4[0], hi4[1], hi4[2], hi4[3]};
          bf16* kd = (bf16*)(ws + WS_KI) + (size_t)krow * 64 + i0; PB_ST4(kd, lo); PB_ST4(kd + 32, hi4); }
      else if (lane < 10) { PB_LD8(5, 0, C_WI + 8 * (lane - 8), x);
#pragma unroll
          for (int i = 0; i < 8; ++i) z[i] = x[i] * WI_SCALE;
          st8f((float*)(ws + WS_WI) + (size_t)r * 16 + 8 * (lane - 8), z); } }
    if (parts & 32u) { const int c = 8 * lane; float bgv[8], u0[8], u1[8], u2[8], w0[8], w1[8], w2[8];
      PB_LD8(6, 0, C_BG + c, bgv); PB_LD8(7, 0, C_CG + c, x); PB_LD8(8, 0, C_XB + c, y);
#pragma unroll
      for (int i = 0; i < 8; ++i) u0[i] = x[i] * y[i];
      const float* st = a.in[9] + ((size_t)(l * NBS + b) * 2) * 512 + c;
      if (t >= 1) { PB_LD8(9, -1, C_CG + c, x); PB_LD8(10, -1, C_XB + c, y);
#pragma unroll
          for (int i = 0; i < 8; ++i) u1[i] = x[i] * y[i]; }
      else if (smp) ld8f(st + 512, u1);
      else {
#pragma unroll
          for (int i = 0; i < 8; ++i) u1[i] = 0.f; }
      if (t >= 2) { PB_LD8(11, -2, C_CG + c, x); PB_LD8(12, -2, C_XB + c, y);
#pragma unroll
          for (int i = 0; i < 8; ++i) u2[i] = x[i] * y[i]; }
      else if (smp) ld8f(st + (size_t)t * 512, u2);
      else {
#pragma unroll
          for (int i = 0; i < 8; ++i) u2[i] = 0.f; }
      const float* cw = a.in[13] + (size_t)l * 3 * 512 + c; ld8f(cw, w0); ld8f(cw + 512, w1); ld8f(cw + 1024, w2);
#pragma unroll
      for (int i = 0; i < 8; ++i) z[i] = bgv[i] * (u2[i] * w0[i] + u1[i] * w1[i] + u0[i] * w2[i]);
      st16((bf16*)(ws + WS_MIX) + (size_t)r * D + 512 + c, pack8(z));
      if (t >= T - 2) { float* so = out + (smp ? O_SCB + ((size_t)(l * NBS + b) * 2 + (t - (T - 2))) * 512 : O_PCB + ((size_t)(l * NBP + b) * 2 + (t - (T - 2))) * 512) + c; st8f_nt(so, u0); } }
    if (parts & 64u) {
#pragma unroll
      for (int s = 0; s < 2; ++s) { const int pc = 512 * s + 8 * lane; PB_LD8(13 + s, 0, C_QCN + pc, x);
#pragma unroll
        for (int i = 0; i < 8; ++i) z[i] = x[i] * QS_C;
        st16((bf16*)(ws + WS_QC) + (size_t)r * 1536 + (pc >> 7) * 192 + (pc & 127), pack8(z)); }
      { float lo[4], hi4[4]; PB_LD8(15, 0, C_QCR + 8 * lane, x); PB_QROPE(QS_C, lo, hi4);
        bf16* qd = (bf16*)(ws + WS_QC) + (size_t)r * 1536 + (lane >> 3) * 192 + 128 + i0; PB_ST4(qd, lo); PB_ST4(qd + 32, hi4); } }
    if (parts & 128u) { PB_LD8(16, 0, C_LAT + 8 * lane, x); float ss = 0.f;
#pragma unroll
      for (int i = 0; i < 8; ++i) ss += x[i] * x[i];
      ss = wave_sum(ss); const float rsq = 1.0f / sqrtf(ss * (1.f / 512.f) + RMS_EPS);
      ld8f(a.in[14] + (size_t)l * 512 + 8 * lane, y);
#pragma unroll
      for (int i = 0; i < 8; ++i) z[i] = x[i] * rsq * y[i];
      st8f_nt(out + (smp ? O_SLAT : O_PLAT) + orow * 512 + 8 * lane, z);
      st16((bf16*)(ws + WS_LAT) + (size_t)krow * 512 + 8 * lane, pack8(z)); }
    if (parts & 256u) {
      if (lane < 8) { float lo[4], hi4[4]; PB_LD8(17, 0, C_KR + 8 * lane, x); PB_QROPE(1.f, lo, hi4);
          float* od = out + O_SKR + orow * 64 + i0; *(f32x4*)od = (f32x4){lo[0], lo[1], lo[2], lo[3]}; *(f32x4*)(od + 32) = (f32x4){hi4[0], hi4[1], hi4[2], hi4[3]};
          bf16* kd = (bf16*)(ws + WS_KR) + (size_t)krow * 64 + i0; PB_ST4(kd, lo); PB_ST4(kd + 32, hi4); } }
#undef PB_LD8
#undef PB_QROPE
#undef PB_ST4
}

__device__ __forceinline__ void pb_cache_row(const Args& a, int l, int cr, int lane) {
    unsigned char* ws = a.ws; const int b = cr >> 10, s = cr & 1023; const size_t krow = (size_t)MP + b * SKEYS + s; const size_t src = (size_t)(l * NBS + b) * PAST + s;
    float x[8];
    ld8f_nt(a.in[4] + src * 512 + 8 * lane, x); st16((bf16*)(ws + WS_KA) + krow * 512 + 8 * lane, pack8(x));
    ld8f_nt(a.in[7] + src * 512 + 8 * lane, x); st16((bf16*)(ws + WS_LAT) + krow * 512 + 8 * lane, pack8(x));
    if (lane < 8) { ld8f_nt(a.in[6] + src * 64 + 8 * lane, x); st16((bf16*)(ws + WS_KI) + krow * 64 + 8 * lane, pack8(x)); }
    else if (lane < 16) { ld8f_nt(a.in[8] + src * 64 + 8 * (lane - 8), x); st16((bf16*)(ws + WS_KR) + krow * 64 + 8 * (lane - 8), pack8(x)); }
}

__device__ __forceinline__ void pb_vat_prompt(const Args& a, int job, int lane) {
    unsigned char* ws = a.ws; const int rb = job >> 3, h = job & 7; const int krow0 = rb * 64, colv = h * 64 + lane;
    const bf16* src = (const bf16*)(ws + WS_PROJ) + (size_t)krow0 * NINP + C_VA + colv;
    unsigned pk[32];
#pragma unroll
    for (int i2 = 0; i2 < 32; ++i2) pk[i2] = (unsigned)src[(size_t)(2 * i2) * NINP] | ((unsigned)src[(size_t)(2 * i2 + 1) * NINP] << 16);
    bf16* dst = (bf16*)(ws + WS_VAT) + (size_t)colv * KROWS + krow0;
#pragma unroll
    for (int q = 0; q < 8; ++q) st16(dst + 8 * q, (u32x4){pk[4 * q], pk[4 * q + 1], pk[4 * q + 2], pk[4 * q + 3]});
}
__device__ __forceinline__ void pb_vat_cache(const Args& a, int l, int job, int lane) {
    unsigned char* ws = a.ws; const int b = job >> 7, j = (job >> 3) & 15, h = job & 7, colv = h * 64 + lane;
    const float* src = a.in[5] + ((size_t)(l * NBS + b) * PAST + 64 * j) * 512 + colv;
    unsigned pk[32];
#pragma unroll
    for (int i2 = 0; i2 < 32; ++i2) pk[i2] = cvtpk(__builtin_nontemporal_load(src + (size_t)(2 * i2) * 512), __builtin_nontemporal_load(src + (size_t)(2 * i2 + 1) * 512));
    bf16* dst = (bf16*)(ws + WS_VAT) + (size_t)colv * KROWS + MP + b * SKEYS + 64 * j;
#pragma unroll
    for (int q = 0; q < 8; ++q) st16(dst + 8 * q, (u32x4){pk[4 * q], pk[4 * q + 1], pk[4 * q + 2], pk[4 * q + 3]});
}
__device__ __forceinline__ void pb_vat_new(const Args& a, int job, int lane) {
    unsigned char* ws = a.ws; const int b = job >> 3, h = job & 7, colv = h * 64 + lane;
    const float* sp = (const float*)(ws + WS_SLAB) + (size_t)(b * TS) * NINP + C_VA + colv;
    unsigned pk[8];
#pragma unroll
    for (int i2 = 0; i2 < 8; ++i2) { float v[2];
#pragma unroll
        for (int e = 0; e < 2; ++e) { const float* q = sp + (size_t)(2 * i2 + e) * NINP; float acc = q[0];
#pragma unroll
            for (int pp = 1; pp < SP_A; ++pp) acc += q[(size_t)pp * 256 * NINP];
            v[e] = acc; }
        pk[i2] = cvtpk(v[0], v[1]); }
    bf16* dst = (bf16*)(ws + WS_VAT) + (size_t)colv * KROWS + MP + b * SKEYS + PAST;
    st16(dst, (u32x4){pk[0], pk[1], pk[2], pk[3]}); st16(dst + 8, (u32x4){pk[4], pk[5], pk[6], pk[7]});
}

constexpr int PD_KEYS = 0, PD_TILE = 131072, PD_HIST = 147456;

__device__ __forceinline__ void radix_scan(const LAS unsigned* hist, unsigned need, int lane, unsigned& Tout, unsigned& above_out) {
    const u32x4 v = *(const LAS u32x4*)(hist + 4 * lane);
    const unsigned s = v.x + v.y + v.z + v.w;
    unsigned suf = s;
#pragma unroll
    for (int o = 1; o < 64; o <<= 1) { const unsigned t = __shfl_down(suf, o); suf += (lane + o < 64) ? t : 0u; }
    const unsigned above = suf - s;
    const bool hit = (above < need) && (above + s >= need);
    const unsigned long long bm = __ballot(hit);
    const int L = bm ? (int)__builtin_ctzll(bm) : 0;
    unsigned c = above, Tl, Al;
    if (c + v.w >= need) { Tl = 3u; Al = c; }
    else { c += v.w; if (c + v.z >= need) { Tl = 2u; Al = c; } else { c += v.z; if (c + v.y >= need) { Tl = 1u; Al = c; } else { c += v.y; Tl = 0u; Al = c; } } }
    Tout = (unsigned)__builtin_amdgcn_readlane((int)Tl, L) + 4u * (unsigned)L;
    above_out = (unsigned)__builtin_amdgcn_readlane((int)Al, L);
}

__device__ __forceinline__ void radix_scan3(const LAS unsigned* hist, unsigned need, int lane, unsigned& Tout, unsigned& above_out, unsigned& cnt_out) {
    const u32x4 v = *(const LAS u32x4*)(hist + 4 * lane);
    const unsigned s = v.x + v.y + v.z + v.w;
    unsigned suf = s;
#pragma unroll
    for (int o = 1; o < 64; o <<= 1) { const unsigned t = __shfl_down(suf, o); suf += (lane + o < 64) ? t : 0u; }
    const unsigned above = suf - s;
    const bool hit = (above < need) && (above + s >= need);
    const unsigned long long bm = __ballot(hit);
    const int L = bm ? (int)__builtin_ctzll(bm) : 0;
    unsigned c = above, Tl, Al, Cl;
    if (c + v.w >= need) { Tl = 3u; Al = c; Cl = v.w; }
    else { c += v.w; if (c + v.z >= need) { Tl = 2u; Al = c; Cl = v.z; } else { c += v.z; if (c + v.y >= need) { Tl = 1u; Al = c; Cl = v.y; } else { c += v.y; Tl = 0u; Al = c; Cl = v.x; } } }
    Tout = (unsigned)__builtin_amdgcn_readlane((int)Tl, L) + 4u * (unsigned)L;
    above_out = (unsigned)__builtin_amdgcn_readlane((int)Al, L);
    cnt_out = (unsigned)__builtin_amdgcn_readlane((int)Cl, L);
}

__device__ __forceinline__ float relu1(float x) { const int b = __float_as_int(x); return __int_as_float(b > 0 ? b : 0); }
__device__ __forceinline__ void pd_group(const Args& a, LAS unsigned char* lds, int q0, int tid) {
    unsigned char* ws = a.ws;
    const int lane = tid & 63, wid = __builtin_amdgcn_readfirstlane(tid >> 6);
    const int q = q0 + wid;
    unsigned long long* SEL = (unsigned long long*)(ws + WS_SEL) + (size_t)q * 64;
    int nsteps, nvalid; size_t krow0;
    if (q0 < MP) { const int t = q0 & 4095; nsteps = (t >> 6) + 1; nvalid = nsteps * 64; krow0 = (size_t)(q0 & ~4095); }
    else { const int b = (q0 - MP) >> 4; nsteps = 17; nvalid = SKEYS; krow0 = (size_t)MP + (size_t)b * SKEYS; }
    if (nsteps <= 4) { SEL[lane] = (lane < nsteps) ? ~0ull : 0ull; return; }
    const int kc = lane & 15, g = lane >> 4;
    bf16x8 af[2];
    { const bf16* qp = (const bf16*)(ws + WS_QI) + (size_t)q * 1024 + kc * 64 + 8 * g; af[0] = *(const bf16x8*)qp; af[1] = *(const bf16x8*)(qp + 32); }
    const f32x4 wv = *(const f32x4*)((const float*)(ws + WS_WI) + (size_t)q * 16 + 4 * g);
    LAS unsigned* keys = (LAS unsigned*)(lds + PD_KEYS + wid * 16384);
    LAS unsigned* hist = (LAS unsigned*)(lds + PD_HIST + wid * 1024);
    const bf16* ksrc = (const bf16*)(ws + WS_KI) + (krow0 + (tid >> 3)) * 64 + 8 * (tid & 7);
    const int sdst = PD_TILE + (tid >> 3) * 128 + (((tid & 7) ^ ((tid >> 4) & 7)) * 16);
    const int sw = (kc >> 1) & 7;
    const int boff0 = PD_TILE + kc * 128 + ((g ^ sw) * 16), boff1 = PD_TILE + kc * 128 + (((4 + g) ^ sw) * 16);
    constexpr int PFD = 8;
    u32x4 pf[PFD];
    for (int rr_ = 0; rr_ < 1 + (int)((MK_REP >> 16) & 1u); ++rr_) {
    __syncthreads();
    *(LAS u32x4*)(hist + 4 * lane) = (u32x4){0u, 0u, 0u, 0u};
    { const u32x4 t0 = ld16(ksrc);
#pragma unroll
      for (int i = 0; i < PFD; ++i) { const int ls = (1 + i < nsteps) ? 1 + i : nsteps - 1; pf[i] = ld16(ksrc + (size_t)ls * 4096); }
      *(LAS u32x4*)(lds + sdst) = t0; }
    __syncthreads();
    for (int st0 = 0; st0 < nsteps; st0 += PFD) {
#pragma unroll
      for (int j = 0; j < PFD; ++j) {
        const int st = st0 + j;
        if (st < nsteps) {
        const LAS unsigned char* tb = lds + (st & 1) * 8192;
        float pg[4];
        {
            bf16x8 bq[8];
#pragma unroll
            for (int grp = 0; grp < 4; ++grp) { bq[2 * grp] = *(const LAS bf16x8*)(tb + boff0 + grp * 2048); bq[2 * grp + 1] = *(const LAS bf16x8*)(tb + boff1 + grp * 2048); }
            __builtin_amdgcn_sched_barrier(0);
            f32x4 acc[4];
#pragma unroll
            for (int grp = 0; grp < 4; ++grp) acc[grp] = __builtin_amdgcn_mfma_f32_16x16x32_bf16(af[0], bq[2 * grp], (f32x4){0.f, 0.f, 0.f, 0.f}, 0, 0, 0);
#pragma unroll
            for (int grp = 0; grp < 4; ++grp) acc[grp] = __builtin_amdgcn_mfma_f32_16x16x32_bf16(af[1], bq[2 * grp + 1], acc[grp], 0, 0, 0);
            __builtin_amdgcn_sched_barrier(0);
#pragma unroll
            for (int grp = 0; grp < 4; ++grp) { float p = 0.f;
                p = fmaf(relu1(acc[grp].x), wv.x, p); p = fmaf(relu1(acc[grp].y), wv.y, p); p = fmaf(relu1(acc[grp].z), wv.z, p); p = fmaf(relu1(acc[grp].w), wv.w, p);
                pg[grp] = p; }
        }
        float mine;
        { const auto s02 = __builtin_amdgcn_permlane32_swap(__float_as_uint(pg[0]), __float_as_uint(pg[2]), false, false);
          const auto s13 = __builtin_amdgcn_permlane32_swap(__float_as_uint(pg[1]), __float_as_uint(pg[3]), false, false);
          const float e = __uint_as_float(s02[0]) + __uint_as_float(s02[1]);
          const float o = __uint_as_float(s13[0]) + __uint_as_float(s13[1]);
          const auto t = __builtin_amdgcn_permlane16_swap(__float_as_uint(e), __float_as_uint(o), false, false);
          mine = __uint_as_float(t[0]) + __uint_as_float(t[1]); }
        const unsigned u = __float_as_uint(mine); const unsigned ok = u ^ ((unsigned)((int)u >> 31) | 0x80000000u);
        const bool kvalid = 64 * st + lane < nvalid;
        keys[64 * st + lane] = kvalid ? ok : 0u;
        if (kvalid) __hip_atomic_fetch_add(hist + (ok >> 24), 1u, __ATOMIC_RELAXED, __HIP_MEMORY_SCOPE_WORKGROUP);
        *(LAS u32x4*)(lds + ((st + 1) & 1) * 8192 + sdst) = pf[j];
        { const int ls = (st + 1 + PFD < nsteps) ? st + 1 + PFD : nsteps - 1; pf[j] = ld16(ksrc + (size_t)ls * 4096); }
        __syncthreads();
        }
      }
    }
    }
    unsigned long long mymask = 0ull;
    for (int rr_ = 0; rr_ < 1 + (int)((MK_REP >> 17) & 1u); ++rr_) {
    if (rr_) { *(LAS u32x4*)(hist + 4 * lane) = (u32x4){0u, 0u, 0u, 0u}; for (int st = 0; st < nsteps; ++st) { const unsigned k = keys[64 * st + lane]; if (64 * st + lane < nvalid) __hip_atomic_fetch_add(hist + (k >> 24), 1u, __ATOMIC_RELAXED, __HIP_MEMORY_SCOPE_WORKGROUP); } }
    unsigned prefix = 0u, need = 256u;
    { unsigned T, ab; radix_scan(hist, need, lane, T, ab); prefix = T; need -= ab; }
#pragma unroll
    for (int pass = 1; pass < 4; ++pass) {
        const int sh = 24 - 8 * pass;
        *(LAS u32x4*)(hist + 4 * lane) = (u32x4){0u, 0u, 0u, 0u};
#pragma unroll 4
        for (int st = 0; st < nsteps; ++st) { const unsigned k = keys[64 * st + lane];
            if ((k >> (sh + 8)) == prefix) __hip_atomic_fetch_add(hist + ((k >> sh) & 0xffu), 1u, __ATOMIC_RELAXED, __HIP_MEMORY_SCOPE_WORKGROUP); }
        unsigned T, ab; radix_scan(hist, need, lane, T, ab);
        prefix = (prefix << 8) | T; need -= ab;
    }
    const unsigned tkey = prefix, take_eq = need;
    mymask = 0ull; unsigned run = 0u;
    const unsigned long long lt = (lane == 0) ? 0ull : (~0ull >> (64 - lane));
#pragma unroll 4
    for (int st = 0; st < nsteps; ++st) { const unsigned k = keys[64 * st + lane];
        const bool gt = k > tkey, eq = k == tkey;
        const unsigned long long em = __ballot(eq);
        const unsigned rank = run + (unsigned)__builtin_popcountll(em & lt);
        const bool sel = gt || (eq && rank < take_eq);
        run += (unsigned)__builtin_popcountll(em);
        const unsigned long long sm = __ballot(sel);
        mymask = (lane == st) ? sm : mymask;
    }
    }
    SEL[lane] = mymask;
}


constexpr int PD2_TILE = 0, PD2_TB = 32768, PD2_H8 = 65536;
__device__ __forceinline__ void pd_group256(const Args& a, LAS unsigned char* lds, int q0, int tid) {
    unsigned char* ws = a.ws;
    const int lane = tid & 63, wid = __builtin_amdgcn_readfirstlane(tid >> 6);
    const int q = q0 + wid;
    unsigned long long* SEL = (unsigned long long*)(ws + WS_SEL) + (size_t)q * 64;
    int nsteps, nvalid; size_t krow0;
    if (q0 < MP) { const int t = q0 & 4095; nsteps = (t >> 6) + 1; nvalid = nsteps * 64; krow0 = (size_t)(q0 & ~4095); }
    else { const int b = (q0 - MP) >> 4; nsteps = 17; nvalid = SKEYS; krow0 = (size_t)MP + (size_t)b * SKEYS; }
    if (nsteps <= 4) { SEL[lane] = (lane < nsteps) ? ~0ull : 0ull; return; }
    const int nbig = (nsteps + 3) >> 2;
    const int kc = lane & 15, g = lane >> 4;
    bf16x8 af[2];
    { const bf16* qp = (const bf16*)(ws + WS_QI) + (size_t)q * 1024 + kc * 64 + 8 * g; af[0] = *(const bf16x8*)qp; af[1] = *(const bf16x8*)(qp + 32); }
    const f32x4 wv = *(const f32x4*)((const float*)(ws + WS_WI) + (size_t)q * 16 + 4 * g);
    LAS unsigned* keys = (LAS unsigned*)(lds + PD_KEYS + wid * 16384);
    LAS unsigned* hist = (LAS unsigned*)(lds + PD_HIST + wid * 1024);
    LAS unsigned* hist8 = (LAS unsigned*)(lds + PD2_H8 + wid * (8 * 260 * 4)) + (lane & 7) * 260;
    const bf16* ksrc = (const bf16*)(ws + WS_KI) + (krow0 + (tid >> 3)) * 64 + 8 * (tid & 7);
    const int sdst = PD2_TILE + (tid >> 3) * 128 + (((tid & 7) ^ ((tid >> 4) & 7)) * 16);
    const int sw = (kc >> 1) & 7;
    const int boff0 = PD2_TILE + kc * 128 + ((g ^ sw) * 16), boff1 = PD2_TILE + kc * 128 + (((4 + g) ^ sw) * 16);
    constexpr int PFD = 2;
    u32x4 pf[PFD][4];
    unsigned key[64];
    __syncthreads();
    unsigned z0 = 0u; asm volatile("" : "+v"(z0));
    const u32x4 zz = (u32x4){z0, z0, z0, z0};
    { LAS unsigned* h8 = (LAS unsigned*)(lds + PD2_H8 + wid * (8 * 260 * 4));
#pragma unroll
      for (int c = 0; c < 8; ++c) *(LAS u32x4*)(h8 + c * 260 + 4 * lane) = zz;
      if (lane < 8) *(LAS u32x4*)(h8 + lane * 260 + 256) = zz; }
    { u32x4 t0[4];
#pragma unroll
      for (int i = 0; i < 4; ++i) t0[i] = ld16(ksrc + (size_t)i * 4096);
#pragma unroll
      for (int s = 0; s < PFD; ++s) { const int bl = (1 + s < nbig) ? 1 + s : nbig - 1;
#pragma unroll
          for (int i = 0; i < 4; ++i) pf[s][i] = ld16(ksrc + (size_t)bl * 16384 + (size_t)i * 4096); }
#pragma unroll
      for (int i = 0; i < 4; ++i) *(LAS u32x4*)(lds + sdst + i * 8192) = t0[i]; }
    __syncthreads();
#pragma unroll
    for (int bs = 0; bs < 16; ++bs) {
#pragma unroll
        for (int s4 = 0; s4 < 4; ++s4) key[4 * bs + s4] = 0u;
        if (bs < nbig) {
            const LAS unsigned char* tb = lds + (bs & 1) * PD2_TB;
#pragma unroll
            for (int s4 = 0; s4 < 4; ++s4) if (256 * bs + 64 * s4 < nvalid) {
                float pg[4];
                {   bf16x8 bq[8];
#pragma unroll
                    for (int grp = 0; grp < 4; ++grp) { bq[2 * grp] = *(const LAS bf16x8*)(tb + boff0 + s4 * 8192 + grp * 2048); bq[2 * grp + 1] = *(const LAS bf16x8*)(tb + boff1 + s4 * 8192 + grp * 2048); }
                    f32x4 acc[4];
#pragma unroll
                    for (int grp = 0; grp < 4; ++grp) acc[grp] = __builtin_amdgcn_mfma_f32_16x16x32_bf16(af[0], bq[2 * grp], (f32x4){0.f, 0.f, 0.f, 0.f}, 0, 0, 0);
#pragma unroll
                    for (int grp = 0; grp < 4; ++grp) acc[grp] = __builtin_amdgcn_mfma_f32_16x16x32_bf16(af[1], bq[2 * grp + 1], acc[grp], 0, 0, 0);
#pragma unroll
                    for (int grp = 0; grp < 4; ++grp) { float p = 0.f;
                        p = fmaf(relu1(acc[grp].x), wv.x, p); p = fmaf(relu1(acc[grp].y), wv.y, p); p = fmaf(relu1(acc[grp].z), wv.z, p); p = fmaf(relu1(acc[grp].w), wv.w, p);
                        pg[grp] = p; }
                }
                float mine;
                { const auto s02 = __builtin_amdgcn_permlane32_swap(__float_as_uint(pg[0]), __float_as_uint(pg[2]), false, false);
                  const auto s13 = __builtin_amdgcn_permlane32_swap(__float_as_uint(pg[1]), __float_as_uint(pg[3]), false, false);
                  const float e = __uint_as_float(s02[0]) + __uint_as_float(s02[1]);
                  const float o = __uint_as_float(s13[0]) + __uint_as_float(s13[1]);
                  const auto t = __builtin_amdgcn_permlane16_swap(__float_as_uint(e), __float_as_uint(o), false, false);
                  mine = __uint_as_float(t[0]) + __uint_as_float(t[1]); }
                const unsigned u = __float_as_uint(mine); const unsigned ok = u ^ ((unsigned)((int)u >> 31) | 0x80000000u);
                if (256 * bs + 64 * s4 + 64 <= nvalid) {
                    key[4 * bs + s4] = ok; __hip_atomic_fetch_add(hist8 + (ok >> 24), 1u, __ATOMIC_RELAXED, __HIP_MEMORY_SCOPE_WORKGROUP);
                } else { const bool kvalid = 256 * bs + 64 * s4 + lane < nvalid;
                    key[4 * bs + s4] = kvalid ? ok : 0u;
                    if (kvalid) __hip_atomic_fetch_add(hist8 + (ok >> 24), 1u, __ATOMIC_RELAXED, __HIP_MEMORY_SCOPE_WORKGROUP); }
            }
#pragma unroll
            for (int i = 0; i < 4; ++i) *(LAS u32x4*)(lds + ((bs + 1) & 1) * PD2_TB + sdst + i * 8192) = pf[bs % PFD][i];
            { const int bl = (bs + 1 + PFD < nbig) ? bs + 1 + PFD : nbig - 1;
#pragma unroll
              for (int i = 0; i < 4; ++i) pf[bs % PFD][i] = ld16(ksrc + (size_t)bl * 16384 + (size_t)i * 4096); }
            __syncthreads();
            __builtin_amdgcn_sched_barrier(0);
        }
    }
    { const LAS unsigned* h8 = (const LAS unsigned*)(lds + PD2_H8 + wid * (8 * 260 * 4)); u32x4 t = *(const LAS u32x4*)(h8 + 4 * lane);
#pragma unroll
      for (int c = 1; c < 8; ++c) { const u32x4 v = *(const LAS u32x4*)(h8 + c * 260 + 4 * lane); t.x += v.x; t.y += v.y; t.z += v.z; t.w += v.w; }
      *(LAS u32x4*)(hist + 4 * lane) = t; }
    __syncthreads();
#pragma unroll
    for (int J = 0; J < 16; ++J) *(LAS u32x4*)(keys + 256 * J + 4 * lane) = (u32x4){key[4 * J], key[4 * J + 1], key[4 * J + 2], key[4 * J + 3]};
    unsigned prefix = 0u, need = 256u, tkey = 0u, take_eq = 0u; bool done = false;
    { unsigned T, ab, cn; radix_scan3(hist, need, lane, T, ab, cn); prefix = T; need -= ab; if (cn == need && prefix != 0u) { tkey = (prefix << 24) - 1u; done = true; } }
#pragma unroll
    for (int pass = 1; pass < 4; ++pass) {
        if (!done) {
        const int sh = 24 - 8 * pass;
        *(LAS u32x4*)(hist + 4 * lane) = zz;
#pragma unroll 2
        for (int J = 0; J < nbig; ++J) { const u32x4 kk = *(const LAS u32x4*)(keys + 256 * J + 4 * lane);
            const bool m0 = (kk[0] >> (sh + 8)) == prefix, m1 = (kk[1] >> (sh + 8)) == prefix, m2 = (kk[2] >> (sh + 8)) == prefix, m3 = (kk[3] >> (sh + 8)) == prefix;
            if (__any(m0 | m1 | m2 | m3)) {
                if (m0) __hip_atomic_fetch_add(hist + ((kk[0] >> sh) & 0xffu), 1u, __ATOMIC_RELAXED, __HIP_MEMORY_SCOPE_WORKGROUP);
                if (m1) __hip_atomic_fetch_add(hist + ((kk[1] >> sh) & 0xffu), 1u, __ATOMIC_RELAXED, __HIP_MEMORY_SCOPE_WORKGROUP);
                if (m2) __hip_atomic_fetch_add(hist + ((kk[2] >> sh) & 0xffu), 1u, __ATOMIC_RELAXED, __HIP_MEMORY_SCOPE_WORKGROUP);
                if (m3) __hip_atomic_fetch_add(hist + ((kk[3] >> sh) & 0xffu), 1u, __ATOMIC_RELAXED, __HIP_MEMORY_SCOPE_WORKGROUP); } }
        unsigned T, ab, cn; radix_scan3(hist, need, lane, T, ab, cn);
        prefix = (prefix << 8) | T; need -= ab;
        if (pass < 3 && cn == need && prefix != 0u) { tkey = (prefix << sh) - 1u; done = true; }
        }
    }
    if (!done) { tkey = prefix; take_eq = need; }
    unsigned long long mymask = 0ull; unsigned run = 0u;
    const unsigned long long lt = (lane == 0) ? 0ull : (~0ull >> (64 - lane));
    if (take_eq == 0u) {
#pragma unroll 2
        for (int J = 0; J < nbig; ++J) { const u32x4 kk = *(const LAS u32x4*)(keys + 256 * J + 4 * lane);
#pragma unroll
            for (int c = 0; c < 4; ++c) { const unsigned long long sm = __ballot(kk[c] > tkey); mymask = (lane == 4 * J + c) ? sm : mymask; } }
    } else
#pragma unroll 2
    for (int J = 0; J < nbig; ++J) { const u32x4 kk = *(const LAS u32x4*)(keys + 256 * J + 4 * lane);
#pragma unroll
        for (int c = 0; c < 4; ++c) { const unsigned k = kk[c]; const int st = 4 * J + c;
            const bool gt = k > tkey, eq = k == tkey;
            const unsigned long long em = __ballot(eq);
            const unsigned rank = run + (unsigned)__builtin_popcountll(em & lt);
            const bool sel = gt || (eq && rank < take_eq);
            run += (unsigned)__builtin_popcountll(em);
            const unsigned long long sm = __ballot(sel);
            mymask = (lane == st) ? sm : mymask; }
    }
    SEL[lane] = mymask;
}

constexpr float ATT_THR = 8.0f, ATT_BIG = 4096.0f;
template <int DQK, int DK1, int DV, bool MASKED>
__device__ __forceinline__ void attn_unit(LAS unsigned char* lds, const bf16* Q, int qpitch, const bf16* K1, int k1p, const bf16* K2, int k2p, const bf16* Vt, int vp,
                                          const unsigned long long* SEL, bf16* O, int opitch, int qb, int tid) {
    constexpr int KP = DQK * 2 + 16, VP = 144, KBYTES = 64 * KP, VBYTES = DV * VP, BUF = KBYTES + VBYTES;
    constexpr int C1 = DK1 / 8, C2 = (DQK - DK1) / 8, NK1 = 64 * C1 / 512, NK2 = 64 * C2 / 512, NVC = DV * 8 / 512, NDS = DQK / 16, NDB = DV / 32;
    static_assert(64 * C1 % 512 == 0 && 64 * C2 % 512 == 0 && DV * 8 % 512 == 0 && 2 * BUF <= LDS_RING, "attention tile staging");
    const int lane = tid & 63, wid = __builtin_amdgcn_readfirstlane(tid >> 6), rho = lane & 31, hi = lane >> 5;
    const int prho = (rho & ~12) | ((rho & 8) >> 1) | ((rho & 4) << 1);
    const int NT = 4 * qb + 4, cw = 4 * qb + (wid >> 1);
    bf16x8 qf[NDS];
    { const bf16* qp = Q + (size_t)(32 * wid + rho) * qpitch + 8 * hi;
#pragma unroll
      for (int ds = 0; ds < NDS; ++ds) qf[ds] = *(const bf16x8*)(qp + 16 * ds); }
    const unsigned long long* selp = MASKED ? SEL + (size_t)(32 * wid + rho) * 64 : nullptr;
    const __amdgpu_buffer_rsrc_t r1 = __builtin_amdgcn_make_buffer_rsrc((void*)K1, 0, 0x7fffffff, 0x00020000);
    const __amdgpu_buffer_rsrc_t r2 = __builtin_amdgcn_make_buffer_rsrc((void*)(C2 ? K2 : K1), 0, 0x7fffffff, 0x00020000);
    const __amdgpu_buffer_rsrc_t rv = __builtin_amdgcn_make_buffer_rsrc((void*)Vt, 0, 0x7fffffff, 0x00020000);
    int ko1[NK1], kl1[NK1], ko2[NK2 ? NK2 : 1], kl2[NK2 ? NK2 : 1], vo[NVC], vl[NVC];
#pragma unroll
    for (int i = 0; i < NK1; ++i) { const int cid = tid + 512 * i, row = cid / C1, ch = cid % C1; ko1[i] = (row * k1p + 8 * ch) * 2; kl1[i] = row * KP + ch * 16; }
#pragma unroll
    for (int i = 0; i < NK2; ++i) { const int cid = tid + 512 * i, row = cid / (C2 ? C2 : 1), ch = cid % (C2 ? C2 : 1); ko2[i] = (row * k2p + 8 * ch) * 2; kl2[i] = row * KP + (C1 + ch) * 16; }
#pragma unroll
    for (int i = 0; i < NVC; ++i) { const int cid = tid + 512 * i, d = cid >> 3, ch = cid & 7; vo[i] = (d * vp + 8 * ch) * 2; vl[i] = KBYTES + d * VP + ch * 16; }
    u32x4 kreg1[NK1], kreg2[NK2 ? NK2 : 1], vreg[NVC];
#define AT_LOAD(t) do { \
        _Pragma("unroll") for (int i = 0; i < NK1; ++i) kreg1[i] = __builtin_amdgcn_raw_buffer_load_b128(r1, ko1[i], (t) * 64 * k1p * 2, 0); \
        _Pragma("unroll") for (int i = 0; i < NK2; ++i) kreg2[i] = __builtin_amdgcn_raw_buffer_load_b128(r2, ko2[i], (t) * 64 * k2p * 2, 0); \
        _Pragma("unroll") for (int i = 0; i < NVC; ++i) vreg[i] = __builtin_amdgcn_raw_buffer_load_b128(rv, vo[i], (t) * 128, 0); } while (0)
#define AT_STORE(buf) do { \
        _Pragma("unroll") for (int i = 0; i < NK1; ++i) *(LAS u32x4*)(lds + (buf) * BUF + kl1[i]) = kreg1[i]; \
        _Pragma("unroll") for (int i = 0; i < NK2; ++i) *(LAS u32x4*)(lds + (buf) * BUF + kl2[i]) = kreg2[i]; \
        _Pragma("unroll") for (int i = 0; i < NVC; ++i) *(LAS u32x4*)(lds + (buf) * BUF + vl[i]) = vreg[i]; } while (0)
    f32x16 o[NDB];
#pragma unroll
    for (int db = 0; db < NDB; ++db)
#pragma unroll
        for (int r = 0; r < 16; ++r) o[db][r] = 0.f;
    float m = -1e30f, l = 0.f;
    __syncthreads();
    AT_LOAD(0); AT_STORE(0);
    __syncthreads();
    for (int t = 0; t < NT; ++t) {
        const int buf = t & 1;
        if (t + 1 < NT) AT_LOAD(t + 1);
        if (t <= cw) {
            const LAS unsigned char* kb = lds + buf * BUF; const LAS unsigned char* vb = kb + KBYTES;
            unsigned long long sw = 0ull; if (MASKED) sw = selp[t];
            f32x16 sb[2];

#pragma unroll
            for (int kbk = 0; kbk < 2; ++kbk) {
#pragma unroll
                for (int r = 0; r < 16; ++r) sb[kbk][r] = 0.f;
                constexpr int PF = (NDS < 6) ? NDS : 6;
                const LAS unsigned char* kr = kb + (32 * kbk + prho) * KP + 16 * hi;
                bf16x8 af[PF];
#pragma unroll
                for (int i = 0; i < PF; ++i) af[i] = *(const LAS bf16x8*)(kr + 32 * i);
#pragma unroll
                for (int ds = 0; ds < NDS; ++ds) {
                    const bf16x8 a0 = af[ds % PF];
                    if (ds + PF < NDS) af[ds % PF] = *(const LAS bf16x8*)(kr + 32 * (ds + PF));
                    sb[kbk] = __builtin_amdgcn_mfma_f32_32x32x16_bf16(a0, qf[ds], sb[kbk], 0, 0, 0);
                }
            }

#pragma unroll
            for (int kbk = 0; kbk < 2; ++kbk) {
                f32x16 s0 = sb[kbk];
                bf16x8 vfr[2 * NDB];
#pragma unroll
                for (int db = 0; db < NDB; ++db) { vfr[2 * db] = *(const LAS bf16x8*)(vb + (32 * db + rho) * VP + (32 * kbk + 8 * hi) * 2); vfr[2 * db + 1] = *(const LAS bf16x8*)(vb + (32 * db + rho) * VP + (32 * kbk + 16 + 8 * hi) * 2); }
                asm volatile("" ::: "memory");
                if (MASKED) {
                    const unsigned w0 = (unsigned)(sw >> (32 * kbk)) >> (8 * hi);
#pragma unroll
                    for (int r = 0; r < 16; ++r) { const unsigned bit = 1u << (16 * (r >> 3) + (r & 7)); s0[r] = (w0 & bit) ? s0[r] : -INFINITY; }
                }
                float mx = s0[0];
#pragma unroll
                for (int r = 1; r < 16; ++r) mx = fmaxf(mx, s0[r]);
                { const auto rr = __builtin_amdgcn_permlane32_swap(__float_as_uint(mx), __float_as_uint(mx), false, false); mx = fmaxf(__uint_as_float(rr[0]), __uint_as_float(rr[1])); }
                if (__any(mx > m + ATT_THR)) {
                    const float mn = fmaxf(m, mx), alpha = __builtin_amdgcn_exp2f(m - mn); m = mn; l *= alpha;
#pragma unroll
                    for (int db = 0; db < NDB; ++db)
#pragma unroll
                        for (int r = 0; r < 16; ++r) o[db][r] *= alpha;
                }
                float ps = 0.f;
#pragma unroll
                for (int r = 0; r < 16; ++r) { s0[r] = __builtin_amdgcn_exp2f(s0[r] - m); ps += s0[r]; }
                l += ps;
                bf16x8 pf[2];
#pragma unroll
                for (int s = 0; s < 2; ++s) { u32x4 p0;
                    p0.x = cvtpk(s0[8 * s], s0[8 * s + 1]); p0.y = cvtpk(s0[8 * s + 2], s0[8 * s + 3]); p0.z = cvtpk(s0[8 * s + 4], s0[8 * s + 5]); p0.w = cvtpk(s0[8 * s + 6], s0[8 * s + 7]);
                    pf[s] = __builtin_bit_cast(bf16x8, p0); }

#pragma unroll
                for (int db = 0; db < NDB; ++db) {
                    o[db] = __builtin_amdgcn_mfma_f32_32x32x16_bf16(vfr[2 * db], pf[0], o[db], 0, 0, 0);
                    o[db] = __builtin_amdgcn_mfma_f32_32x32x16_bf16(vfr[2 * db + 1], pf[1], o[db], 0, 0, 0);
                }

            }
        }
        if (t + 1 < NT) AT_STORE(buf ^ 1);
        __syncthreads();
    }
#undef AT_LOAD
#undef AT_STORE
    const float lt = l + __shfl_xor(l, 32); const float inv = 1.0f / lt;
    bf16* op = O + (size_t)(32 * wid + rho) * opitch + 4 * hi;
#pragma unroll
    for (int db = 0; db < NDB; ++db)
#pragma unroll
        for (int g4 = 0; g4 < 4; ++g4) { u32x2 w; w.x = cvtpk(o[db][4 * g4] * inv, o[db][4 * g4 + 1] * inv); w.y = cvtpk(o[db][4 * g4 + 2] * inv, o[db][4 * g4 + 3] * inv);
            *(u32x2*)(op + 32 * db + 8 * g4) = w; }
}

template <int DQK, int DK1, int DV, bool MASKED>
__device__ __forceinline__ void attn_unit_deep(LAS unsigned char* lds, const bf16* Q, int qpitch, const bf16* K1, int k1p, const bf16* K2, int k2p, const bf16* Vt, int vp,
                                          const unsigned long long* SEL, bf16* O, int opitch, int qb, int tid) {
    constexpr int KP = DQK * 2 + 16, VP = 144, KBYTES = 64 * KP, VBYTES = DV * VP, BUF = KBYTES + VBYTES;
    constexpr int C1 = DK1 / 8, C2 = (DQK - DK1) / 8, NK1 = 64 * C1 / 512, NK2 = 64 * C2 / 512, NVC = DV * 8 / 512, NDS = DQK / 16, NDB = DV / 32;
    static_assert(64 * C1 % 512 == 0 && 64 * C2 % 512 == 0 && DV * 8 % 512 == 0 && 2 * BUF <= LDS_RING, "attention tile staging");
    const int lane = tid & 63, wid = __builtin_amdgcn_readfirstlane(tid >> 6), rho = lane & 31, hi = lane >> 5;
    const int prho = (rho & ~12) | ((rho & 8) >> 1) | ((rho & 4) << 1);
    const int NT = 4 * qb + 4, cw = 4 * qb + (wid >> 1);
    bf16x8 qf[NDS];
    { const bf16* qp = Q + (size_t)(32 * wid + rho) * qpitch + 8 * hi;
#pragma unroll
      for (int ds = 0; ds < NDS; ++ds) qf[ds] = *(const bf16x8*)(qp + 16 * ds); }
    const unsigned long long* selp = MASKED ? SEL + (size_t)(32 * wid + rho) * 64 : nullptr;
    const __amdgpu_buffer_rsrc_t r1 = __builtin_amdgcn_make_buffer_rsrc((void*)K1, 0, 0x7fffffff, 0x00020000);
    const __amdgpu_buffer_rsrc_t r2 = __builtin_amdgcn_make_buffer_rsrc((void*)(C2 ? K2 : K1), 0, 0x7fffffff, 0x00020000);
    const __amdgpu_buffer_rsrc_t rv = __builtin_amdgcn_make_buffer_rsrc((void*)Vt, 0, 0x7fffffff, 0x00020000);
    int ko1[NK1], kl1[NK1], ko2[NK2 ? NK2 : 1], kl2[NK2 ? NK2 : 1], vo[NVC], vl[NVC];
#pragma unroll
    for (int i = 0; i < NK1; ++i) { const int cid = tid + 512 * i, row = cid / C1, ch = cid % C1; ko1[i] = (row * k1p + 8 * ch) * 2; kl1[i] = row * KP + ch * 16; }
#pragma unroll
    for (int i = 0; i < NK2; ++i) { const int cid = tid + 512 * i, row = cid / (C2 ? C2 : 1), ch = cid % (C2 ? C2 : 1); ko2[i] = (row * k2p + 8 * ch) * 2; kl2[i] = row * KP + (C1 + ch) * 16; }
#pragma unroll
    for (int i = 0; i < NVC; ++i) { const int cid = tid + 512 * i, d = cid >> 3, ch = cid & 7; vo[i] = (d * vp + 8 * ch) * 2; vl[i] = KBYTES + d * VP + ch * 16; }
    u32x4 kreg1[4][NK1], kreg2[4][NK2 ? NK2 : 1], vreg[4][NVC];
#define AT_LOAD(t, S) do { \
        _Pragma("unroll") for (int i = 0; i < NK1; ++i) kreg1[S][i] = __builtin_amdgcn_raw_buffer_load_b128(r1, ko1[i], (t) * 64 * k1p * 2, 0); \
        _Pragma("unroll") for (int i = 0; i < NK2; ++i) kreg2[S][i] = __builtin_amdgcn_raw_buffer_load_b128(r2, ko2[i], (t) * 64 * k2p * 2, 0); \
        _Pragma("unroll") for (int i = 0; i < NVC; ++i) vreg[S][i] = __builtin_amdgcn_raw_buffer_load_b128(rv, vo[i], (t) * 128, 0); } while (0)
#define AT_STORE(buf, S) do { \
        _Pragma("unroll") for (int i = 0; i < NK1; ++i) *(LAS u32x4*)(lds + (buf) * BUF + kl1[i]) = kreg1[S][i]; \
        _Pragma("unroll") for (int i = 0; i < NK2; ++i) *(LAS u32x4*)(lds + (buf) * BUF + kl2[i]) = kreg2[S][i]; \
        _Pragma("unroll") for (int i = 0; i < NVC; ++i) *(LAS u32x4*)(lds + (buf) * BUF + vl[i]) = vreg[S][i]; } while (0)
    f32x16 o[NDB];
#pragma unroll
    for (int db = 0; db < NDB; ++db)
#pragma unroll
        for (int r = 0; r < 16; ++r) o[db][r] = 0.f;
    float m = -1e30f, l = 0.f;
    __syncthreads();
    AT_LOAD(0, 0); AT_STORE(0, 0);
    AT_LOAD(1, 1); AT_LOAD(2, 2);
    unsigned long long swn = 0ull; if (MASKED) swn = selp[0];
    __syncthreads();
    for (int t0 = 0; t0 < NT; t0 += 4) {
#pragma unroll
      for (int u = 0; u < 4; ++u) {
        const int t = t0 + u, buf = u & 1;
        { const int tl = (t + 3 < NT) ? t + 3 : NT - 1; AT_LOAD(tl, (u + 3) & 3); }
        const unsigned long long sw = swn; if (MASKED) swn = selp[(t + 1 < NT) ? t + 1 : NT - 1];
        if (t <= cw) {
            const LAS unsigned char* kb = lds + buf * BUF; const LAS unsigned char* vb = kb + KBYTES;
            f32x16 sb[2];

#pragma unroll
            for (int kbk = 0; kbk < 2; ++kbk) {
#pragma unroll
                for (int r = 0; r < 16; ++r) sb[kbk][r] = 0.f;
                constexpr int PF = (NDS < 6) ? NDS : 6;
                const LAS unsigned char* kr = kb + (32 * kbk + prho) * KP + 16 * hi;
                bf16x8 af[PF];
#pragma unroll
                for (int i = 0; i < PF; ++i) af[i] = *(const LAS bf16x8*)(kr + 32 * i);
#pragma unroll
                for (int ds = 0; ds < NDS; ++ds) {
                    const bf16x8 a0 = af[ds % PF];
                    if (ds + PF < NDS) af[ds % PF] = *(const LAS bf16x8*)(kr + 32 * (ds + PF));
                    sb[kbk] = __builtin_amdgcn_mfma_f32_32x32x16_bf16(a0, qf[ds], sb[kbk], 0, 0, 0);
                }
            }

#pragma unroll
            for (int kbk = 0; kbk < 2; ++kbk) {
                f32x16 s0 = sb[kbk];
                bf16x8 vfr[2 * NDB];
#pragma unroll
                for (int db = 0; db < NDB; ++db) { vfr[2 * db] = *(const LAS bf16x8*)(vb + (32 * db + rho) * VP + (32 * kbk + 8 * hi) * 2); vfr[2 * db + 1] = *(const LAS bf16x8*)(vb + (32 * db + rho) * VP + (32 * kbk + 16 + 8 * hi) * 2); }
                asm volatile("" ::: "memory");
                if (MASKED) {
                    const unsigned w0 = (unsigned)(sw >> (32 * kbk)) >> (8 * hi);
#pragma unroll
                    for (int r = 0; r < 16; ++r) { const unsigned mk = (unsigned)((int)(w0 << (31 - (16 * (r >> 3) + (r & 7)))) >> 31);
                        s0[r] = __uint_as_float((mk & __float_as_uint(s0[r])) | (~mk & 0xff800000u)); }
                }
                f32x16 pe; float ps = 0.f;
#pragma unroll
                for (int r = 0; r < 16; ++r) { pe[r] = __builtin_amdgcn_exp2f(s0[r] - m); ps += pe[r]; }
                if (__any(!(ps <= ATT_BIG))) {
                    float mx = s0[0];
#pragma unroll
                    for (int r = 1; r < 16; ++r) mx = fmaxf(mx, s0[r]);
                    { const auto rr = __builtin_amdgcn_permlane32_swap(__float_as_uint(mx), __float_as_uint(mx), false, false); mx = fmaxf(__uint_as_float(rr[0]), __uint_as_float(rr[1])); }
                    const float mn = fmaxf(m, mx), alpha = __builtin_amdgcn_exp2f(m - mn); m = mn; l *= alpha;
#pragma unroll
                    for (int db = 0; db < NDB; ++db)
#pragma unroll
                        for (int r = 0; r < 16; ++r) o[db][r] *= alpha;
                    ps = 0.f;
#pragma unroll
                    for (int r = 0; r < 16; ++r) { pe[r] = __builtin_amdgcn_exp2f(s0[r] - m); ps += pe[r]; }
                }
                l += ps;
                bf16x8 pf[2];
#pragma unroll
                for (int s = 0; s < 2; ++s) { u32x4 p0;
                    p0.x = cvtpk(pe[8 * s], pe[8 * s + 1]); p0.y = cvtpk(pe[8 * s + 2], pe[8 * s + 3]); p0.z = cvtpk(pe[8 * s + 4], pe[8 * s + 5]); p0.w = cvtpk(pe[8 * s + 6], pe[8 * s + 7]);
                    pf[s] = __builtin_bit_cast(bf16x8, p0); }

#pragma unroll
                for (int db = 0; db < NDB; ++db) {
                    o[db] = __builtin_amdgcn_mfma_f32_32x32x16_bf16(vfr[2 * db], pf[0], o[db], 0, 0, 0);
                    o[db] = __builtin_amdgcn_mfma_f32_32x32x16_bf16(vfr[2 * db + 1], pf[1], o[db], 0, 0, 0);
                }

            }
        }
        if (t + 1 < NT) AT_STORE(buf ^ 1, (u + 1) & 3);
        __syncthreads();
      }
    }
#undef AT_LOAD
#undef AT_STORE
    const float lt = l + __shfl_xor(l, 32); const float inv = 1.0f / lt;
    bf16* op = O + (size_t)(32 * wid + rho) * opitch + 4 * hi;
#pragma unroll
    for (int db = 0; db < NDB; ++db)
#pragma unroll
        for (int g4 = 0; g4 < 4; ++g4) { u32x2 w; w.x = cvtpk(o[db][4 * g4] * inv, o[db][4 * g4 + 1] * inv); w.y = cvtpk(o[db][4 * g4 + 2] * inv, o[db][4 * g4 + 3] * inv);
            *(u32x2*)(op + 32 * db + 8 * g4) = w; }
}

template <int DQK, int DK1, int DV, bool MASKED, bool QLDS>
__device__ __forceinline__ void attn_unit_pipe(LAS unsigned char* lds, const bf16* Q, int qpitch, const bf16* K1, int k1p, const bf16* K2, int k2p, const bf16* Vt, int vp,
                                          const unsigned long long* SEL, bf16* O, int opitch, int qb, int tid) {
    constexpr int KP = DQK * 2 + 16, VP = 144, KBYTES = 64 * KP, VBYTES = DV * VP, VOFF = 2 * KBYTES;
    constexpr int C1 = DK1 / 8, C2 = (DQK - DK1) / 8, NK1 = 64 * C1 / 512, NK2 = 64 * C2 / 512, NVC = DV * 8 / 512, NDS = DQK / 16, NDB = DV / 32;
    static_assert(64 * C1 % 512 == 0 && 64 * C2 % 512 == 0 && DV * 8 % 512 == 0 && 2 * KBYTES + 3 * VBYTES <= LDS_RING, "attention tile staging");
    const int lane = tid & 63, wid = __builtin_amdgcn_readfirstlane(tid >> 6), rho = lane & 31, hi = lane >> 5;
    const int prho = (rho & ~12) | ((rho & 8) >> 1) | ((rho & 4) << 1);
    const int NT = 4 * qb + 4, cw = 4 * qb + (wid >> 1);
    constexpr int NQR = QLDS ? DK1 / 16 : NDS, QOFF = VOFF + 3 * VBYTES;
    static_assert(!QLDS || QOFF + 8 * 32 * 144 <= LDS_BYTES - 8192, "Q image");
    bf16x8 qf[NQR];
    LAS unsigned char* const qlds = lds + QOFF + (32 * wid + rho) * 144 + 16 * hi;
    { const bf16* qp = Q + (size_t)(32 * wid + rho) * qpitch + 8 * hi;
#pragma unroll
      for (int ds = 0; ds < NDS; ++ds) { const bf16x8 v = *(const bf16x8*)(qp + 16 * ds); if (ds < NQR) qf[ds] = v; else *(LAS bf16x8*)(qlds + 32 * (ds - NQR)) = v; } }
    const unsigned long long* selp = MASKED ? SEL + (size_t)(32 * wid + rho) * 64 : nullptr;
    const __amdgpu_buffer_rsrc_t r1 = __builtin_amdgcn_make_buffer_rsrc((void*)K1, 0, 0x7fffffff, 0x00020000);
    const __amdgpu_buffer_rsrc_t r2 = __builtin_amdgcn_make_buffer_rsrc((void*)(C2 ? K2 : K1), 0, 0x7fffffff, 0x00020000);
    const __amdgpu_buffer_rsrc_t rv = __builtin_amdgcn_make_buffer_rsrc((void*)Vt, 0, 0x7fffffff, 0x00020000);
#define AT_OFFS() int tq_ = tid; asm volatile("" : "+v"(tq_)); int ko1[NK1], kl1[NK1], ko2[NK2 ? NK2 : 1], kl2[NK2 ? NK2 : 1], vo[NVC], vl[NVC]; \
        _Pragma("unroll") for (int i = 0; i < NK1; ++i) { const int cid = tq_ + 512 * i, row = cid / C1, ch = cid % C1; ko1[i] = (row * k1p + 8 * ch) * 2; kl1[i] = row * KP + ch * 16; } \
        _Pragma("unroll") for (int i = 0; i < NK2; ++i) { const int cid = tq_ + 512 * i, row = cid / (C2 ? C2 : 1), ch = cid % (C2 ? C2 : 1); ko2[i] = (row * k2p + 8 * ch) * 2; kl2[i] = row * KP + (C1 + ch) * 16; } \
        _Pragma("unroll") for (int i = 0; i < NVC; ++i) { const int cid = tq_ + 512 * i, d = cid >> 3, ch = cid & 7; vo[i] = (d * vp + 8 * ch) * 2; vl[i] = VOFF + d * VP + ch * 16; } \
        (void)ko1; (void)kl1; (void)ko2; (void)kl2; (void)vo; (void)vl
    u32x4 kreg1[NK1], kreg2[NK2 ? NK2 : 1], vreg[NVC];
#define AT_LOADK(t) do { AT_OFFS(); \
        _Pragma("unroll") for (int i = 0; i < NK1; ++i) kreg1[i] = __builtin_amdgcn_raw_buffer_load_b128(r1, ko1[i], (t) * 64 * k1p * 2, 0); \
        _Pragma("unroll") for (int i = 0; i < NK2; ++i) kreg2[i] = __builtin_amdgcn_raw_buffer_load_b128(r2, ko2[i], (t) * 64 * k2p * 2, 0); } while (0)
#define AT_LOADV(t) do { AT_OFFS(); \
        _Pragma("unroll") for (int i = 0; i < NVC; ++i) vreg[i] = __builtin_amdgcn_raw_buffer_load_b128(rv, vo[i], (t) * 128, 0); } while (0)
#define AT_STOREK(buf) do { AT_OFFS(); \
        _Pragma("unroll") for (int i = 0; i < NK1; ++i) *(LAS u32x4*)(lds + (buf) * KBYTES + kl1[i]) = kreg1[i]; \
        _Pragma("unroll") for (int i = 0; i < NK2; ++i) *(LAS u32x4*)(lds + (buf) * KBYTES + kl2[i]) = kreg2[i]; } while (0)
#define AT_STOREV(buf) do { AT_OFFS(); \
        _Pragma("unroll") for (int i = 0; i < NVC; ++i) *(LAS u32x4*)(lds + (buf) * VBYTES + vl[i]) = vreg[i]; } while (0)
    f32x16 o[NDB];
#pragma unroll
    for (int db = 0; db < NDB; ++db)
#pragma unroll
        for (int r = 0; r < 16; ++r) o[db][r] = 0.f;
    float m = -1e30f, l = 0.f;
    f32x16 sc;
    constexpr int PF = (NDS < 2) ? NDS : 2;
    constexpr int NCH = 12, CPM = NCH / NDS;
    static_assert(NCH % NDS == 0, "softmax chunking");
#define AT_QK_PLAIN(kbase) do { \
        _Pragma("unroll") for (int r = 0; r < 16; ++r) sc[r] = 0.f; \
        const LAS unsigned char* kr_ = (kbase) + prho * KP + 16 * hi; bf16x8 af_[PF]; \
        _Pragma("unroll") for (int i = 0; i < PF; ++i) af_[i] = *(const LAS bf16x8*)(kr_ + 32 * i); \
        _Pragma("unroll") for (int ds = 0; ds < NDS; ++ds) { const bf16x8 a0 = af_[ds % PF]; if (ds + PF < NDS) af_[ds % PF] = *(const LAS bf16x8*)(kr_ + 32 * (ds + PF)); \
            const bf16x8 qv = (ds < NQR) ? qf[ds < NQR ? ds : 0] : *(const LAS bf16x8*)(qlds + 32 * (ds - NQR)); \
            sc = __builtin_amdgcn_mfma_f32_32x32x16_bf16(a0, qv, sc, 0, 0, 0); } } while (0)
#define AT_STEP(HAVE_NEXT, knext, vbase, koff, mw) do { \
        f32x16 sn; \
        _Pragma("unroll") for (int r = 0; r < 16; ++r) sn[r] = 0.f; \
        const LAS unsigned char* kr_ = (knext) + prho * KP + 16 * hi; bf16x8 af_[PF]; \
        if (HAVE_NEXT) { _Pragma("unroll") for (int i = 0; i < PF; ++i) af_[i] = *(const LAS bf16x8*)(kr_ + 32 * i); } \
        bf16x8 va0 = *(const LAS bf16x8*)((vbase) + rho * VP + ((koff) + 8 * hi) * 2), va1 = *(const LAS bf16x8*)((vbase) + rho * VP + ((koff) + 16 + 8 * hi) * 2);     \
        float mx = 0.f, alpha = 1.f, ps = 0.f; u32x4 pw0, pw1; bf16x8 qn = af_[0]; \
        _Pragma("unroll") for (int c = 0; c < NCH; ++c) { \
            if (c == 0) { if (MASKED) { const unsigned w0_ = (mw) >> (8 * hi); \
                    _Pragma("unroll") for (int r = 0; r < 16; ++r) { const unsigned bit = 1u << (16 * (r >> 3) + (r & 7)); sc[r] = (w0_ & bit) ? sc[r] : -INFINITY; } } \
                mx = fmaxf(fmaxf(fmaxf(sc[0], sc[1]), fmaxf(sc[2], sc[3])), fmaxf(fmaxf(sc[4], sc[5]), fmaxf(sc[6], sc[7]))); } \
            else if (c == 1) { mx = fmaxf(mx, fmaxf(fmaxf(fmaxf(sc[8], sc[9]), fmaxf(sc[10], sc[11])), fmaxf(fmaxf(sc[12], sc[13]), fmaxf(sc[14], sc[15])))); \
                const auto rr = __builtin_amdgcn_permlane32_swap(__float_as_uint(mx), __float_as_uint(mx), false, false); mx = fmaxf(__uint_as_float(rr[0]), __uint_as_float(rr[1])); \
                const float mn = fmaxf(m, mx); alpha = __builtin_amdgcn_exp2f(m - mn); m = mn; l *= alpha; } \
            else if (c < 10) { const int e = 2 * (c - 2); sc[e] = __builtin_amdgcn_exp2f(sc[e] - m); sc[e + 1] = __builtin_amdgcn_exp2f(sc[e + 1] - m); ps += sc[e] + sc[e + 1]; } \
            else if (c == 10) { pw0.x = cvtpk(sc[0], sc[1]); pw0.y = cvtpk(sc[2], sc[3]); pw0.z = cvtpk(sc[4], sc[5]); pw0.w = cvtpk(sc[6], sc[7]); } \
            else { pw1.x = cvtpk(sc[8], sc[9]); pw1.y = cvtpk(sc[10], sc[11]); pw1.z = cvtpk(sc[12], sc[13]); pw1.w = cvtpk(sc[14], sc[15]); l += ps; } \
            if (HAVE_NEXT && (c % CPM) == 0) { const int ds = c / CPM; const bf16x8 a0 = af_[ds % PF]; if (ds + PF < NDS) af_[ds % PF] = *(const LAS bf16x8*)(kr_ + 32 * (ds + PF)); \
                const bf16x8 qv = (ds < NQR) ? qf[ds < NQR ? ds : 0] : qn; if (QLDS && ds + 1 >= NQR && ds + 1 < NDS) qn = *(const LAS bf16x8*)(qlds + 32 * (ds + 1 - NQR)); \
                sn = __builtin_amdgcn_mfma_f32_32x32x16_bf16(a0, qv, sn, 0, 0, 0); } \
            __builtin_amdgcn_sched_barrier(0); } \
        const bf16x8 pf0 = __builtin_bit_cast(bf16x8, pw0), pf1 = __builtin_bit_cast(bf16x8, pw1); \
        _Pragma("unroll") for (int r = 0; r < 16; ++r) o[0][r] *= alpha; \
        __builtin_amdgcn_sched_barrier(0); \
        _Pragma("unroll") for (int db = 0; db < NDB; ++db) { \
            bf16x8 vb0 = va0, vb1 = va1; \
            if (db + 1 < NDB) { vb0 = *(const LAS bf16x8*)((vbase) + (32 * (db + 1) + rho) * VP + ((koff) + 8 * hi) * 2); vb1 = *(const LAS bf16x8*)((vbase) + (32 * (db + 1) + rho) * VP + ((koff) + 16 + 8 * hi) * 2); } \
            o[db] = __builtin_amdgcn_mfma_f32_32x32x16_bf16(va0, pf0, o[db], 0, 0, 0); \
            if (db + 1 < NDB) { _Pragma("unroll") for (int r = 0; r < 8; ++r) o[db + 1][r] *= alpha; } \
            __builtin_amdgcn_sched_barrier(0); \
            o[db] = __builtin_amdgcn_mfma_f32_32x32x16_bf16(va1, pf1, o[db], 0, 0, 0); \
            if (db + 1 < NDB) { _Pragma("unroll") for (int r = 8; r < 16; ++r) o[db + 1][r] *= alpha; } \
            __builtin_amdgcn_sched_barrier(0); \
            va0 = vb0; va1 = vb1; } \
        if (HAVE_NEXT) sc = sn; } while (0)
    __syncthreads();
    AT_LOADK(0); AT_LOADV(0); AT_STOREK(0); AT_STOREV(0);
    __syncthreads();
    unsigned long long swp = 0ull;
    int v3 = 0;
    unsigned long long swn = 0ull; if (MASKED) swn = selp[0];
    for (int t = 0; t < NT; ++t) {
        const int buf = t & 1, v3n = (v3 == 2) ? 0 : v3 + 1, v3p = (v3 == 0) ? 2 : v3 - 1; const bool more = t + 1 < NT;
        if (more) AT_LOADK(t + 1);
        const LAS unsigned char* kb = lds + buf * KBYTES; const LAS unsigned char* vb = lds + VOFF + v3 * VBYTES; const LAS unsigned char* vbp = lds + VOFF + v3p * VBYTES;
        const unsigned long long sw = swn; if (MASKED && t + 1 <= cw) swn = selp[t + 1];
        if (t <= cw) {
            if (t == 0) AT_QK_PLAIN(kb);
            else AT_STEP(true, kb, vbp, 32, (unsigned)(swp >> 32));
        }
        if (more) { AT_STOREK(buf ^ 1); AT_LOADV(t + 1); }
        if (t <= cw) {
            AT_STEP(true, kb + 32 * KP, vb, 0, (unsigned)sw);
            if (t == cw) AT_STEP(false, kb, vb, 32, (unsigned)(sw >> 32));
            swp = sw;
        }
        if (more) AT_STOREV(v3n);
        v3 = v3n;
        __syncthreads();
    }
#undef AT_QK_PLAIN
#undef AT_STEP
#undef AT_LOAD
#undef AT_STORE
#undef AT_LOADK
#undef AT_LOADV
#undef AT_STOREK
#undef AT_STOREV
#undef AT_OFFS
    const float lt = l + __shfl_xor(l, 32); const float inv = 1.0f / lt;
    bf16* op = O + (size_t)(32 * wid + rho) * opitch + 4 * hi;
#pragma unroll
    for (int db = 0; db < NDB; ++db)
#pragma unroll
        for (int g4 = 0; g4 < 4; ++g4) { u32x2 w; w.x = cvtpk(o[db][4 * g4] * inv, o[db][4 * g4 + 1] * inv); w.y = cvtpk(o[db][4 * g4 + 2] * inv, o[db][4 * g4 + 3] * inv);
            *(u32x2*)(op + 32 * db + 8 * g4) = w; }
}

template <int DQK, int DK1, int DV, bool MASKED>
__device__ __forceinline__ void sattn_block(LAS unsigned char* lds, const bf16* Q, int qpitch, const bf16* K1, int k1p, const bf16* K2, int k2p, const bf16* Vt, int vp,
                                            const unsigned long long* SEL, bf16* O, int opitch, int tid) {
    constexpr int NDS = DQK / 16, NDS1 = DK1 / 16, NDB = DV / 32, NT = (SKEYS + 63) / 64;
    const int lane = tid & 63, wid = __builtin_amdgcn_readfirstlane(tid >> 6), rho = lane & 31, hi = lane >> 5, qr = rho & 15;
    const int prho = (rho & ~12) | ((rho & 8) >> 1) | ((rho & 4) << 1);
    bf16x8 qf[NDS];
    { const bf16* qp = Q + (size_t)qr * qpitch + 8 * hi;
#pragma unroll
      for (int ds = 0; ds < NDS; ++ds) qf[ds] = *(const bf16x8*)(qp + 16 * ds); }
    const unsigned long long* selp = MASKED ? SEL + (size_t)qr * 64 : nullptr;
    f32x16 o[NDB];
#pragma unroll
    for (int db = 0; db < NDB; ++db)
#pragma unroll
        for (int r = 0; r < 16; ++r) o[db][r] = 0.f;
    float m = -1e30f, l = 0.f;
    for (int t = wid; t < NT; t += 8) {
        unsigned long long sw = 0ull; if (MASKED) sw = selp[t];
#pragma unroll
        for (int kbk = 0; kbk < 2; ++kbk) {
            const int kb0 = 64 * t + 32 * kbk;
            if (kb0 < SKEYS) {
                const int krow = (kb0 + prho < SKEYS) ? kb0 + prho : 0;
                const bf16* k1 = K1 + (size_t)krow * k1p + 8 * hi; const bf16* k2 = (NDS > NDS1) ? K2 + (size_t)krow * k2p + 8 * hi : K1;
                bf16x8 af[NDS];
#pragma unroll
                for (int ds = 0; ds < NDS; ++ds) af[ds] = (ds < NDS1) ? *(const bf16x8*)(k1 + 16 * ds) : *(const bf16x8*)(k2 + 16 * (ds - NDS1));
                bf16x8 vf[2][NDB];
#pragma unroll
                for (int s = 0; s < 2; ++s)
#pragma unroll
                    for (int db = 0; db < NDB; ++db) vf[s][db] = *(const bf16x8*)(Vt + (size_t)(32 * db + rho) * vp + kb0 + ((kb0 + 16 * s < SKEYS) ? 16 * s : 0) + 8 * hi);
                f32x16 s0;
#pragma unroll
                for (int r = 0; r < 16; ++r) s0[r] = 0.f;
#pragma unroll
                for (int ds = 0; ds < NDS; ++ds) s0 = __builtin_amdgcn_mfma_f32_32x32x16_bf16(af[ds], qf[ds], s0, 0, 0, 0);
                const unsigned w0 = MASKED ? ((unsigned)(sw >> (32 * kbk)) >> (8 * hi)) : 0xffffffffu;
#pragma unroll
                for (int r = 0; r < 16; ++r) { const int kl = 16 * (r >> 3) + (r & 7); const bool on = (w0 & (1u << kl)) && (kb0 + kl + 8 * hi < SKEYS); s0[r] = on ? s0[r] : -INFINITY; }
                float mx = s0[0];
#pragma unroll
                for (int r = 1; r < 16; ++r) mx = fmaxf(mx, s0[r]);
                mx = fmaxf(mx, __shfl_xor(mx, 32));
                if (__any(mx > m + ATT_THR)) {
                  const float mn = fmaxf(m, mx), alpha = __builtin_amdgcn_exp2f(m - mn); m = mn; l *= alpha;
#pragma unroll
                  for (int db = 0; db < NDB; ++db)
#pragma unroll
                      for (int r = 0; r < 16; ++r) o[db][r] *= alpha; }
                float ps = 0.f;
#pragma unroll
                for (int r = 0; r < 16; ++r) { s0[r] = __builtin_amdgcn_exp2f(s0[r] - m); ps += s0[r]; }
                l += ps;
#pragma unroll
                for (int s = 0; s < 2; ++s) {
                    if (kb0 + 16 * s < SKEYS) {
                        u32x4 p0;
                        p0.x = cvtpk(s0[8 * s], s0[8 * s + 1]); p0.y = cvtpk(s0[8 * s + 2], s0[8 * s + 3]); p0.z = cvtpk(s0[8 * s + 4], s0[8 * s + 5]); p0.w = cvtpk(s0[8 * s + 6], s0[8 * s + 7]);
                        const bf16x8 pf = __builtin_bit_cast(bf16x8, p0);
#pragma unroll
                        for (int db = 0; db < NDB; ++db) o[db] = __builtin_amdgcn_mfma_f32_32x32x16_bf16(vf[s][db], pf, o[db], 0, 0, 0);
                    }
                }
            }
        }
    }
    LAS float* ML = (LAS float*)lds; LAS float* OS = (LAS float*)(lds + 1024);
    const float lt = l + __shfl_xor(l, 32);
    __syncthreads();
    if (lane < 16) { ML[(wid * 16 + lane) * 2] = m; ML[(wid * 16 + lane) * 2 + 1] = lt; }
    if (rho < 16) {
#pragma unroll
        for (int db = 0; db < NDB; ++db)
#pragma unroll
            for (int r = 0; r < 16; ++r) { const int d = 32 * db + (r & 3) + 8 * (r >> 2) + 4 * hi; OS[(wid * DV + d) * 16 + rho] = o[db][r]; }
    }
    __syncthreads();
    { const int q = tid & 15, d0 = tid >> 4;
      float mw[8], mm = -1e30f;
#pragma unroll
      for (int w = 0; w < 8; ++w) { mw[w] = ML[(w * 16 + q) * 2]; mm = fmaxf(mm, mw[w]); }
      float den = 0.f;
#pragma unroll
      for (int w = 0; w < 8; ++w) { mw[w] = __builtin_amdgcn_exp2f(mw[w] - mm); den += ML[(w * 16 + q) * 2 + 1] * mw[w]; }
      const float inv = 1.0f / den;
#pragma unroll
      for (int j = 0; j < DV / 32; ++j) { const int d = d0 + 32 * j; float num = 0.f;
#pragma unroll
          for (int w = 0; w < 8; ++w) num += OS[(w * DV + d) * 16 + q] * mw[w];
          O[(size_t)q * opitch + d] = (bf16)(cvtpk(num * inv, 0.f) & 0xffffu); } }
    __syncthreads();
}

template <int P> __device__ __forceinline__ void ln_row(const bf16* xin, const bf16* trow, const float* slab  , const float* gate, const float* lng, const float* lnb, bf16* xout, float* yout  , const float* sc, const float* sh, bf16* hrow, int lane) {
    f32x4 y[8]; float s = 0.f;
#pragma unroll
    for (int j = 0; j < 8; ++j) { const int col = 4 * lane + 256 * j; const u32x2 xw = *(const u32x2*)(xin + col); const f32x4 x = (f32x4){bflo(xw.x), bfhi(xw.x), bflo(xw.y), bfhi(xw.y)}, g = *(const f32x4*)(gate + col);
        f32x4 tv;
        if (!slab) { const u32x2 tw = *(const u32x2*)(trow + col); tv = (f32x4){bflo(tw.x), bfhi(tw.x), bflo(tw.y), bfhi(tw.y)}; }
        else { tv = *(const f32x4*)(slab + col);
#pragma unroll
            for (int pp = 1; pp < P; ++pp) tv += *(const f32x4*)(slab + (size_t)pp * 256 * D + col); }
        y[j] = x * ALPHA_RES + (1.f + g) * tv; s += (y[j].x + y[j].y) + (y[j].z + y[j].w); }
    const float mean = wave_sum(s) * (1.f / D); float s2 = 0.f;
#pragma unroll
    for (int j = 0; j < 8; ++j) { y[j] = y[j] - mean; s2 += (y[j].x * y[j].x + y[j].y * y[j].y) + (y[j].z * y[j].z + y[j].w * y[j].w); }
    const float rstd = 1.0f / sqrtf(wave_sum(s2) * (1.f / D) + LN_EPS);
#pragma unroll
    for (int j = 0; j < 8; ++j) { const int col = 4 * lane + 256 * j; const f32x4 g = *(const f32x4*)(lng + col), b = *(const f32x4*)(lnb + col);
        const f32x4 xn = y[j] * rstd * g + b;
        if (yout) *(f32x4*)(yout + col) = xn; else { u32x2 xo; xo.x = cvtpk(xn.x, xn.y); xo.y = cvtpk(xn.z, xn.w); *(u32x2*)(xout + col) = xo; }
        if (sc) { const f32x4 c = *(const f32x4*)(sc + col), h = *(const f32x4*)(sh + col); const f32x4 o = xn * (1.f + c) + h; u32x2 w; w.x = cvtpk(o.x, o.y); w.y = cvtpk(o.z, o.w); *(u32x2*)(hrow + col) = w; } }
}

__device__ __forceinline__ void ln_row2(const bf16* xin0, const bf16* xin1, const bf16* trow0, const bf16* trow1, const float* gate0, const float* gate1, const float* lng, const float* lnb,
                                        bf16* xout0, bf16* xout1, float* yout0, float* yout1, const float* sc0, const float* sc1, const float* sh0, const float* sh1, bf16* hrow0, bf16* hrow1, int lane) {
    f32x4 y0[8], y1[8]; float s0 = 0.f, s1 = 0.f;
#pragma unroll
    for (int j = 0; j < 8; ++j) { const int col = 4 * lane + 256 * j;
        const u32x2 xwa = *(const u32x2*)(xin0 + col), xwb = *(const u32x2*)(xin1 + col); const f32x4 xa = (f32x4){bflo(xwa.x), bfhi(xwa.x), bflo(xwa.y), bfhi(xwa.y)}, xb = (f32x4){bflo(xwb.x), bfhi(xwb.x), bflo(xwb.y), bfhi(xwb.y)};
        const f32x4 ga = *(const f32x4*)(gate0 + col), gb = *(const f32x4*)(gate1 + col);
        const u32x2 ta = *(const u32x2*)(trow0 + col), tb = *(const u32x2*)(trow1 + col);
        y0[j] = xa * ALPHA_RES + (1.f + ga) * (f32x4){bflo(ta.x), bfhi(ta.x), bflo(ta.y), bfhi(ta.y)}; s0 += (y0[j].x + y0[j].y) + (y0[j].z + y0[j].w);
        y1[j] = xb * ALPHA_RES + (1.f + gb) * (f32x4){bflo(tb.x), bfhi(tb.x), bflo(tb.y), bfhi(tb.y)}; s1 += (y1[j].x + y1[j].y) + (y1[j].z + y1[j].w); }
#pragma unroll
    for (int o = 1; o < 64; o <<= 1) { s0 += __shfl_xor(s0, o); s1 += __shfl_xor(s1, o); }
    const float mean0 = s0 * (1.f / D), mean1 = s1 * (1.f / D); float q0 = 0.f, q1 = 0.f;
#pragma unroll
    for (int j = 0; j < 8; ++j) { y0[j] = y0[j] - mean0; q0 += (y0[j].x * y0[j].x + y0[j].y * y0[j].y) + (y0[j].z * y0[j].z + y0[j].w * y0[j].w);
        y1[j] = y1[j] - mean1; q1 += (y1[j].x * y1[j].x + y1[j].y * y1[j].y) + (y1[j].z * y1[j].z + y1[j].w * y1[j].w); }
#pragma unroll
    for (int o = 1; o < 64; o <<= 1) { q0 += __shfl_xor(q0, o); q1 += __shfl_xor(q1, o); }
    const float r0 = 1.0f / sqrtf(q0 * (1.f / D) + LN_EPS), r1 = 1.0f / sqrtf(q1 * (1.f / D) + LN_EPS);
#pragma unroll
    for (int j = 0; j < 8; ++j) { const int col = 4 * lane + 256 * j; const f32x4 g = *(const f32x4*)(lng + col), b = *(const f32x4*)(lnb + col);
        const f32x4 xa = y0[j] * r0 * g + b, xb = y1[j] * r1 * g + b;
        if (yout0) { *(f32x4*)(yout0 + col) = xa; *(f32x4*)(yout1 + col) = xb; }
        else { u32x2 pa, pb; pa.x = cvtpk(xa.x, xa.y); pa.y = cvtpk(xa.z, xa.w); pb.x = cvtpk(xb.x, xb.y); pb.y = cvtpk(xb.z, xb.w); *(u32x2*)(xout0 + col) = pa; *(u32x2*)(xout1 + col) = pb; }
        if (sc0) { const f32x4 ca = *(const f32x4*)(sc0 + col), ha = *(const f32x4*)(sh0 + col), cb = *(const f32x4*)(sc1 + col), hb = *(const f32x4*)(sh1 + col);
            const f32x4 oa = xa * (1.f + ca) + ha, ob = xb * (1.f + cb) + hb; u32x2 wa, wb; wa.x = cvtpk(oa.x, oa.y); wa.y = cvtpk(oa.z, oa.w); wb.x = cvtpk(ob.x, ob.y); wb.y = cvtpk(ob.z, ob.w);
            *(u32x2*)(hrow0 + col) = wa; *(u32x2*)(hrow1 + col) = wb; } }
}

__device__ __forceinline__ void pi_row(const Args& a, int l, int r, int lane, int s_lo, int s_hi) {
    unsigned char* ws = a.ws;
    const bf16* G0 = (const bf16*)(ws + WS_GU) + (size_t)r * NGU;
    const bool smp = r >= MP; int b, t, T;
    if (!smp) { b = r >> 12; t = r & 4095; T = SEQ; } else { const int rs = r - MP; b = rs >> 4; t = rs & 15; T = TS; }
    const float* st = a.in[10] + ((size_t)(l * NBS + b) * 2) * DFF;
    const float* cw = a.in[24] + (size_t)l * 3 * DFF;
    bf16* arow = (bf16*)(ws + WS_ACT) + (size_t)r * DFF;
    float* so = (t >= T - 2) ? a.out + (smp ? O_SCF + ((size_t)(l * NBS + b) * 2 + (t - (T - 2))) * DFF : O_PCF + ((size_t)(l * NBP + b) * 2 + (t - (T - 2))) * DFF) : nullptr;
    const float* SH = (const float*)(ws + WS_SLAB); const int rs = r - MP;
#define PI_LD8(dr, col, dst) do { const int c_ = (col) < DFF ? (col) : (col) - DFF; slab_ld8<SP_H>(SH, NGU, rs + (dr), 256 * (c_ / 128) + c_ % 128 + ((col) < DFF ? 0 : 128), dst); } while (0)
    for (int s = s_lo; s < s_hi; ++s) {
        const int c = 8 * (lane + 64 * s);
        float g0[8], g1[8], g2[8], up[8], w0[8], w1[8], w2[8], z[8];
        PI_LD8(0, c, g0); PI_LD8(0, DFF + c, up);
        if (t >= 1) PI_LD8(-1, c, g1); else if (smp) ld8f(st + DFF + c, g1); else {
#pragma unroll
            for (int i = 0; i < 8; ++i) g1[i] = 0.f; }
        if (t >= 2) PI_LD8(-2, c, g2); else if (smp) ld8f(st + (size_t)t * DFF + c, g2); else {
#pragma unroll
            for (int i = 0; i < 8; ++i) g2[i] = 0.f; }
        ld8f(cw + c, w0); ld8f(cw + DFF + c, w1); ld8f(cw + 2 * DFF + c, w2);
#pragma unroll
        for (int i = 0; i < 8; ++i) { const float gc = g2[i] * w0[i] + g1[i] * w1[i] + g0[i] * w2[i]; z[i] = gc / (1.f + __expf(-gc)) * up[i]; }
        st16(arow + c, pack8(z));
        if (so) st8f_nt(so + c, g0);
    }
#undef PI_LD8
}

__device__ __forceinline__ void pi_block(const Args& a, int l, int item, int lane) {
    unsigned char* ws = a.ws;
    const int rb = item / 11, strip = item - rb * 11, r0 = rb * 16, c = 512 * strip + 8 * lane;
    const int b = r0 >> 12, t0 = r0 & 4095;
    const bf16* G0 = (const bf16*)(ws + WS_GU) + (size_t)r0 * NGU + c;
    bf16* arow = (bf16*)(ws + WS_ACT) + (size_t)r0 * DFF + c;
    float w0[8], w1[8], w2[8], g1[8], g2[8];
    { const float* cw = a.in[24] + (size_t)l * 3 * DFF + c; ld8f(cw, w0); ld8f(cw + DFF, w1); ld8f(cw + 2 * DFF, w2); }
    if (t0 > 0) { unpack8(ld16(G0 - NGU), g1); unpack8(ld16(G0 - 2 * NGU), g2); }
    else {
#pragma unroll
        for (int i = 0; i < 8; ++i) { g1[i] = 0.f; g2[i] = 0.f; } }
#pragma unroll
    for (int hb = 0; hb < 2; ++hb) {
        u32x4 gq[8], uq[8];
#pragma unroll
        for (int i = 0; i < 8; ++i) { gq[i] = ld16(G0 + (size_t)(8 * hb + i) * NGU); uq[i] = ld16(G0 + (size_t)(8 * hb + i) * NGU + DFF); }
#pragma unroll
        for (int i = 0; i < 8; ++i) { float g0[8], up[8], z[8]; unpack8(gq[i], g0); unpack8(uq[i], up);
#pragma unroll
            for (int e = 0; e < 8; ++e) { const float gc = g2[e] * w0[e] + g1[e] * w1[e] + g0[e] * w2[e]; z[e] = gc / (1.f + __expf(-gc)) * up[e]; }
            st16(arow + (size_t)(8 * hb + i) * DFF, pack8(z));
            const int t = t0 + 8 * hb + i;
            if (t >= SEQ - 2) st8f(a.out + O_PCF + ((size_t)(l * NBP + b) * 2 + (t - (SEQ - 2))) * DFF + c, g0);
#pragma unroll
            for (int e = 0; e < 8; ++e) { g2[e] = g1[e]; g1[e] = g0[e]; } }
    }
}

__device__ __forceinline__ void pi_fix(const Args& a, int l, int item, int lane) {
    unsigned char* ws = a.ws; const int pm = item / 11, strip = item - pm * 11, c = 512 * strip + 8 * lane;
    const float* GH = (const float*)(ws + WS_GH); const float* G01 = (const float*)(ws + WS_G01) + (size_t)pm * 4 * DFF + c;
    float w0[8], w1[8], w2[8], ga[8], gb[8], ua[8], ub[8], p14[8], p15[8], z[8];
    { const float* cw = a.in[24] + (size_t)l * 3 * DFF + c; ld8f(cw, w0); ld8f(cw + DFF, w1); ld8f(cw + 2 * DFF, w2); }
    ld8f(G01, ga); ld8f(G01 + DFF, ua); ld8f(G01 + 2 * DFF, gb); ld8f(G01 + 3 * DFF, ub);
    if (pm & 15) { ld8f(GH + ((size_t)(pm - 1) * 2) * DFF + c, p14); ld8f(GH + ((size_t)(pm - 1) * 2 + 1) * DFF + c, p15); }
    else {
#pragma unroll
        for (int i = 0; i < 8; ++i) { p14[i] = 0.f; p15[i] = 0.f; } }
    bf16* arow = (bf16*)(ws + WS_ACT) + (size_t)pm * 256 * DFF + c;
#pragma unroll
    for (int i = 0; i < 8; ++i) { const float gc = p14[i] * w0[i] + p15[i] * w1[i] + ga[i] * w2[i]; z[i] = gc / (1.f + __expf(-gc)) * ua[i]; }
    st16(arow, pack8(z));
#pragma unroll
    for (int i = 0; i < 8; ++i) { const float gc = p15[i] * w0[i] + ga[i] * w1[i] + gb[i] * w2[i]; z[i] = gc / (1.f + __expf(-gc)) * ub[i]; }
    st16(arow + DFF, pack8(z));
    if ((pm & 15) == 15) { const int b = pm >> 4; float* so = a.out + O_PCF + ((size_t)(l * NBP + b) * 2) * DFF + c;
        float g[8]; ld8f(GH + ((size_t)pm * 2) * DFF + c, g); st8f_nt(so, g); ld8f(GH + ((size_t)pm * 2 + 1) * DFF + c, g); st8f_nt(so + DFF, g); }
}


constexpr int LNV_G1 = 0, LNV_LG = 8192, LNV_LB = 16384, LNV_S1 = 24576, LNV_SH = 32768, LNV_RED = 40960;
template <bool HOUT> __device__ __forceinline__ void ln_stage_vectors(LAS unsigned char* lds, const float* gate, const float* lng, const float* lnb, const float* sc, const float* sh, int tid) {
    const int c = 4 * tid, p = (((c >> 9) * 2 + ((c >> 2) & 1)) * 64 + ((c & 511) >> 3)) * 16;
    const f32x4 g = *(const f32x4*)(gate + c), a = *(const f32x4*)(lng + c), b = *(const f32x4*)(lnb + c);
    *(LAS f32x4*)(lds + LNV_G1 + p) = 1.f + g; *(LAS f32x4*)(lds + LNV_LG + p) = a; *(LAS f32x4*)(lds + LNV_LB + p) = b;
    if constexpr (HOUT) { const f32x4 s = *(const f32x4*)(sc + c), h = *(const f32x4*)(sh + c); *(LAS f32x4*)(lds + LNV_S1 + p) = 1.f + s; *(LAS f32x4*)(lds + LNV_SH + p) = h; }
}
__device__ __forceinline__ void lnv_ld8(const LAS unsigned char* lds, int base, int j, int lane, float (&f)[8]) {
    const f32x4 a = *(const LAS f32x4*)(lds + base + ((2 * j) * 64 + lane) * 16), b = *(const LAS f32x4*)(lds + base + ((2 * j + 1) * 64 + lane) * 16);
    f[0] = a.x; f[1] = a.y; f[2] = a.z; f[3] = a.w; f[4] = b.x; f[5] = b.y; f[6] = b.z; f[7] = b.w;
}
#ifdef LNV_GLOBAL
struct LnVec { const float* v[5]; };
__device__ __forceinline__ void lnv_gl8(const float* base, int j, int lane, float (&f)[8]) {
    const __amdgpu_buffer_rsrc_t r = __builtin_amdgcn_make_buffer_rsrc((void*)base, 0, 0x7fffffff, 0x00020000);
    const u32x4 a = __builtin_amdgcn_raw_buffer_load_b128(r, 32 * lane, 2048 * j, 0), b = __builtin_amdgcn_raw_buffer_load_b128(r, 32 * lane, 2048 * j + 16, 0);
    f[0] = __uint_as_float(a.x); f[1] = __uint_as_float(a.y); f[2] = __uint_as_float(a.z); f[3] = __uint_as_float(a.w); f[4] = __uint_as_float(b.x); f[5] = __uint_as_float(b.y); f[6] = __uint_as_float(b.z); f[7] = __uint_as_float(b.w);
}
#define LNV(idx, base, j, ll, dst) do { lnv_gl8(lv.v[idx], j, ll, dst); if ((idx) == 0 || (idx) == 3) { _Pragma("unroll") for (int e_ = 0; e_ < 8; ++e_) dst[e_] += 1.f; } } while (0)
#define LNV_PARAM , const LnVec lv
#else
#define LNV(idx, base, j, ll, dst) lnv_ld8(lds, base, j, ll, dst)
#define LNV_PARAM
#endif
template <bool YOUT, bool HOUT>
__device__ __forceinline__ void ln_rows8(const LAS unsigned char* lds, const bf16* Xi, const bf16* Ti, bf16* Xo, float* Yo, bf16* Ho, size_t row0, int lane LNV_PARAM) {
    const __amdgpu_buffer_rsrc_t rx = __builtin_amdgcn_make_buffer_rsrc((void*)(Xi + row0 * D), 0, 0x7fffffff, 0x00020000), rt = __builtin_amdgcn_make_buffer_rsrc((void*)(Ti + row0 * D), 0, 0x7fffffff, 0x00020000);
    const __amdgpu_buffer_rsrc_t ro = __builtin_amdgcn_make_buffer_rsrc(YOUT ? (void*)(Yo + row0 * D) : (void*)(Xo + row0 * D), 0, 0x7fffffff, 0x00020000);
    const __amdgpu_buffer_rsrc_t rh = __builtin_amdgcn_make_buffer_rsrc(HOUT ? (void*)(Ho + row0 * D) : (void*)(Ti + row0 * D), 0, 0x7fffffff, 0x00020000);
    const int vo = 16 * lane;
#ifdef LN_GLOBAL
#define LN_LDX(o) ld16((const char*)(Xi + row0 * D) + vo + (o))
#define LN_LDT(o) ld16((const char*)(Ti + row0 * D) + vo + (o))
#define LN_STX(v, o) st16((char*)(Xo + row0 * D) + vo + (o), v)
#define LN_STH(v, o) st16((char*)(Ho + row0 * D) + vo + (o), v)
#else
#define LN_LDX(o) __builtin_amdgcn_raw_buffer_load_b128(rx, vo + ((o) & 4095), (o) & ~4095, 0)
#define LN_LDT(o) __builtin_amdgcn_raw_buffer_load_b128(rt, vo + ((o) & 4095), (o) & ~4095, 0)
#define LN_STX(v, o) __builtin_amdgcn_raw_buffer_store_b128(v, ro, vrow + ((o) & 4095), 0, 0)
#define LN_STH(v, o) __builtin_amdgcn_raw_buffer_store_b128(v, rh, vrow + ((o) & 4095), 0, 0)
#endif
    u32x4 xr[2][4], tr[2][4];
#pragma unroll
    for (int rr = 0; rr < 2; ++rr)
#pragma unroll
        for (int j = 0; j < 4; ++j) { xr[rr][j] = LN_LDX((rr * D + 512 * j) * 2); tr[rr][j] = LN_LDT((rr * D + 512 * j) * 2); }
#pragma unroll
    for (int p = 0; p < 4; ++p) {
        float y[2][32]; float s[2] = {0.f, 0.f};
        int ll = lane; asm volatile("" : "+v"(ll));
#pragma unroll
        for (int j = 0; j < 4; ++j) { float g[8]; LNV(0, LNV_G1, j, ll, g);
#pragma unroll
            for (int rr = 0; rr < 2; ++rr) { float xf[8], tf[8]; unpack8(xr[rr][j], xf); unpack8(tr[rr][j], tf);
#pragma unroll
                for (int e = 0; e < 8; ++e) { const float v = xf[e] * ALPHA_RES + g[e] * tf[e]; y[rr][8 * j + e] = v; s[rr] += v; } } }
        __builtin_amdgcn_sched_barrier(0);
        if (p < 3) {
#pragma unroll
            for (int rr = 0; rr < 2; ++rr)
#pragma unroll
                for (int j = 0; j < 4; ++j) { xr[rr][j] = LN_LDX(((2 * (p + 1) + rr) * D + 512 * j) * 2); tr[rr][j] = LN_LDT(((2 * (p + 1) + rr) * D + 512 * j) * 2); }
        }
        __builtin_amdgcn_sched_barrier(0);
#pragma unroll
        for (int o = 1; o < 64; o <<= 1) { s[0] += __shfl_xor(s[0], o); s[1] += __shfl_xor(s[1], o); }
        const float m0 = s[0] * (1.f / D), m1 = s[1] * (1.f / D); float q0 = 0.f, q1 = 0.f;
#pragma unroll
        for (int e = 0; e < 32; ++e) { y[0][e] -= m0; q0 += y[0][e] * y[0][e]; y[1][e] -= m1; q1 += y[1][e] * y[1][e]; }
#pragma unroll
        for (int o = 1; o < 64; o <<= 1) { q0 += __shfl_xor(q0, o); q1 += __shfl_xor(q1, o); }
        const float r[2] = {1.0f / sqrtf(q0 * (1.f / D) + LN_EPS), 1.0f / sqrtf(q1 * (1.f / D) + LN_EPS)};
#pragma unroll
        for (int j = 0; j < 4; ++j) { float lg[8], lb[8], s1[8], sh[8]; LNV(1, LNV_LG, j, ll, lg); LNV(2, LNV_LB, j, ll, lb);
            if constexpr (HOUT) { LNV(3, LNV_S1, j, ll, s1); LNV(4, LNV_SH, j, ll, sh); }
#pragma unroll
            for (int rr = 0; rr < 2; ++rr) { const int off = (2 * p + rr) * D + 512 * j; float xn[8]; const int vrow = vo + (2 * p + rr) * D * 2, vrow4 = 2 * vo + (2 * p + rr) * D * 4; (void)vrow; (void)vrow4;
#pragma unroll
                for (int e = 0; e < 8; ++e) xn[e] = y[rr][8 * j + e] * r[rr] * lg[e] + lb[e];
                if constexpr (YOUT) { __builtin_amdgcn_raw_buffer_store_b128((u32x4){__float_as_uint(xn[0]), __float_as_uint(xn[1]), __float_as_uint(xn[2]), __float_as_uint(xn[3])}, ro, vrow4 + 2048 * j, 0, 0);
                                      __builtin_amdgcn_raw_buffer_store_b128((u32x4){__float_as_uint(xn[4]), __float_as_uint(xn[5]), __float_as_uint(xn[6]), __float_as_uint(xn[7])}, ro, vrow4 + 2048 * j + 16, 0, 0); }
                else LN_STX(pack8(xn), off * 2);
                if constexpr (HOUT) { float h[8];
#pragma unroll
                    for (int e = 0; e < 8; ++e) h[e] = xn[e] * s1[e] + sh[e];
                    LN_STH(pack8(h), off * 2); } } }
    }
#undef LN_LDX
#undef LN_LDT
#undef LN_STX
#undef LN_STH
}
template <int P, bool YOUT, bool HOUT>
__device__ __forceinline__ void ln_sample_coop(LAS unsigned char* lds, const bf16* xin, const float* slab, const float* gate, const float* lng, const float* lnb, bf16* xout, float* yout, const float* sc, const float* sh, bf16* hrow, int tid) {
    const int col = 4 * tid, lane = tid & 63, w = tid >> 6; LAS float* red = (LAS float*)(lds + LNV_RED);
    const u32x2 xw = *(const u32x2*)(xin + col); const f32x4 g = *(const f32x4*)(gate + col);
    f32x4 tv = *(const f32x4*)(slab + col);
#pragma unroll
    for (int pp = 1; pp < P; ++pp) tv += *(const f32x4*)(slab + (size_t)pp * 256 * D + col);
    const f32x4 a = *(const f32x4*)(lng + col), b = *(const f32x4*)(lnb + col);
    f32x4 y = (f32x4){bflo(xw.x), bfhi(xw.x), bflo(xw.y), bfhi(xw.y)} * ALPHA_RES + (1.f + g) * tv;
    const float s = wave_sum((y.x + y.y) + (y.z + y.w));
    if (lane == 0) red[w] = s;
    __syncthreads();
    float m = 0.f;
#pragma unroll
    for (int i = 0; i < 8; ++i) m += red[i];
    y = y - m * (1.f / D);
    const float q = wave_sum((y.x * y.x + y.y * y.y) + (y.z * y.z + y.w * y.w));
    if (lane == 0) red[8 + w] = q;
    __syncthreads();
    float v = 0.f;
#pragma unroll
    for (int i = 0; i < 8; ++i) v += red[8 + i];
    const float rstd = 1.0f / sqrtf(v * (1.f / D) + LN_EPS);
    const f32x4 xn = y * rstd * a + b;
    if constexpr (YOUT) *(f32x4*)(yout + col) = xn; else { u32x2 xo; xo.x = cvtpk(xn.x, xn.y); xo.y = cvtpk(xn.z, xn.w); *(u32x2*)(xout + col) = xo; }
    if constexpr (HOUT) { const f32x4 c = *(const f32x4*)(sc + col), h = *(const f32x4*)(sh + col); const f32x4 o = xn * (1.f + c) + h; u32x2 wv; wv.x = cvtpk(o.x, o.y); wv.y = cvtpk(o.z, o.w); *(u32x2*)(hrow + col) = wv; }
}

constexpr int N_PHASES = 2 + 10 * NL;
#ifndef MK_PHMASK
#define MK_PHMASK 0xFFFFu
#endif
#define EN(k) (((MK_PHMASK) >> (k)) & 1u)
#ifndef MK_REP
#define MK_REP 0u
#endif
#define REP(k) for (int rep_ = 0; rep_ < 1 + (int)(((MK_REP) >> (k)) & 1u); ++rep_)
__global__ void __launch_bounds__(512, 2) mk_fwd(Args args) {
    extern __shared__ __attribute__((aligned(16))) unsigned char lds_raw[];
    LAS unsigned char* lds = (LAS unsigned char*)lds_raw;
    const int tid = threadIdx.x, lane = tid & 63, wave = __builtin_amdgcn_readfirstlane(tid >> 6);
    const int G = gridDim.x, bx = blockIdx.x; const int vcu = (G % 8 == 0) ? (bx % 8) * (G / 8) + bx / 8 : bx;
    const int gw = vcu * 8 + wave, NGW = G * 8;
    for (int u = tid; u < (LDS_BYTES - LDS_CTL) / 4; u += 512) ((LAS unsigned*)(lds + LDS_CTL))[u] = 0u;
    __syncthreads();
#if !MK_MULTI
    XcdBarrier bar = xcd_barrier_post((unsigned*)(args.ws + WS_CTL) + CW_BAR, (volatile LAS unsigned*)(lds + LDS_MISC) + 8);
#define GRID_BAR() do { xcd_barrier(bar, wave); if ((MK_REP >> 19) & 1u) xcd_barrier(bar, wave); } while (0)
#else
#define GRID_BAR() do { } while (0)
#endif
    const int lo = args.ph_lo, hi = args.ph_hi;
#define IN(k) (lo <= (k) && (k) < hi)
#define SEAM(k) do { if (IN(k) && IN((k) + 1)) GRID_BAR(); } while (0)
#define GEMM_PHASE(Ap, Bp, Mv, Nv, Kv, Op, ldcv) do { pg8::Gemm g_{(const bf16*)(Ap), (const bf16*)(Bp), (Mv), (Nv), (Kv), (Kv)}; pg8::StaticOrder S_; S_.init((Mv), (Nv), G, bx); \
        pg8::EpiStoreBf16 E_{(bf16*)(Op), (ldcv)}; pg8::gemm_phase<pg8::EpiStoreBf16, pg8::StaticOrder, true, true>(lds, g_, S_, E_, wave); } while (0)
#define FRESH() const int lane_p = fresh_lane(); const int tid_p = wave * 64 + lane_p; (void)lane_p
#define GEMM_RESID(Ap, Bp, Kv, gatep) do { pg8::Gemm g_{(const bf16*)(Ap), (const bf16*)(Bp), MP, D, (Kv), (Kv)}; pg8::StaticOrder S_; S_.init(MP, D, G, bx); \
        pg8::EpiResid E_{(bf16*)(ws + WS_X), D, (gatep), NMOD, ALPHA_RES}; pg8::gemm_phase<pg8::EpiResid, pg8::StaticOrder, true, true>(lds, g_, S_, E_, wave); } while (0)
#define GEMM_SPLIT(Ap, Bp, Nv, Klen, ldv, Pv) for (int rs_ = 0; rs_ < 1 + (int)((MK_REP >> 18) & 1u); ++rs_) { pg8::Gemm g_{(const bf16*)(Ap), (const bf16*)(Bp), 256, (Nv), (Klen), (ldv)}; pg8::SplitOrder S_; S_.init((Pv), (Nv), G, bx); \
        pg8::EpiSlabF32 E_{(float*)(ws + WS_SLAB), (Nv)}; pg8::gemm_phase<pg8::EpiSlabF32, pg8::SplitOrder, true, true, true>(lds, g_, S_, E_, wave); }
    unsigned char* ws = args.ws;
    const float* MOD = (const float*)(ws + WS_MOD);
    float* Y = args.out + O_Y; bf16* X = (bf16*)(ws + WS_X);

    if (EN(0) && IN(0)) REP(0) p0a_prologue(args, lds, tid, lane, wave, vcu, G);
    SEAM(0);
    if (EN(1) && IN(1)) p0b_h0(args, lane, gw, NGW);
    SEAM(1);
    for (int l = 0; l < NL; ++l) {
        const int pb = 2 + 10 * l;
        unsigned char* wl = ws + WS_W + (size_t)l * W_LAYER;
        if (EN(2) && IN(pb)) { { { pg8::Gemm g_{(const bf16*)(ws + WS_H), (const bf16*)(wl + WO_IN), MP, NINP, D, D}; pg8::StaticOrder S_; S_.init(MP, NINP, G, bx);
              pg8::EpiProj E_{(bf16*)(ws + WS_PROJ), NINP, (bf16*)(ws + WS_QA), (bf16*)(ws + WS_QI), (bf16*)(ws + WS_QC), (bf16*)(ws + WS_KA), (bf16*)(ws + WS_KI), (bf16*)(ws + WS_KR), (float*)(ws + WS_WI),
                                 (const float*)(ws + WS_ROPE), QS_A, QS_C, WI_SCALE,
                                 args.out + O_PAK + (size_t)l * MP * 512, args.out + O_PAV + (size_t)l * MP * 512, args.out + O_PIK + (size_t)l * MP * 64, args.out + O_PKR + (size_t)l * MP * 64};
              pg8::gemm_phase<pg8::EpiProj, pg8::StaticOrder, true, true>(lds, g_, S_, E_, wave); }
            GEMM_SPLIT(ws + WS_H + (size_t)MP * D * 2, wl + WO_IN, NINP, D / SP_A, D, SP_A); }
            { FRESH(); unsigned* tk = (unsigned*)(ws + WS_CTL) + CW_TICKET + 64 * l;
              for (;;) { unsigned j = 0u; if (lane_p == 0) j = __hip_atomic_fetch_add(tk, 1u, __ATOMIC_RELAXED, __HIP_MEMORY_SCOPE_AGENT); j = (unsigned)__builtin_amdgcn_readfirstlane((int)j);
                  if (j >= 4096u) break;
                  if (j < 2048u) { for (int i = 0; i < 8; ++i) pb_cache_row(args, l, (int)j * 8 + i, lane_p); } else pb_vat_cache(args, l, (int)j - 2048, lane_p); } } }
        SEAM(pb);
        if (EN(3) && IN(pb + 1)) REP(3) { FRESH();
            for (int r = gw; r < MP; r += NGW) pb_token_row(args, l, r, lane_p, 0xa0u);
            for (int i = gw; i < MS * 9; i += NGW) pb_token_row(args, l, MP + i / 9, lane_p, 1u << (i % 9));
            for (int jv = gw; jv < (MP / 64) * 8; jv += NGW) pb_vat_prompt(args, jv, lane_p);
            for (int jv = gw; jv < NBS * 8; jv += NGW) pb_vat_new(args, jv, lane_p);
        }
        SEAM(pb + 1);
        if (IN(pb + 2)) {
            if (EN(4)) REP(4) { GEMM_PHASE(ws + WS_LAT, wl + WO_UK, KROWS, 1024, 512, ws + WS_KN, 1024);
            { pg8::Gemm g_{(const bf16*)(wl + WO_UV), (const bf16*)(ws + WS_LAT), 1024, KROWS, 512, 512}; pg8::StaticOrder S_; S_.init(1024, KROWS, G, (bx + G / 2) % G);
              pg8::EpiStoreBf16 E_{(bf16*)(ws + WS_VCT), KROWS}; pg8::gemm_phase<pg8::EpiStoreBf16, pg8::StaticOrder, true, true>(lds, g_, S_, E_, wave); } }
            if (EN(5)) REP(5) { FRESH();
            for (int i = vcu; i < 2048 + 256; i += G) { int q0;
                if (i < 2048) { const int b = i >> 9, r = i & 511, j = (r < 256) ? r : 767 - r; q0 = b * SEQ + 8 * j; }
                else { if ((i - 2048) & 7) continue; q0 = MP + 8 * ((i - 2048) >> 3); }
                pd_group256(args, lds, q0, tid_p); } }
        }
        SEAM(pb + 2);
        if (IN(pb + 3)) { FRESH();
            const bf16* QC = (const bf16*)(ws + WS_QC); const bf16* KN = (const bf16*)(ws + WS_KN); const bf16* KR = (const bf16*)(ws + WS_KR); const bf16* VCT = (const bf16*)(ws + WS_VCT);
            const bf16* QA = (const bf16*)(ws + WS_QA); const bf16* KA = (const bf16*)(ws + WS_KA); const bf16* VAT = (const bf16*)(ws + WS_VAT);
            const unsigned long long* SEL = (const unsigned long long*)(ws + WS_SEL); bf16* MIX = (bf16*)(ws + WS_MIX);
            if (EN(6)) REP(6) { FRESH(); for (int u = vcu; u < 256; u += G) { const int bh = u >> 3, s = u & 7, b = bh >> 3, h = bh & 7;
                for (int k = 0; k < 2; ++k) { const int qb = k ? 15 - s : s; const size_t row0 = (size_t)b * SEQ + 256 * qb;
                    attn_unit<192, 128, 128, false>(lds, QC + row0 * 1536 + h * 192, 1536, KN + (size_t)b * SEQ * 1024 + h * 128, 1024, KR + (size_t)b * SEQ * 64, 64,
                                                    VCT + (size_t)(h * 128) * KROWS + (size_t)b * SEQ, KROWS, nullptr, MIX + row0 * D + 1024 + h * 128, D, qb, tid_p); } } }
            if (EN(7)) REP(7) { FRESH(); for (int u = vcu; u < 256; u += G) { const int bh = u >> 3, s = u & 7, b = bh >> 3, h = bh & 7;
                for (int k = 0; k < 2; ++k) { const int qb = k ? 15 - s : s; const size_t row0 = (size_t)b * SEQ + 256 * qb;
                    attn_unit_deep<64, 64, 64, true>(lds, QA + row0 * 512 + h * 64, 512, KA + (size_t)b * SEQ * 512 + h * 64, 512, nullptr, 0,
                                                VAT + (size_t)(h * 64) * KROWS + (size_t)b * SEQ, KROWS, SEL + row0 * 64, MIX + row0 * D + h * 64, D, qb, tid_p); } } }
            if (EN(8)) REP(8) { FRESH(); for (int u = vcu; u < 2 * NBS * 8; u += G) { const int b = (u >> 3) & 15, h = u & 7; const size_t r0 = (size_t)MP + b * TS, kr0 = (size_t)MP + (size_t)b * SKEYS;
                if (u < NBS * 8) sattn_block<192, 128, 128, false>(lds, QC + r0 * 1536 + h * 192, 1536, KN + kr0 * 1024 + h * 128, 1024, KR + kr0 * 64, 64, VCT + (size_t)(h * 128) * KROWS + kr0, KROWS, nullptr, MIX + r0 * D + 1024 + h * 128, D, tid_p);
                else sattn_block<64, 64, 64, true>(lds, QA + r0 * 512 + h * 64, 512, KA + kr0 * 512 + h * 64, 512, nullptr, 0, VAT + (size_t)(h * 64) * KROWS + kr0, KROWS, SEL + r0 * 64, MIX + r0 * D + h * 64, D, tid_p); } }
        }
        SEAM(pb + 3);
        if (EN(9) && IN(pb + 4)) REP(9) { GEMM_PHASE(ws + WS_MIX, wl + WO_OUT, MP, D, D, ws + WS_T, D); GEMM_SPLIT(ws + WS_MIX + (size_t)MP * D * 2, wl + WO_OUT, D, D / SP_F, D, SP_F); }
        SEAM(pb + 4);
        if (EN(10) && IN(pb + 5)) REP(10) { FRESH();
            const bool dry = ((MK_REP >> 10) & 1u) && rep_ == 0;
            const bf16* Tb = (const bf16*)(ws + WS_T); bf16* Hb = dry ? (bf16*)(ws + WS_PROJ + 70 * MiB) : (bf16*)(ws + WS_H); bf16* Xo = dry ? (bf16*)(ws + WS_PROJ) : X;
            const float* lng = args.in[19] + (size_t)l * D; const float* lnb = args.in[20] + (size_t)l * D;
            for (int rs = vcu; rs < MS; rs += G) { const int r = MP + rs; const float* mod = MOD + ((size_t)l * NCOND + cond_idx(r)) * NMOD;
                if (rs != vcu) __syncthreads();
                ln_sample_coop<SP_F, false, true>(lds, X + (size_t)r * D, (const float*)(ws + WS_SLAB) + (size_t)rs * D, mod + 2 * D, lng, lnb, Xo + (size_t)r * D, nullptr, mod + 4 * D, mod + 3 * D, Hb + (size_t)r * D, tid_p); }
            for (int blk = vcu; blk < MP / 64; blk += G) { const int r0 = blk * 64; const float* mod = MOD + ((size_t)l * NCOND + cond_idx(r0)) * NMOD;
                __syncthreads(); ln_stage_vectors<true>(lds, mod + 2 * D, lng, lnb, mod + 4 * D, mod + 3 * D, tid_p); __syncthreads();
                ln_rows8<false, true>(lds, X, Tb, Xo, nullptr, Hb, (size_t)r0 + 8 * wave, lane_p); }
        }
        SEAM(pb + 5);
        if (EN(11) && IN(pb + 6)) REP(11) {
            { pg8::Gemm g_{(const bf16*)(ws + WS_H), (const bf16*)(wl + WO_GU), MP, NGU, D, D}; pg8::StaticOrder S_; S_.init(MP, NGU, G, bx);
              pg8::EpiAct E_{(bf16*)(ws + WS_ACT), DFF, (float*)(ws + WS_GH), (float*)(ws + WS_G01), args.in[24] + (size_t)l * 3 * DFF, (PG8_LAS float*)(lds + LDS_HALO)};
              pg8::gemm_phase<pg8::EpiAct, pg8::StaticOrder, true, true>(lds, g_, S_, E_, wave); }
            GEMM_SPLIT(ws + WS_H + (size_t)MP * D * 2, wl + WO_GU, NGU, D / SP_H, D, SP_H); }
        SEAM(pb + 6);
        if (EN(12) && IN(pb + 7)) REP(12) { FRESH(); for (int it = gw; it < (MP / 256) * 11; it += NGW) pi_fix(args, l, it, lane_p); for (int i = NGW - 1 - gw; i < MS * 11; i += NGW) pi_row(args, l, MP + i / 11, lane_p, i % 11, i % 11 + 1); }
        SEAM(pb + 7);
        if (EN(13) && IN(pb + 8)) REP(13) { GEMM_PHASE(ws + WS_ACT, wl + WO_DN, MP, D, DFF, ws + WS_T, D); GEMM_SPLIT(ws + WS_ACT + (size_t)MP * DFF * 2, wl + WO_DN, D, DFF / SP_J, DFF, SP_J); }
        SEAM(pb + 8);
        if (EN(14) && IN(pb + 9)) { FRESH();
            const bf16* Tb = (const bf16*)(ws + WS_T); bf16* Hb = (bf16*)(ws + WS_H); const bool more = l + 1 < NL;
            const float* lng = args.in[21] + (size_t)l * D; const float* lnb = args.in[22] + (size_t)l * D;
            for (int rs = vcu; rs < MS; rs += G) { const int r = MP + rs, m = cond_idx(r); const float* mod = MOD + ((size_t)l * NCOND + m) * NMOD; const float* modn = MOD + ((size_t)(more ? l + 1 : l) * NCOND + m) * NMOD;
                if (rs != vcu) __syncthreads();
                const float* sl = (const float*)(ws + WS_SLAB) + (size_t)rs * D;
                if (more) ln_sample_coop<SP_J, false, true>(lds, X + (size_t)r * D, sl, mod + 5 * D, lng, lnb, X + (size_t)r * D, nullptr, modn + D, modn, Hb + (size_t)r * D, tid_p);
                else ln_sample_coop<SP_J, true, false>(lds, X + (size_t)r * D, sl, mod + 5 * D, lng, lnb, nullptr, Y + (size_t)r * D, nullptr, nullptr, nullptr, tid_p); }
            for (int blk = vcu; blk < MP / 64; blk += G) { const int r0 = blk * 64, m = cond_idx(r0); const float* mod = MOD + ((size_t)l * NCOND + m) * NMOD; const float* modn = MOD + ((size_t)(more ? l + 1 : l) * NCOND + m) * NMOD;
                __syncthreads();
                if (more) { ln_stage_vectors<true>(lds, mod + 5 * D, lng, lnb, modn + D, modn, tid_p); __syncthreads(); ln_rows8<false, true>(lds, X, Tb, X, nullptr, Hb, (size_t)r0 + 8 * wave, lane_p); }
                else { ln_stage_vectors<false>(lds, mod + 5 * D, lng, lnb, nullptr, nullptr, tid_p); __syncthreads(); ln_rows8<true, false>(lds, X, Tb, nullptr, Y, nullptr, (size_t)r0 + 8 * wave, lane_p); } }
        }
        SEAM(pb + 9);
    }
#undef IN
#undef SEAM
#undef GEMM_PHASE
#undef GEMM_SPLIT
#undef GRID_BAR
}

extern "C" void kernel_launch(void* const* d_in, const int* in_sizes, int n_in, void* d_out, int out_size, void* d_ws, size_t ws_size, hipStream_t stream) {
    static int grid = 0;
    if (grid == 0) {
        if (n_in != 26 || (size_t)out_size != O_END || ws_size < WS_END || in_sizes[0] != MP * D || in_sizes[11] != NL * D * NIN) {
            fprintf(stderr, "kernel_launch: unexpected shapes (n_in %d, out %d, ws %zu); nothing launched\n", n_in, out_size, ws_size); grid = -1; return; }
        int dev = 0, cus = 0, per_cu = 0;
        if (hipGetDevice(&dev) != hipSuccess || hipDeviceGetAttribute(&cus, hipDeviceAttributeMultiprocessorCount, dev) != hipSuccess) { grid = -1; return; }
        if (hipFuncSetAttribute((const void*)mk_fwd, hipFuncAttributeMaxDynamicSharedMemorySize, LDS_BYTES) != hipSuccess) { fprintf(stderr, "kernel_launch: hipFuncSetAttribute failed\n"); grid = -1; return; }
        if (hipOccupancyMaxActiveBlocksPerMultiprocessor(&per_cu, (const void*)mk_fwd, 512, LDS_BYTES) != hipSuccess || per_cu < 1) fprintf(stderr, "kernel_launch: occupancy query reports %d\n", per_cu);
        (void)hipGetLastError();
        grid = cus;
    }
    if (grid < 0) return;
    if (hipMemsetAsync((char*)d_ws + WS_CTL, 0, CTL_ZERO_BYTES, stream) != hipSuccess) { fprintf(stderr, "kernel_launch: memset failed\n"); return; }
    Args a{};
    for (int i = 0; i < 26; ++i) a.in[i] = (const float*)d_in[i];
    a.out = (float*)d_out; a.ws = (unsigned char*)d_ws;
#if !MK_MULTI
    a.ph_lo = 0; a.ph_hi = N_PHASES;
    hipLaunchKernelGGL(mk_fwd, dim3(grid), dim3(512), LDS_BYTES, stream, a);
#else
    for (int p = 0; p < N_PHASES; ++p) { a.ph_lo = p; a.ph_hi = p + 1; hipLaunchKernelGGL(mk_fwd, dim3(grid), dim3(512), LDS_BYTES, stream, a); }
#endif
    const hipError_t le = hipPeekAtLastError();
    if (le != hipSuccess) fprintf(stderr, "kernel_launch: launch failed: %s\n", hipGetErrorName(le));
}
```

```cpp
#include <hip/hip_runtime.h>
#include <cstdio>
#include <cstdint>

#ifndef MK_MULTI
#define MK_MULTI 0
#endif

__device__ __forceinline__ int pg8_fresh_lane() { int l; asm volatile("v_mbcnt_lo_u32_b32 %0, -1, 0\n\tv_mbcnt_hi_u32_b32 %0, -1, %0" : "=v"(l)); return l; }
namespace pg8 {
#define PG8_LAS __attribute__((address_space(3)))
typedef unsigned short bf16_t;
typedef short bf16x8 __attribute__((ext_vector_type(8)));
typedef float f32x4 __attribute__((ext_vector_type(4)));
typedef unsigned u32x4 __attribute__((ext_vector_type(4)));
constexpr int BM = 256, BK = 64, HALF = 128, HTB = HALF * BK * 2  , STAGE_BYTES = 8 * HTB, NXCD = 8, WGM = 8;

__host__ __device__ __forceinline__ int lds_byte(int r, int c) { const int st = (r >> 4) * 2 + (c >> 5), rr = r & 15, cc = c & 31, ob = rr * 64 + cc * 2; return st * 1024 + (ob ^ (((ob >> 9) & 1) << 5)); }
__host__ __device__ __forceinline__ void stage_rc(int b, int& R, int& C) { const int st = b / 1024, sb = b % 1024, swz = sb ^ (((sb >> 9) & 1) << 5); R = (st >> 1) * 16 + swz / 64; C = (st & 1) * 32 + (swz % 64) / 2; }
__host__ __device__ __forceinline__ int perm32(int rho) { const int n = rho >> 4, i = rho & 15; return 8 * (i >> 2) + 4 * n + (i & 3); }

struct Unit { int pm, pn; };
struct Gemm { const bf16_t* A; const bf16_t* Bt; int M, N, K, ld; };

struct StaticOrder {
    int nM, nN, nwg, G, c;
    __host__ __device__ void init(int M, int N, int G_, int c_) { nM = M / BM; nN = N / BM; nwg = nM * nN; G = G_; c = c_; }
    __host__ __device__ bool next(int i, Unit& u) const {
        const long L = (long)i * G + c; if (L >= nwg) return false;
        int wgid = (int)L; { const int q = nwg / NXCD, r = nwg % NXCD, xcd = wgid % NXCD, off = wgid / NXCD; wgid = (xcd < r ? xcd * (q + 1) : r * (q + 1) + (xcd - r) * q) + off; }
        const int nig = WGM * nN, gid = wgid / nig, fm = gid * WGM, gsz = (nM - fm) < WGM ? (nM - fm) : WGM;
        u.pm = fm + ((wgid % nig) % gsz); u.pn = (wgid % nig) / gsz; return true;
    }
    __device__ __forceinline__ void a_ready(const Unit&) const {}
    __device__ __forceinline__ void done(const Unit&) const {}
};

__device__ __forceinline__ unsigned cvt_pk_bf16(float lo, float hi) { unsigned r; asm volatile("v_cvt_pk_bf16_f32 %0, %1, %2" : "=v"(r) : "v"(lo), "v"(hi)); return r; }

struct EpiStoreBf16 {
    static constexpr bool PERM = true, AFTER_DRAIN = false;
    bf16_t* O; int ldc;
    __device__ __forceinline__ void operator()(const f32x4 (&acc)[2][2][4][2], const Unit& u, int wr, int wc, int fr, int fq) const {
        const int row0 = u.pm * BM + wr * 64 + fr; const int col0 = u.pn * BM + wc * 32 + 8 * fq;
#pragma unroll
        for (int ai = 0; ai < 2; ++ai)
#pragma unroll
            for (int m = 0; m < 4; ++m) { bf16_t* rowp = O + (size_t)(row0 + ai * HALF + m * 16) * ldc + col0;
#pragma unroll
                for (int bj = 0; bj < 2; ++bj) { const f32x4 v0 = acc[ai][bj][m][0], v1 = acc[ai][bj][m][1];
                    u32x4 w; w.x = cvt_pk_bf16(v0[0], v0[1]); w.y = cvt_pk_bf16(v0[2], v0[3]); w.z = cvt_pk_bf16(v1[0], v1[1]); w.w = cvt_pk_bf16(v1[2], v1[3]);
                    *(u32x4*)(rowp + bj * HALF) = w; } }
    }
};
struct SplitOrder {
    int P, nwg, G, c;
    __host__ __device__ void init(int P_, int N, int G_, int c_) { P = P_; nwg = P_ * (N / BM); G = G_; c = c_; }
    __host__ __device__ bool next(int i, Unit& u) const { const long L = (long)i * G + c; if (L >= nwg) return false; u.pm = (int)(L % P); u.pn = (int)(L / P); return true; }
    __device__ __forceinline__ void a_ready(const Unit&) const {}
    __device__ __forceinline__ void done(const Unit&) const {}
};
struct EpiSlabF32 {
    static constexpr bool PERM = false, AFTER_DRAIN = false;
    float* S; int N;
    __device__ __forceinline__ void operator()(const f32x4 (&acc)[2][2][4][2], const Unit& u, int wr, int wc, int fr, int fq) const {
        const int row0 = wr * 64 + fr, col0 = u.pn * BM + wc * 32 + 4 * fq;
#pragma unroll
        for (int ai = 0; ai < 2; ++ai)
#pragma unroll
            for (int m = 0; m < 4; ++m) { float* rowp = S + ((size_t)u.pm * BM + row0 + ai * HALF + m * 16) * N + col0;
#pragma unroll
                for (int bj = 0; bj < 2; ++bj)
#pragma unroll
                    for (int n = 0; n < 2; ++n) *(f32x4*)(rowp + bj * HALF + n * 16) = acc[ai][bj][m][n]; }
    }
};

struct EpiAct {
    static constexpr bool PERM = true, AFTER_DRAIN = false;
    bf16_t* ACT; int dff;
    float* GH;
    float* G01;
    const float* cw;
    PG8_LAS float* halo;
    __device__ __forceinline__ void operator()(const f32x4 (&acc)[2][2][4][2], const Unit& u, int wr, int wc, int fr, int fq) const {
        const int chl = wc * 32 + 8 * fq, ch = u.pn * 128 + chl;
#pragma unroll
        for (int ai = 0; ai < 2; ++ai) if (fr >= 14) {
#pragma unroll
            for (int n = 0; n < 2; ++n) { *(PG8_LAS f32x4*)(halo + ((2 * ai + wr) * 2 + (fr - 14)) * 128 + chl + 4 * n) = acc[ai][0][3][n];
                if (ai == 1 && wr == 1) *(f32x4*)(GH + ((u.pm * 2 + (fr - 14)) * dff + ch + 4 * n)) = acc[ai][0][3][n]; } }
        asm volatile("s_waitcnt lgkmcnt(0)" ::: "memory"); __builtin_amdgcn_s_barrier(); asm volatile("" ::: "memory");
#pragma unroll
        for (int n = 0; n < 2; ++n) {
            const f32x4 w0 = *(const f32x4*)(cw + ch + 4 * n), w1 = *(const f32x4*)(cw + dff + ch + 4 * n), w2 = *(const f32x4*)(cw + 2 * dff + ch + 4 * n);
#pragma unroll
            for (int ai = 0; ai < 2; ++ai) {
                const int grp = 2 * ai + wr;
                f32x4 h14 = (f32x4){0.f, 0.f, 0.f, 0.f}, h15 = h14;
                if (grp > 0) { h14 = *(const PG8_LAS f32x4*)(halo + ((grp - 1) * 2 + 0) * 128 + chl + 4 * n); h15 = *(const PG8_LAS f32x4*)(halo + ((grp - 1) * 2 + 1) * 128 + chl + 4 * n); }
#pragma unroll
                for (int m = 0; m < 4; ++m) {
                    const f32x4 cur = acc[ai][0][m][n], upv = acc[ai][1][m][n]; f32x4 z;
#pragma unroll
                    for (int j = 0; j < 4; ++j) {
                        float t1, t2;
                        if (m > 0) { const int pv = __float_as_int(acc[ai][0][m - 1][n][j]);
                            t1 = __int_as_float(__builtin_amdgcn_update_dpp(pv, pv, 0x121, 0xf, 0xf, false)); t2 = __int_as_float(__builtin_amdgcn_update_dpp(pv, pv, 0x122, 0xf, 0xf, false)); }
                        else { t1 = h15[j]; t2 = (fr == 0) ? h14[j] : h15[j]; }
                        const int cv = __float_as_int(cur[j]);
                        const float g1 = __int_as_float(__builtin_amdgcn_update_dpp(__float_as_int(t1), cv, 0x111, 0xf, 0xf, false));
                        const float g2 = __int_as_float(__builtin_amdgcn_update_dpp(__float_as_int(t2), cv, 0x112, 0xf, 0xf, false));
                        const float gc = g2 * w0[j] + g1 * w1[j] + cur[j] * w2[j];
                        z[j] = gc * __builtin_amdgcn_rcpf(1.f + __expf(-gc)) * upv[j];
                    }
                    const int row = u.pm * BM + ai * HALF + wr * 64 + m * 16 + fr;
                    if (grp == 0 && m == 0 && fr < 2) {
                        *(f32x4*)(G01 + (((u.pm * 2 + fr) * 2 + 0) * dff + ch + 4 * n)) = cur;
                        *(f32x4*)(G01 + (((u.pm * 2 + fr) * 2 + 1) * dff + ch + 4 * n)) = upv;
                    } else {
                        unsigned w[2]; w[0] = cvt_pk_bf16(z[0], z[1]); w[1] = cvt_pk_bf16(z[2], z[3]);
                        *(unsigned long long*)(ACT + (size_t)row * dff + ch + 4 * n) = (unsigned long long)w[0] | ((unsigned long long)w[1] << 32);
                    }
                }
            }
        }
    }
};

struct EpiResid {
    static constexpr bool PERM = true, AFTER_DRAIN = false;
    bf16_t* X; int ldc; const float* gate_base; int gate_stride; float alpha;
    __device__ __forceinline__ void operator()(const f32x4 (&acc)[2][2][4][2], const Unit& u, int wr, int wc, int fr, int fq) const {
        const int row0 = u.pm * BM + wr * 64 + fr, col0 = u.pn * BM + wc * 32 + 8 * fq;
        const float* gp = gate_base + (size_t)(u.pm >> 4) * gate_stride + col0;
        f32x4 gv[2][2];
#pragma unroll
        for (int bj = 0; bj < 2; ++bj)
#pragma unroll
            for (int n = 0; n < 2; ++n) gv[bj][n] = *(const f32x4*)(gp + bj * HALF + 4 * n) + 1.f;
#pragma unroll
        for (int ai = 0; ai < 2; ++ai)
#pragma unroll
            for (int m = 0; m < 4; ++m) { bf16_t* rowp = X + (size_t)(row0 + ai * HALF + m * 16) * ldc + col0;
#pragma unroll
                for (int bj = 0; bj < 2; ++bj) { const u32x4 xw = *(const u32x4*)(rowp + bj * HALF);
                    const f32x4 x0 = (f32x4){__uint_as_float(xw.x << 16), __uint_as_float(xw.x & 0xffff0000u), __uint_as_float(xw.y << 16), __uint_as_float(xw.y & 0xffff0000u)};
                    const f32x4 x1 = (f32x4){__uint_as_float(xw.z << 16), __uint_as_float(xw.z & 0xffff0000u), __uint_as_float(xw.w << 16), __uint_as_float(xw.w & 0xffff0000u)};
                    const f32x4 v0 = x0 * alpha + gv[bj][0] * acc[ai][bj][m][0], v1 = x1 * alpha + gv[bj][1] * acc[ai][bj][m][1];
                    u32x4 w; w.x = cvt_pk_bf16(v0[0], v0[1]); w.y = cvt_pk_bf16(v0[2], v0[3]); w.z = cvt_pk_bf16(v1[0], v1[1]); w.w = cvt_pk_bf16(v1[2], v1[3]);
                    *(u32x4*)(rowp + bj * HALF) = w; } }
    }
};

struct EpiProj {
    static constexpr bool PERM = true, AFTER_DRAIN = false;
    bf16_t* PROJ; int ldp; bf16_t* QA; bf16_t* QI; bf16_t* QC; bf16_t* KA; bf16_t* KI; bf16_t* KR; float* WI; const float* rope; float qs_a, qs_c, wi_scale;
    float* o_ak; float* o_av; float* o_ik; float* o_kr;
    __device__ __forceinline__ void rope4(const f32x4& v0, const f32x4& v1, const f32x4& cs0, const f32x4& cs1, float sc, f32x4& lo, f32x4& hi) const {
        lo[0] = (v0[0] * cs0[0] - v0[1] * cs0[1]) * sc; hi[0] = (v0[0] * cs0[1] + v0[1] * cs0[0]) * sc;
        lo[1] = (v0[2] * cs0[2] - v0[3] * cs0[3]) * sc; hi[1] = (v0[2] * cs0[3] + v0[3] * cs0[2]) * sc;
        lo[2] = (v1[0] * cs1[0] - v1[1] * cs1[1]) * sc; hi[2] = (v1[0] * cs1[1] + v1[1] * cs1[0]) * sc;
        lo[3] = (v1[2] * cs1[2] - v1[3] * cs1[3]) * sc; hi[3] = (v1[2] * cs1[3] + v1[3] * cs1[2]) * sc; }
    static __device__ __forceinline__ void st4bf(bf16_t* p, const f32x4& v) { *(unsigned long long*)p = (unsigned long long)cvt_pk_bf16(v[0], v[1]) | ((unsigned long long)cvt_pk_bf16(v[2], v[3]) << 32); }
    __device__ __forceinline__ void operator()(const f32x4 (&acc)[2][2][4][2], const Unit& u, int wr, int wc, int fr, int fq) const {
        const int row0 = u.pm * BM + wr * 64 + fr, pn = u.pn;
        const int i0 = 16 * (wc & 1) + 4 * fq;
        if (pn >= 14 && pn < 24) {
            const int col0 = pn * BM + wc * 32 + 8 * fq;
#pragma unroll
            for (int ai = 0; ai < 2; ++ai)
#pragma unroll
                for (int m = 0; m < 4; ++m) { const int row = row0 + ai * HALF + m * 16; bf16_t* rowp = PROJ + (size_t)row * ldp + col0;
#pragma unroll
                    for (int bj = 0; bj < 2; ++bj) { const f32x4 v0 = acc[ai][bj][m][0], v1 = acc[ai][bj][m][1];
                        u32x4 w; w.x = cvt_pk_bf16(v0[0], v0[1]); w.y = cvt_pk_bf16(v0[2], v0[3]); w.z = cvt_pk_bf16(v1[0], v1[1]); w.w = cvt_pk_bf16(v1[2], v1[3]);
                        *(u32x4*)(rowp + bj * HALF) = w;
                        if (pn < 16) { float* op = o_av + (size_t)row * 512 + (pn - 14) * BM + bj * HALF + wc * 32 + 8 * fq; __builtin_nontemporal_store(v0, (f32x4*)op); __builtin_nontemporal_store(v1, (f32x4*)(op + 4)); } } }
        } else if (pn >= 6 && pn < 10) {
            const int d0 = wc * 32 + 8 * fq;
#pragma unroll
            for (int ai = 0; ai < 2; ++ai)
#pragma unroll
                for (int m = 0; m < 4; ++m) { bf16_t* rowp = QC + (size_t)(row0 + ai * HALF + m * 16) * 1536 + (2 * (pn - 6)) * 192 + d0;
#pragma unroll
                    for (int bj = 0; bj < 2; ++bj) { const f32x4 v0 = acc[ai][bj][m][0] * qs_c, v1 = acc[ai][bj][m][1] * qs_c;
                        u32x4 w; w.x = cvt_pk_bf16(v0[0], v0[1]); w.y = cvt_pk_bf16(v0[2], v0[3]); w.z = cvt_pk_bf16(v1[0], v1[1]); w.w = cvt_pk_bf16(v1[2], v1[3]);
                        *(u32x4*)(rowp + bj * 192) = w; } }
        } else if (pn == 24) {
#pragma unroll
            for (int ai = 0; ai < 2; ++ai)
#pragma unroll
                for (int m = 0; m < 4; ++m) { const int row = row0 + ai * HALF + m * 16; const float* cp = rope + ((size_t)(row & 4095) * 32 + i0) * 2;
                    const f32x4 cs0 = *(const f32x4*)cp, cs1 = *(const f32x4*)(cp + 4);
                    { f32x4 lo, hi; rope4(acc[ai][0][m][0], acc[ai][0][m][1], cs0, cs1, 1.f, lo, hi);
                      float* op = ((wc >> 1) ? o_kr : o_ik) + (size_t)row * 64 + i0; __builtin_nontemporal_store(lo, (f32x4*)op); __builtin_nontemporal_store(hi, (f32x4*)(op + 32));
                      bf16_t* kp = ((wc >> 1) ? KR : KI) + (size_t)row * 64 + i0; st4bf(kp, lo); st4bf(kp + 32, hi); }
                    if (wc == 0 && fq < 2) { float* wp = WI + (size_t)row * 16 + 8 * fq; *(f32x4*)wp = acc[ai][1][m][0] * wi_scale; *(f32x4*)(wp + 4) = acc[ai][1][m][1] * wi_scale; } }
        } else {
            bf16_t* dst; int pitch, hbase, hstride, coff; float sc;
            if (pn < 2) { dst = QA; pitch = 512; hbase = 4 * pn; hstride = 64; coff = 0; sc = qs_a; }
            else if (pn < 6) { dst = QI; pitch = 1024; hbase = 4 * (pn - 2); hstride = 64; coff = 0; sc = 1.f; }
            else if (pn < 12) { dst = QC; pitch = 1536; hbase = 4 * (pn - 10); hstride = 192; coff = 128; sc = qs_c; }
            else { dst = KA; pitch = 512; hbase = 4 * (pn - 12); hstride = 64; coff = 0; sc = 1.f; }
#pragma unroll
            for (int ai = 0; ai < 2; ++ai)
#pragma unroll
                for (int m = 0; m < 4; ++m) { const int row = row0 + ai * HALF + m * 16; const float* cp = rope + ((size_t)(row & 4095) * 32 + i0) * 2;
                    const f32x4 cs0 = *(const f32x4*)cp, cs1 = *(const f32x4*)(cp + 4);
#pragma unroll
                    for (int bj = 0; bj < 2; ++bj) { f32x4 lo, hi; rope4(acc[ai][bj][m][0], acc[ai][bj][m][1], cs0, cs1, sc, lo, hi);
                        const int hc = (hbase + 2 * bj + (wc >> 1)) * hstride + coff + i0;
                        bf16_t* hp = dst + (size_t)row * pitch + hc; st4bf(hp, lo); st4bf(hp + 32, hi);
                        if (pn >= 12) { float* op = o_ak + (size_t)row * 512 + hc; __builtin_nontemporal_store(lo, (f32x4*)op); __builtin_nontemporal_store(hi, (f32x4*)(op + 32)); } } }
        }
    }
};

template <class Epi, class Sched, bool ALIGN_EPI = false, bool SP2 = false, bool SPLITK = false>
__device__ __forceinline__ void gemm_phase(PG8_LAS unsigned char* lds, const Gemm g, const Sched& S, const Epi& E, const int wave_s) {
    int tid_ = wave_s * 64 + pg8_fresh_lane();
    const int tid = tid_, wid = __builtin_amdgcn_readfirstlane(tid >> 6), lane = tid & 63, wr = wid >> 2, wc = wid & 3, fr = lane & 15, fq = lane >> 4;
    const int K = g.ld, nt = g.K / BK;
    unsigned voffA[2], voffB[2];
#pragma unroll
    for (int i = 0; i < 2; ++i) { int R, C; stage_rc(tid * 16 + i * 8192, R, C); const int Rb = Epi::PERM ? ((R & ~31) + perm32(R & 31)) : R;
        voffA[i] = (unsigned)(R * K + C) * 2u; voffB[i] = (unsigned)(Rb * K + C) * 2u; }
    const size_t kstep = (size_t)(BK * 2);
    const size_t hstep = (size_t)HALF * K * 2;
    const size_t tstep = 2 * hstep;
    const unsigned ldsw = (unsigned)wid * 1024u;
    const int aoff = lds_byte(wr * 64 + fr, fq * 8), boff = lds_byte(wc * 32 + fr, fq * 8);
#define PG8_SA(b, h) (((b) * 2 + (h)) * HTB)
#define PG8_SB(b, h) ((4 + (b) * 2 + (h)) * HTB)
#define PG8_STAGE(bufoff, gbase, voff) do { _Pragma("unroll") for (int _i = 0; _i < 2; ++_i) \
        __builtin_amdgcn_global_load_lds((const unsigned*)((const char*)(gbase) + (voff)[_i]), (PG8_LAS unsigned*)(lds + (bufoff) + ldsw + _i * 8192), 16, 0, 0); } while (0)
#define PG8_LDA(dst, b, h) do { _Pragma("unroll") for (int m = 0; m < 4; ++m) _Pragma("unroll") for (int k = 0; k < 2; ++k) dst[m][k] = *(const PG8_LAS bf16x8*)(lds + PG8_SA(b, h) + aoff + m * 2048 + k * 1024); } while (0)
#define PG8_LDB(dst, b, h) do { _Pragma("unroll") for (int n = 0; n < 2; ++n) _Pragma("unroll") for (int k = 0; k < 2; ++k) dst[n][k] = *(const PG8_LAS bf16x8*)(lds + PG8_SB(b, h) + boff + n * 2048 + k * 1024); } while (0)
#define PG8_MMA(ai, bj, At, Bt) do { __builtin_amdgcn_s_setprio(1); _Pragma("unroll") for (int m = 0; m < 4; ++m) _Pragma("unroll") for (int n = 0; n < 2; ++n) _Pragma("unroll") for (int k = 0; k < 2; ++k) \
        acc[ai][bj][m][n] = __builtin_amdgcn_mfma_f32_16x16x32_bf16(Bt[n][k], At[m][k], acc[ai][bj][m][n], 0, 0, 0); __builtin_amdgcn_s_setprio(0); } while (0)
#define PG8_WAIT_V(n) asm volatile("s_waitcnt vmcnt(" #n ")" ::: "memory")
#define PG8_WAIT_L(n) asm volatile("s_waitcnt lgkmcnt(" #n ")" ::: "memory")
#define PG8_BAR __builtin_amdgcn_s_barrier()
#define PG8_SCHED __builtin_amdgcn_sched_barrier(0)
    Unit cur, nxt; int ui = 0;
    if (!S.next(0, cur)) return;
    f32x4 acc[2][2][4][2];
#pragma unroll
    for (int a = 0; a < 2; ++a)
#pragma unroll
        for (int b = 0; b < 2; ++b)
#pragma unroll
            for (int m = 0; m < 4; ++m)
#pragma unroll
                for (int n = 0; n < 2; ++n) acc[a][b][m][n] = (f32x4){0.f, 0.f, 0.f, 0.f};
    bf16x8 At[4][2], B0[2][2], B1[2][2];
    const size_t kpart = (size_t)g.K * 2;
    const char* cA = SPLITK ? (const char*)g.A + (size_t)cur.pm * kpart : (const char*)g.A + (size_t)cur.pm * tstep; const char* cB = (const char*)g.Bt + (size_t)cur.pn * tstep + (SPLITK ? (size_t)cur.pm * kpart : (size_t)0);
    S.a_ready(cur);
    if constexpr (SP2) {
        PG8_STAGE(PG8_SB(0, 0), cB, voffB); PG8_STAGE(PG8_SB(0, 1), cB + hstep, voffB); PG8_STAGE(PG8_SA(0, 0), cA, voffA); PG8_STAGE(PG8_SA(0, 1), cA + hstep, voffA);
        if (wr == 1) PG8_BAR;
        PG8_WAIT_V(2); PG8_BAR;
        PG8_STAGE(PG8_SB(1, 0), cB + kstep, voffB); PG8_STAGE(PG8_SA(1, 0), cA + kstep, voffA); PG8_STAGE(PG8_SB(1, 1), cB + hstep + kstep, voffB);
        PG8_WAIT_V(6); PG8_BAR;
    } else {
        PG8_STAGE(PG8_SB(0, 0), cB, voffB); PG8_STAGE(PG8_SA(0, 0), cA, voffA); PG8_STAGE(PG8_SB(0, 1), cB + hstep, voffB); PG8_STAGE(PG8_SA(0, 1), cA + hstep, voffA);
        if (wr == 1) PG8_BAR;
        PG8_WAIT_V(4); PG8_BAR;
        PG8_STAGE(PG8_SB(1, 0), cB + kstep, voffB); PG8_STAGE(PG8_SA(1, 0), cA + kstep, voffA); PG8_STAGE(PG8_SB(1, 1), cB + hstep + kstep, voffB);
        PG8_WAIT_V(6); PG8_BAR;
    }
    for (;;) {
        const bool has_next = S.next(ui + 1, nxt);
        const char* nA = has_next ? (SPLITK ? (const char*)g.A + (size_t)nxt.pm * kpart : (const char*)g.A + (size_t)nxt.pm * tstep) : cA; const char* nB = has_next ? (const char*)g.Bt + (size_t)nxt.pn * tstep + (SPLITK ? (size_t)nxt.pm * kpart : (size_t)0) : cB;
        for (int t = 0; t < nt; t += 2) {
            const bool last = (t == nt - 2);
            const char* a1 = cA + (size_t)(t + 1) * kstep;
            const char* a2 = last ? nA : cA + (size_t)(t + 2) * kstep; const char* b2 = last ? nB : cB + (size_t)(t + 2) * kstep;
            const char* a3 = a2 + kstep; const char* b3 = b2 + kstep;
            if (last && has_next) S.a_ready(nxt);
            if constexpr (SP2) {
            PG8_LDB(B0, 0, 0); PG8_LDB(B1, 0, 1); PG8_SCHED; PG8_LDA(At, 0, 0); PG8_STAGE(PG8_SA(1, 1), a1 + hstep, voffA);
            PG8_WAIT_V(8); PG8_WAIT_L(0); PG8_BAR; PG8_MMA(0, 0, At, B0); PG8_MMA(0, 1, At, B1); PG8_BAR; PG8_SCHED;
            PG8_LDA(At, 0, 1); PG8_STAGE(PG8_SB(0, 0), b2, voffB); PG8_STAGE(PG8_SB(0, 1), b2 + hstep, voffB); PG8_STAGE(PG8_SA(0, 0), a2, voffA);
            PG8_WAIT_V(8); PG8_WAIT_L(0); PG8_BAR; PG8_MMA(1, 0, At, B0); PG8_MMA(1, 1, At, B1); PG8_BAR; PG8_SCHED;
            PG8_LDB(B0, 1, 0); PG8_LDB(B1, 1, 1); PG8_SCHED; PG8_LDA(At, 1, 0); PG8_STAGE(PG8_SA(0, 1), a2 + hstep, voffA);
            PG8_WAIT_V(8); PG8_WAIT_L(0); PG8_BAR; PG8_MMA(0, 0, At, B0); PG8_MMA(0, 1, At, B1); PG8_BAR; PG8_SCHED;
            PG8_LDA(At, 1, 1); PG8_STAGE(PG8_SB(1, 0), b3, voffB); PG8_STAGE(PG8_SB(1, 1), b3 + hstep, voffB); PG8_STAGE(PG8_SA(1, 0), a3, voffA);
            PG8_WAIT_V(8); PG8_WAIT_L(0); PG8_BAR; PG8_MMA(1, 0, At, B0); PG8_MMA(1, 1, At, B1); PG8_BAR; PG8_SCHED;
            } else {
            PG8_LDB(B0, 0, 0); PG8_SCHED; PG8_LDA(At, 0, 0); PG8_STAGE(PG8_SA(1, 1), a1 + hstep, voffA);
            PG8_WAIT_L(8); PG8_BAR; PG8_WAIT_L(0); PG8_MMA(0, 0, At, B0); PG8_BAR; PG8_SCHED;
            PG8_LDB(B1, 0, 1); PG8_STAGE(PG8_SB(0, 0), b2, voffB);
            PG8_BAR; PG8_WAIT_L(0); PG8_MMA(0, 1, At, B1); PG8_BAR;
            PG8_LDA(At, 0, 1); PG8_STAGE(PG8_SA(0, 0), a2, voffA);
            PG8_BAR; PG8_WAIT_L(0); PG8_MMA(1, 0, At, B0); PG8_BAR; PG8_SCHED;
            PG8_STAGE(PG8_SB(0, 1), b2 + hstep, voffB);
            PG8_WAIT_V(6); PG8_BAR; PG8_MMA(1, 1, At, B1); PG8_BAR;
            PG8_LDB(B0, 1, 0); PG8_SCHED; PG8_LDA(At, 1, 0); PG8_STAGE(PG8_SA(0, 1), a2 + hstep, voffA);
            PG8_WAIT_L(8); PG8_BAR; PG8_WAIT_L(0); PG8_MMA(0, 0, At, B0); PG8_BAR; PG8_SCHED;
            PG8_LDB(B1, 1, 1); PG8_STAGE(PG8_SB(1, 0), b3, voffB);
            PG8_BAR; PG8_WAIT_L(0); PG8_MMA(0, 1, At, B1); PG8_BAR;
            PG8_LDA(At, 1, 1); PG8_STAGE(PG8_SA(1, 0), a3, voffA);
            PG8_BAR; PG8_WAIT_L(0); PG8_MMA(1, 0, At, B0); PG8_BAR; PG8_SCHED;
            PG8_STAGE(PG8_SB(1, 1), b3 + hstep, voffB);
            PG8_WAIT_V(6); PG8_BAR; PG8_MMA(1, 1, At, B1); PG8_BAR;
            }
        }
        if constexpr (ALIGN_EPI) { if (wr == 0) PG8_BAR; }
        if constexpr (!Epi::AFTER_DRAIN) { E(acc, cur, wr, wc, fr, fq); S.done(cur); }
        if (!has_next) break;
#pragma unroll
        for (int a = 0; a < 2; ++a)
#pragma unroll
            for (int b = 0; b < 2; ++b)
#pragma unroll
                for (int m = 0; m < 4; ++m)
#pragma unroll
                    for (int n = 0; n < 2; ++n) acc[a][b][m][n] = (f32x4){0.f, 0.f, 0.f, 0.f};
        cur = nxt; cA = nA; cB = nB; ++ui;
        if constexpr (ALIGN_EPI) { if (wr == 1) PG8_BAR; }
    }
    PG8_WAIT_V(0);
    if constexpr (!ALIGN_EPI) { if (wr == 0) PG8_BAR; }
    PG8_BAR;
    if constexpr (Epi::AFTER_DRAIN) { E.fused(acc, cur, wr, wc, fr, fq, lds, wid, lane); S.done(cur); }
#undef PG8_SA
#undef PG8_SB
#undef PG8_STAGE
#undef PG8_LDA
#undef PG8_LDB
#undef PG8_MMA
#undef PG8_WAIT_V
#undef PG8_WAIT_L
#undef PG8_BAR
#undef PG8_SCHED
}
}
#define GAS __attribute__((address_space(1)))
#define LAS __attribute__((address_space(3)))
typedef unsigned short bf16;
typedef unsigned v4u __attribute__((ext_vector_type(4)));
typedef float f32x4 __attribute__((ext_vector_type(4)));
typedef short bf16x8 __attribute__((ext_vector_type(8)));
typedef GAS unsigned gu32;
typedef GAS unsigned long long gu64;
#define RLX_AGENT __ATOMIC_RELAXED, __HIP_MEMORY_SCOPE_AGENT
#define LDS_WAIT() asm volatile("s_waitcnt lgkmcnt(0)" ::: "memory")
#define VM_WAIT() asm volatile("s_waitcnt vmcnt(0)" ::: "memory")
__device__ __forceinline__ unsigned long long rt() { return __builtin_amdgcn_s_memrealtime(); }
__device__ __forceinline__ unsigned f2bf(float f) { unsigned u = __builtin_bit_cast(unsigned, f); return (u + 0x7fffu + ((u >> 16) & 1u)) >> 16; }
__device__ __forceinline__ unsigned pk2(float lo, float hi) { return f2bf(lo) | (f2bf(hi) << 16); }

__device__ __forceinline__ int fresh_lane() { int l; asm volatile("v_mbcnt_lo_u32_b32 %0, -1, 0\n\tv_mbcnt_hi_u32_b32 %0, -1, %0" : "=v"(l)); return l; }
#define XB_TMO      128
#define XB_XCNT(j)  (256  + 64 * (j))
#define XB_XSUB(j)  (1280 + 64 * (j))
#define XB_XGEN(j)  (2304 + 64 * (j))
#define XB_TOP      3328
#define XB_TOPGEN   3392
#define XCD_BAR_WORDS 3456
#define XB_SPIN_CAP (1u << 18)

__device__ __forceinline__ unsigned xb_ld(unsigned* p)              { return __hip_atomic_load(p, __ATOMIC_RELAXED, __HIP_MEMORY_SCOPE_AGENT); }
__device__ __forceinline__ unsigned xb_add(unsigned* p, unsigned v) { return __hip_atomic_fetch_add(p, v, __ATOMIC_RELAXED, __HIP_MEMORY_SCOPE_AGENT); }
__device__ __forceinline__ unsigned xb_xcc_id() { return (unsigned)__builtin_amdgcn_s_getreg((3 << 11) | 20) & 0xFu; }
#define XB_SPIN(cond, bar) do { unsigned _sp = 0; while (cond) { __builtin_amdgcn_s_sleep(1); \
    if ((++_sp & 255u) == 0u) { if (xb_ld(&(bar)[XB_TMO])) break; if (_sp > XB_SPIN_CAP) { atomicAdd(&(bar)[XB_TMO], 1u); break; } } } } while (0)

struct XcdBarrier {
    unsigned* bar; unsigned x;
    volatile LAS unsigned* st;
};

__device__ __forceinline__ XcdBarrier xcd_barrier_post(unsigned* bar, volatile LAS unsigned* st) {
    XcdBarrier b; b.bar = bar; b.x = xb_xcc_id(); b.st = st;
    if (threadIdx.x == 0) (void)xb_add(&bar[XB_XCNT(b.x)], 1u);
    return b;
}
__device__ __forceinline__ void xcd_barrier_complete(unsigned* bar, unsigned x, unsigned& nloc, unsigned& nx) {
    const unsigned G = gridDim.x * gridDim.y * gridDim.z;
    unsigned sum, cnt, mine, sp = 0u;
    for (;;) {
        sum = 0u; cnt = 0u; mine = 0u;
#pragma unroll
        for (unsigned j = 0; j < 16; ++j) { const unsigned c = xb_ld(&bar[XB_XCNT(j)]); sum += c; cnt += (c > 0u) ? 1u : 0u; mine = (j == x) ? c : mine; }
        if (sum == G) break;
        __builtin_amdgcn_s_sleep(1);
        if ((++sp & 255u) == 0u) { if (xb_ld(&bar[XB_TMO])) break; if (sp > XB_SPIN_CAP) { atomicAdd(&bar[XB_TMO], 1u); break; } }
    }
    nloc = mine > 0u ? mine : 1u; nx = cnt > 0u ? cnt : 1u;
}

__device__ __forceinline__ void xcd_barrier(const XcdBarrier& b, const int wave_s) {
    asm volatile("s_waitcnt vmcnt(0)" ::: "memory");
    __syncthreads();
    if (wave_s == 0 && pg8_fresh_lane() == 0) {
        unsigned* bar = b.bar;
        __builtin_amdgcn_s_waitcnt(0);
        unsigned nloc = b.st[0], nx = b.st[1];
        if (nloc == 0u) { xcd_barrier_complete(bar, b.x, nloc, nx); b.st[0] = nloc; b.st[1] = nx; }
        const unsigned old = xb_add(&bar[XB_XSUB(b.x)], 1u);
        const unsigned gen = old / nloc;
        if (old + 1u == (gen + 1u) * nloc) {
            __builtin_amdgcn_fence(__ATOMIC_RELEASE, "agent");
            asm volatile("s_waitcnt vmcnt(0)" ::: "memory");
            const unsigned og = xb_add(&bar[XB_TOP], 1u);
            const unsigned tg = og / nx;
            if (og + 1u == (tg + 1u) * nx) xb_add(&bar[XB_TOPGEN], 1u);
            else XB_SPIN(xb_ld(&bar[XB_TOPGEN]) == tg, bar);
            __builtin_amdgcn_fence(__ATOMIC_ACQUIRE, "agent");
            xb_add(&bar[XB_XGEN(b.x)], 1u);
            asm volatile("s_waitcnt vmcnt(0)" ::: "memory");
        } else {
            XB_SPIN(xb_ld(&bar[XB_XGEN(b.x)]) == gen, bar);
            __builtin_amdgcn_fence(__ATOMIC_ACQUIRE, "agent");
            asm volatile("s_waitcnt vmcnt(0)" ::: "memory");
        }
    }
    __syncthreads();
}

typedef unsigned short bf16;
typedef float f32x2 __attribute__((ext_vector_type(2)));
typedef float f32x4 __attribute__((ext_vector_type(4)));
typedef float f32x16 __attribute__((ext_vector_type(16)));
typedef short bf16x8 __attribute__((ext_vector_type(8)));
typedef unsigned u32x2 __attribute__((ext_vector_type(2)));
typedef unsigned u32x4 __attribute__((ext_vector_type(4)));

constexpr int NL = 4, D = 2048, SEQ = 4096, NBP = 4, MP = 16384, NBS = 16, TS = 16, MS = 256, M = 16640, PAST = 1024, SKEYS = 1040;
constexpr int NIN = 6288, NINP = 6400, DFF = 5632, NGU = 11264, NMOD = 12288, NCOND = 20, KROWS = 33024;
constexpr int C_QA = 0, C_QI = 512, C_QCN = 1536, C_QCR = 2560, C_KA = 3072, C_VA = 3584, C_BG = 4096, C_CG = 4608, C_XB = 5120, C_LAT = 5632, C_KI = 6144, C_KR = 6208, C_WI = 6272;
__host__ __device__ __forceinline__ int win_il(int d) { return d < 32 ? 2 * d : 2 * (d - 32) + 1; }
__host__ __device__ __forceinline__ int win_row(int n) {
    if (n < 512) return (n & ~63) + win_il(n & 63);
    if (n < 1024) { const int i = n - 512; return C_KA + (i & ~63) + win_il(i & 63); }
    if (n < 1536) return C_VA + (n - 1024);
    if (n < 2560) { const int i = n - 1536; return C_QI + (i & ~63) + win_il(i & 63); }
    if (n < 2624) return C_KI + win_il(n - 2560);
    if (n < 2640) return C_WI + (n - 2624);
    if (n < 3152) return C_BG + (n - 2640);
    if (n < 3664) return C_CG + (n - 3152);
    if (n < 4176) return C_XB + (n - 3664);
    if (n < 5712) { const int i = n - 4176, h = i / 192, o = i - h * 192; return o < 128 ? C_QCN + h * 128 + o : C_QCR + h * 64 + win_il(o - 128); }
    if (n < 6224) return C_LAT + (n - 5712);
    if (n < 6288) return C_KR + win_il(n - 6224);
    return n;
}
constexpr float ALPHA_RES = 1.681792830507429f;
constexpr float LN_EPS = 1e-5f, RMS_EPS = 1e-6f;
constexpr float LOG2E = 1.4426950408889634f;
constexpr float QS_A = 0.125f * LOG2E;
constexpr float QS_C = 0.07216878364870322f * LOG2E;
constexpr float WI_SCALE = 0.25f * 0.125f;

constexpr size_t O_Y = 0, O_PAK = 34078720, O_PAV = 67633152, O_PIK = 101187584, O_PLAT = 105381888, O_PKR = 138936320, O_PCB = 143130624, O_PCF = 143147008,
                 O_SAK = 143327232, O_SAV = 143851520, O_SIK = 144375808, O_SLAT = 144441344, O_SKR = 144965632, O_SCB = 145031168, O_SCF = 145096704, O_END = 145817600;

constexpr size_t MiB = 1u << 20;
constexpr size_t WS_CTL = 0, CTL_ZERO_BYTES = 1 * MiB;
constexpr size_t WS_ROPE = 1 * MiB;
constexpr size_t WS_MOD = 2 * MiB;
constexpr size_t WS_WI = 6 * MiB;
constexpr size_t WS_W = 8 * MiB, W_LAYER = 101 * MiB;
constexpr size_t WO_IN = 0, WO_OUT = 25 * MiB, WO_GU = 33 * MiB, WO_DN = 77 * MiB, WO_UK = 99 * MiB, WO_UV = 100 * MiB;
constexpr size_t WS_H = 412 * MiB;
constexpr size_t WS_T = 477 * MiB;
constexpr size_t WS_MIX = 542 * MiB;
constexpr size_t WS_ACT = 607 * MiB;
constexpr size_t WS_PROJ = 786 * MiB;
constexpr size_t WS_QA = 990 * MiB;
constexpr size_t WS_KA = 1007 * MiB;
constexpr size_t WS_VAT = 1040 * MiB;
constexpr size_t WS_QI = 1073 * MiB;
constexpr size_t WS_KI = 1106 * MiB;
constexpr size_t WS_QC = 1111 * MiB;
constexpr size_t WS_LAT = 1160 * MiB;
constexpr size_t WS_KR = 1193 * MiB;
constexpr size_t WS_KN = 1198 * MiB;
constexpr size_t WS_VCT = 1263 * MiB;
constexpr size_t WS_SEL = 1328 * MiB;
constexpr size_t WS_GU = 786 * MiB;
constexpr size_t WS_SLAB = 1337 * MiB;
constexpr size_t WS_X = 1387 * MiB;
constexpr size_t WS_GH = 1452 * MiB;
constexpr size_t WS_G01 = 1455 * MiB;
constexpr size_t WS_END = 1461 * MiB;
static_assert(WS_GH + (size_t)64 * 2 * DFF * 4 <= WS_G01 && WS_G01 + (size_t)64 * 4 * DFF * 4 <= WS_END, "ws map 6");
constexpr int LDS_HALO = 131072;
constexpr int SP_A = 4, SP_F = 4, SP_H = 4, SP_J = 11;
static_assert(WS_GU + (size_t)M * NGU * 2 <= WS_LAT, "GU overlay must stay clear of buffers that are live later");
static_assert(WS_PROJ + (size_t)M * NINP * 2 <= WS_QA && WS_KA + (size_t)KROWS * 512 * 2 <= WS_VAT && WS_VAT + (size_t)KROWS * 512 * 2 <= WS_QI && WS_QI + (size_t)M * 1024 * 2 <= WS_KI, "ws map 1");
static_assert(WS_KI + (size_t)KROWS * 64 * 2 <= WS_QC && WS_QC + (size_t)M * 1536 * 2 <= WS_LAT && WS_LAT + (size_t)KROWS * 512 * 2 <= WS_KR && WS_KR + (size_t)KROWS * 64 * 2 <= WS_KN, "ws map 2");
static_assert(WS_KN + (size_t)KROWS * 1024 * 2 <= WS_VCT && WS_VCT + (size_t)KROWS * 1024 * 2 <= WS_SEL && WS_SEL + (size_t)M * 512 <= WS_END, "ws map 3");
static_assert(WS_ACT + (size_t)M * DFF * 2 <= WS_PROJ && WS_MIX + (size_t)M * D * 2 <= WS_ACT && WS_T + (size_t)M * D * 2 <= WS_MIX && WS_H + (size_t)M * D * 2 <= WS_T && WS_W + 4 * W_LAYER <= WS_H, "ws map 4");
static_assert(WS_QA + (size_t)M * 512 * 2 <= WS_KA && WS_WI + (size_t)M * 16 * 4 <= WS_W && WS_MOD + (size_t)NL * NCOND * NMOD * 4 <= WS_WI, "ws map 5");

constexpr int CW_TICKET = 1024;
constexpr int CW_BAR = 4096;
constexpr int LDS_RING = 131072, LDS_CTL = 155648, LDS_MISC = LDS_CTL + 320, LDS_BYTES = 163840;

#ifndef MK_REP
#define MK_REP 0u
#endif
__device__ __forceinline__ float bflo(unsigned w) { return __uint_as_float(w << 16); }
__device__ __forceinline__ float bfhi(unsigned w) { return __uint_as_float(w & 0xffff0000u); }
typedef __bf16 bf16x2_t __attribute__((ext_vector_type(2)));
__device__ __forceinline__ unsigned cvtpk(float lo, float hi) { const f32x2 v = {lo, hi}; const bf16x2_t b = __builtin_convertvector(v, bf16x2_t); return __builtin_bit_cast(unsigned, b); }
__device__ __forceinline__ void unpack8(const u32x4 w, float (&f)[8]) { f[0] = bflo(w.x); f[1] = bfhi(w.x); f[2] = bflo(w.y); f[3] = bfhi(w.y); f[4] = bflo(w.z); f[5] = bfhi(w.z); f[6] = bflo(w.w); f[7] = bfhi(w.w); }
__device__ __forceinline__ u32x4 pack8(const float (&f)[8]) { u32x4 w; w.x = cvtpk(f[0], f[1]); w.y = cvtpk(f[2], f[3]); w.z = cvtpk(f[4], f[5]); w.w = cvtpk(f[6], f[7]); return w; }
__device__ __forceinline__ u32x4 ld16(const void* p) { return *(const u32x4*)p; }
__device__ __forceinline__ void st16(void* p, u32x4 v) { *(u32x4*)p = v; }
__device__ __forceinline__ void ld8f(const float* p, float (&f)[8]) { const f32x4 a = *(const f32x4*)p, b = *(const f32x4*)(p + 4); f[0] = a.x; f[1] = a.y; f[2] = a.z; f[3] = a.w; f[4] = b.x; f[5] = b.y; f[6] = b.z; f[7] = b.w; }
__device__ __forceinline__ void st8f(float* p, const float (&f)[8]) { *(f32x4*)p = (f32x4){f[0], f[1], f[2], f[3]}; *(f32x4*)(p + 4) = (f32x4){f[4], f[5], f[6], f[7]}; }
__device__ __forceinline__ void st8f_nt(float* p, const float (&f)[8]) { __builtin_nontemporal_store((f32x4){f[0], f[1], f[2], f[3]}, (f32x4*)p); __builtin_nontemporal_store((f32x4){f[4], f[5], f[6], f[7]}, (f32x4*)(p + 4)); }
__device__ __forceinline__ void ld8f_nt(const float* p, float (&f)[8]) { const f32x4 a = __builtin_nontemporal_load((const f32x4*)p), b = __builtin_nontemporal_load((const f32x4*)(p + 4)); f[0] = a.x; f[1] = a.y; f[2] = a.z; f[3] = a.w; f[4] = b.x; f[5] = b.y; f[6] = b.z; f[7] = b.w; }
__device__ __forceinline__ u32x4 shx4(u32x4 w, int m) { u32x4 o; o.x = __shfl_xor(w.x, m); o.y = __shfl_xor(w.y, m); o.z = __shfl_xor(w.z, m); o.w = __shfl_xor(w.w, m); return o; }
__device__ __forceinline__ float wave_sum(float v) {
#pragma unroll
    for (int o = 1; o < 64; o <<= 1) v += __shfl_xor(v, o);
    return v;
}
__device__ __forceinline__ float wave_max(float v) {
#pragma unroll
    for (int o = 1; o < 64; o <<= 1) v = fmaxf(v, __shfl_xor(v, o));
    return v;
}
__device__ __forceinline__ int cond_idx(int r) { return r < MP ? (r >> 12) : 4 + ((r - MP) >> 4); }
template <int P> __device__ __forceinline__ void slab_ld8(const float* S, int N, int rs, int col, float (&f)[8]) {
    ld8f(S + (size_t)rs * N + col, f);
#pragma unroll
    for (int p = 1; p < P; ++p) { float t[8]; ld8f(S + ((size_t)p * 256 + rs) * N + col, t);
#pragma unroll
        for (int i = 0; i < 8; ++i) f[i] += t[i]; }
}
#define LDS_WAIT() asm volatile("s_waitcnt lgkmcnt(0)" ::: "memory")

struct Args { const float* in[26]; float* out; unsigned char* ws; int ph_lo, ph_hi; };
static_assert(sizeof(Args) == 26 * 8 + 8 + 8 + 8, "Args has no padding");

template <int MODE = 0  > __device__ __forceinline__ void p0_transpose_item(const float* W, int K, int N, int nblk, bf16* WT, LAS float* scr, int item, int lane) {
    const int kb = item / nblk, nb = item % nblk, k0 = 64 * kb, n0 = 32 * nb;
    constexpr bool GU = MODE == 1;
    const int r0 = GU ? ((n0 < DFF) ? 256 * (n0 / 128) + n0 % 128 : 256 * ((n0 - DFF) / 128) + 128 + (n0 - DFF) % 128) : n0;
    const int k8 = lane >> 3, n4 = lane & 7; const bool ok = n0 + 4 * n4 < N;
    f32x4 wv[8];
#pragma unroll
    for (int i = 0; i < 8; ++i) wv[i] = ok ? __builtin_nontemporal_load((const f32x4*)(W + (size_t)(k0 + 8 * i + k8) * N + n0 + 4 * n4)) : (f32x4){0.f, 0.f, 0.f, 0.f};
#pragma unroll
    for (int i = 0; i < 8; ++i) { LAS float* d = scr + (8 * i + k8) * 33 + 4 * n4; d[0] = wv[i].x; d[1] = wv[i].y; d[2] = wv[i].z; d[3] = wv[i].w; }
    LDS_WAIT(); asm volatile("" ::: "memory");
    const int c = lane & 7;
#pragma unroll
    for (int j = 0; j < 4; ++j) { const int nn = (lane >> 3) + 8 * j; const LAS float* s = scr + (8 * c) * 33 + nn;
        u32x4 o; o.x = cvtpk(s[0 * 33], s[1 * 33]); o.y = cvtpk(s[2 * 33], s[3 * 33]); o.z = cvtpk(s[4 * 33], s[5 * 33]); o.w = cvtpk(s[6 * 33], s[7 * 33]);
        const int rowd = (MODE == 2) ? win_row(n0 + nn) : r0 + nn;
        *(u32x4*)(WT + (size_t)rowd * K + k0 + 8 * c) = o; }
    LDS_WAIT(); asm volatile("" ::: "memory");
}

struct TItem { const float* W; bf16* WT; int K, N, nblk, mode, r; };
__device__ __forceinline__ void p0_tload(const TItem& t, int lane, f32x4 (&wv)[8]) {
    const int kb = t.r / t.nblk, nb = t.r - kb * t.nblk, k0 = 64 * kb, n0 = 32 * nb, k8 = lane >> 3, n4 = lane & 7;
    const int col = (n0 + 4 * n4 < t.N) ? n0 + 4 * n4 : 0;
#pragma unroll
    for (int i = 0; i < 8; ++i) wv[i] = __builtin_nontemporal_load((const f32x4*)(t.W + (size_t)(k0 + 8 * i + k8) * t.N + col));
}
__device__ __forceinline__ void p0_tstore(const TItem& t, int lane, const f32x4 (&wv)[8], LAS float* scr) {
    const int kb = t.r / t.nblk, nb = t.r - kb * t.nblk, k0 = 64 * kb, n0 = 32 * nb, k8 = lane >> 3, n4 = lane & 7; const bool ok = n0 + 4 * n4 < t.N;
    const int r0 = (t.mode == 1) ? ((n0 < DFF) ? 256 * (n0 / 128) + n0 % 128 : 256 * ((n0 - DFF) / 128) + 128 + (n0 - DFF) % 128) : n0;
#pragma unroll
    for (int i = 0; i < 8; ++i) { LAS float* d = scr + (8 * i + k8) * 33 + 4 * n4; d[0] = ok ? wv[i].x : 0.f; d[1] = ok ? wv[i].y : 0.f; d[2] = ok ? wv[i].z : 0.f; d[3] = ok ? wv[i].w : 0.f; }
    LDS_WAIT(); asm volatile("" ::: "memory");
    const int c = lane & 7;
#pragma unroll
    for (int j = 0; j < 4; ++j) { const int nn = (lane >> 3) + 8 * j; const LAS float* s = scr + (8 * c) * 33 + nn;
        u32x4 o; o.x = cvtpk(s[0 * 33], s[1 * 33]); o.y = cvtpk(s[2 * 33], s[3 * 33]); o.z = cvtpk(s[4 * 33], s[5 * 33]); o.w = cvtpk(s[6 * 33], s[7 * 33]);
        const int rowd = (t.mode == 2) ? win_row(n0 + nn) : r0 + nn;
        *(u32x4*)(t.WT + (size_t)rowd * t.K + k0 + 8 * c) = o; }
    LDS_WAIT(); asm volatile("" ::: "memory");
}
__device__ __forceinline__ TItem p0_decode(const Args& a, int it) {
    constexpr int I_IN = 32 * 200, I_OUT = 32 * 64, I_GU = 32 * 352, I_DN = 88 * 64, I_UK = 8 * 32, I_UV = 8 * 32, I_L = I_IN + I_OUT + I_GU + I_DN + I_UK + I_UV;
    const int l = it / I_L; int r = it - l * I_L; unsigned char* wl = a.ws + WS_W + (size_t)l * W_LAYER;
    if (r < I_IN) return TItem{a.in[11] + (size_t)l * D * NIN, (bf16*)(wl + WO_IN), D, NIN, 200, 2, r}; r -= I_IN;
    if (r < I_OUT) return TItem{a.in[12] + (size_t)l * D * D, (bf16*)(wl + WO_OUT), D, D, 64, 0, r}; r -= I_OUT;
    if (r < I_GU) return TItem{a.in[23] + (size_t)l * D * NGU, (bf16*)(wl + WO_GU), D, NGU, 352, 1, r}; r -= I_GU;
    if (r < I_DN) return TItem{a.in[25] + (size_t)l * DFF * D, (bf16*)(wl + WO_DN), DFF, D, 64, 0, r}; r -= I_DN;
    if (r < I_UK) return TItem{a.in[15] + (size_t)l * 512 * 1024, (bf16*)(wl + WO_UK), 512, 1024, 32, 0, r}; r -= I_UK;
    return TItem{a.in[16] + (size_t)l * 512 * 1024, (bf16*)(wl + WO_UV), 512, 1024, 32, 0, r};
}

__device__ __forceinline__ void p0a_prologue(const Args& a, LAS unsigned char* lds, int tid, int lane, int wave, int vcu, int G) {
    unsigned char* ws = a.ws;
    {
        f32x2* rope = (f32x2*)(ws + WS_ROPE);
        for (int e = (vcu * 8 + wave) * 64 + lane; e < 4096 * 32; e += G * 512) {
            const int pos = e >> 5, i = e & 31;
            double inv = 1.0; for (int q = 0; q < i; ++q) inv *= 0.74989420933245582730;
            const float ang = (float)pos * (float)inv;
            double x = (double)ang * 0.15915494309189533577; x -= __builtin_rint(x);
            const float xf = (float)x;
            rope[e] = (f32x2){__builtin_amdgcn_cosf(xf), __builtin_amdgcn_sinf(xf)};
        }
    }
    {
        LAS float* tab = (LAS float*)lds;
        LAS float* red = (LAS float*)(lds + 81920);
        LAS float* part = (LAS float*)(lds + 122880);
        float* MOD = (float*)(ws + WS_MOD);
        const int nq = (vcu < 768) ? (768 - vcu + G - 1) / G : 0, g = lane >> 4, c4 = (lane & 15) * 4;
        for (int qb = 0; qb < nq; qb += 3) {
            for (int half = 0; half < 2; ++half) {
                __syncthreads();
                for (int e = tid; e < 20 * 1024; e += 512) { const int m = e >> 10, k = (e & 1023) + half * 1024;
                    const float c = (m < 4) ? a.in[2][m * D + k] : a.in[3][(m - 4) * D + k]; tab[e] = c / (1.f + __expf(-c)); }
                __syncthreads();
                for (int qi = 0; qi < 3 && qb + qi < nq; ++qi) {
                    const int it = vcu + (qb + qi) * G, l = it / 192, strip = it % 192, k0 = wave * 128;
                    const __amdgpu_buffer_rsrc_t rw = __builtin_amdgcn_make_buffer_rsrc((void*)(a.in[17] + (size_t)l * D * NMOD + (size_t)(half * 1024 + k0) * NMOD + strip * 64), 0, 0x7fffffff, 0x00020000);
                    const int wvo = (8 * g * NMOD + c4) * 4;
                    f32x4 acc[20];
#pragma unroll
                    for (int m = 0; m < 20; ++m) acc[m] = (f32x4){0.f, 0.f, 0.f, 0.f};
                    u32x4 wa[8], wb[8];
#define P0_WLD(dst, step) do { _Pragma("unroll") for (int i = 0; i < 8; ++i) dst[i] = __builtin_amdgcn_raw_buffer_load_b128(rw, wvo, ((step) * 32 + i) * (NMOD * 4), 0); } while (0)
#define P0_WF(v) ((f32x4){__uint_as_float((v).x), __uint_as_float((v).y), __uint_as_float((v).z), __uint_as_float((v).w)})
#define P0_WFMA(src, step) do { _Pragma("unroll") for (int m = 0; m < 20; ++m) { const LAS float* tp = tab + m * 1024 + k0 + (step) * 32 + 8 * g; const f32x4 t0 = *(const LAS f32x4*)tp, t1 = *(const LAS f32x4*)(tp + 4); \
                            acc[m] += t0.x * P0_WF(src[0]) + t0.y * P0_WF(src[1]) + t0.z * P0_WF(src[2]) + t0.w * P0_WF(src[3]) + t1.x * P0_WF(src[4]) + t1.y * P0_WF(src[5]) + t1.z * P0_WF(src[6]) + t1.w * P0_WF(src[7]); } } while (0)
                    P0_WLD(wa, 0);
#pragma unroll 1
                    for (int st = 0; st < 4; st += 2) {
                        P0_WLD(wb, st + 1);
                        P0_WFMA(wa, st);
                        P0_WLD(wa, (st + 2 < 4 ? st + 2 : st));
                        P0_WFMA(wb, st + 1);
                    }
#undef P0_WLD
#undef P0_WF
#undef P0_WFMA
#pragma unroll
                    for (int m = 0; m < 20; ++m) {
#pragma unroll
                        for (int e = 0; e < 4; ++e) { float v = acc[m][e]; v += __shfl_xor(v, 16); v += __shfl_xor(v, 32); acc[m][e] = v; }
                        if (g == 0) *(LAS f32x4*)(red + (wave * 20 + m) * 64 + c4) = acc[m]; }
                    __syncthreads();
                    for (int e = tid; e < 20 * 64; e += 512) { const int m = e >> 6, ln = e & 63; float sum = 0.f;
#pragma unroll
                        for (int w8 = 0; w8 < 8; ++w8) sum += red[(w8 * 20 + m) * 64 + ln];
                        if (half == 0) part[qi * 1280 + e] = sum;
                        else MOD[((size_t)l * NCOND + m) * NMOD + strip * 64 + ln] = sum + part[qi * 1280 + e] + a.in[18][(size_t)l * NMOD + strip * 64 + ln]; }
                    __syncthreads();
                }
            }
        }
        __syncthreads();
    }
    {
        LAS float* scr = (LAS float*)(lds + wave * 16384);
        const int gw = vcu * 8 + wave, NGW = G * 8;
        constexpr int I_TOT = NL * (32 * 200 + 32 * 64 + 32 * 352 + 88 * 64 + 8 * 32 + 8 * 32);
        if (gw < I_TOT) {
            f32x4 wa[8], wb[8];
            p0_tload(p0_decode(a, gw), lane, wa);
            for (int it = gw; it < I_TOT; it += 2 * NGW) {
                const int i1 = it + NGW, i2 = it + 2 * NGW; const bool h1 = i1 < I_TOT;
                const TItem t0 = p0_decode(a, it), t1 = p0_decode(a, h1 ? i1 : it), t2 = p0_decode(a, i2 < I_TOT ? i2 : it);
                p0_tload(t1, lane, wb);
                p0_tstore(t0, lane, wa, scr);
                p0_tload(t2, lane, wa);
                if (h1) p0_tstore(t1, lane, wb, scr);
            }
        }
    }
}

__device__ __forceinline__ void modulate_row(const float* xrow, const float* sc, const float* sh, bf16* hrow, bf16* xbrow, int lane) {
#pragma unroll
    for (int j = 0; j < 8; ++j) { const int col = 4 * lane + 256 * j;
        const f32x4 x = __builtin_nontemporal_load((const f32x4*)(xrow + col)), s = *(const f32x4*)(sc + col), h = *(const f32x4*)(sh + col);
        const f32x4 o = x * (1.f + s) + h; u32x2 w; w.x = cvtpk(o.x, o.y); w.y = cvtpk(o.z, o.w); *(u32x2*)(hrow + col) = w;
        u32x2 xw; xw.x = cvtpk(x.x, x.y); xw.y = cvtpk(x.z, x.w); *(u32x2*)(xbrow + col) = xw; }
}
__device__ __forceinline__ void p0b_h0(const Args& a, int lane, int gw, int NGW) {
    const float* MOD = (const float*)(a.ws + WS_MOD); bf16* H = (bf16*)(a.ws + WS_H); bf16* XB = (bf16*)(a.ws + WS_X);
    for (int r = gw; r < M; r += NGW) {
        const float* xrow = r < MP ? a.in[0] + (size_t)r * D : a.in[1] + (size_t)(r - MP) * D;
        const float* mod = MOD + (size_t)cond_idx(r) * NMOD;
        modulate_row(xrow, mod + D, mod, H + (size_t)r * D, XB + (size_t)r * D, lane);
    }
}

__device__ __forceinline__ void rope8(const float (&own)[8], const float (&oth)[8], const float (&cs)[16], float sgn, float (&o)[8]) {
#pragma unroll
    for (int i = 0; i < 8; ++i) o[i] = own[i] * cs[2 * i] + sgn * (oth[i] * cs[2 * i + 1]);
}

__device__ __forceinline__ void shf8(const float (&x)[8], float (&y)[8]) {
#pragma unroll
    for (int i = 0; i < 8; ++i) y[i] = __shfl_xor(x[i], 4);
}
__device__ __forceinline__ void pb_token_row(const Args& a, int l, int r, int lane, unsigned parts) {
    unsigned char* ws = a.ws;
    const bf16* P = (const bf16*)(ws + WS_PROJ) + (size_t)r * NINP;
    const float* SA = (const float*)(ws + WS_SLAB);
    const bool smp = r >= MP; const int rs = r - MP;
    int b, t, pos, krow, T;
    if (!smp) { b = r >> 12; t = r & 4095; pos = t; krow = r; T = SEQ; }
    else { b = rs >> 4; t = rs & 15; pos = PAST + t; krow = MP + b * SKEYS + PAST + t; T = TS; }
    u32x4 L[18];
    if (!smp) { const bf16* P1 = (t >= 1) ? P - NINP : P; const bf16* P2 = (t >= 2) ? P - 2 * NINP : P;
        L[6] = ld16(P + C_BG + 8 * lane); L[7] = ld16(P + C_CG + 8 * lane); L[8] = ld16(P + C_XB + 8 * lane);
        L[9] = ld16(P1 + C_CG + 8 * lane); L[10] = ld16(P1 + C_XB + 8 * lane); L[11] = ld16(P2 + C_CG + 8 * lane); L[12] = ld16(P2 + C_XB + 8 * lane);
        L[16] = ld16(P + C_LAT + 8 * lane); }
#define PB_LD8(k, dr, col, dst) do { if (!smp) unpack8(L[k], dst); else slab_ld8<SP_A>(SA, NINP, rs + (dr), (col), dst); } while (0)
    float* out = a.out;
    const size_t orow = smp ? (size_t)l * MS + rs : (size_t)l * MP + r;
    float x[8], y[8], z[8];
    const int i0 = 4 * (lane & 7);
    float cq[8]; ld8f((const float*)(ws + WS_ROPE) + ((size_t)pos * 32 + i0) * 2, cq);
#define PB_QROPE(scale, lo, hi) do { _Pragma("unroll") for (int k = 0; k < 4; ++k) { lo[k] = (x[2 * k] * cq[2 * k] - x[2 * k + 1] * cq[2 * k + 1]) * (scale); hi[k] = (x[2 * k] * cq[2 * k + 1] + x[2 * k + 1] * cq[2 * k]) * (scale); } } while (0)
#define PB_ST4(ptr, v) do { u32x2 w_; w_.x = cvtpk(v[0], v[1]); w_.y = cvtpk(v[2], v[3]); *(u32x2*)(ptr) = w_; } while (0)
    if (parts & 1u) { float lo[4], hi4[4]; PB_LD8(0, 0, C_QA + 8 * lane, x); PB_QROPE(QS_A, lo, hi4);
      bf16* qd = (bf16*)(ws + WS_QA) + (size_t)r * 512 + (lane >> 3) * 64 + i0; PB_ST4(qd, lo); PB_ST4(qd + 32, hi4); }
    if (parts & 2u) { float lo[4], hi4[4]; PB_LD8(1, 0, C_KA + 8 * lane, x); PB_QROPE(1.f, lo, hi4);
      float* od = out + O_SAK + orow * 512 + (lane >> 3) * 64 + i0; *(f32x4*)od = (f32x4){lo[0], lo[1], lo[2], lo[3]}; *(f32x4*)(od + 32) = (f32x4){hi4[0], hi4[1], hi4[2], hi4[3]};
      bf16* kd = (bf16*)(ws + WS_KA) + (size_t)krow * 512 + (lane >> 3) * 64 + i0; PB_ST4(kd, lo); PB_ST4(kd + 32, hi4); }
    if (parts & 4u) { PB_LD8(2, 0, C_VA + 8 * lane, x); st8f_nt(out + (smp ? O_SAV : O_PAV) + orow * 512 + 8 * lane, x); }
    if (parts & 8u)
#pragma unroll
    for (int s = 0; s < 2; ++s) { float lo[4], hi4[4]; PB_LD8(3 + s, 0, C_QI + 512 * s + 8 * lane, x); PB_QROPE(1.f, lo, hi4);
      bf16* qd = (bf16*)(ws + WS_QI) + (size_t)r * 1024 + 512 * s + (lane >> 3) * 64 + i0; PB_ST4(qd, lo); PB_ST4(qd + 32, hi4); }
    if (parts & 16u) {
      if (lane < 8) { float lo[4], hi4[4]; PB_LD8(5, 0, C_KI + 8 * lane, x); PB_QROPE(1.f, lo, hi4);
          float* od = out + O_SIK + orow * 64 + i0; *(f32x4*)od = (f32x4){lo[0], lo[1], lo[2], lo[3]}; *(f32x4*)(od + 32) = (f32x4){hi4[0], hi4[1], hi4[2], hi4[3]};
          bf16* kd = (bf16*)(ws + WS_KI) + (size_t)krow * 64 + i0; PB_ST4(kd, lo); PB_ST4(kd + 32, hi4); }
      else if (lane < 10) { PB_LD8(5, 0, C_WI + 8 * (lane - 8), x);
#pragma unroll
          for (int i = 0; i < 8; ++i) z[i] = x[i] * WI_SCALE;
          st8f((float*)(ws + WS_WI) + (size_t)r * 16 + 8 * (lane - 8), z); } }
    if (parts & 32u) { const int c = 8 * lane; float bgv[8], u0[8], u1[8], u2[8], w0[8], w1[8], w2[8];
      PB_LD8(6, 0, C_BG + c, bgv); PB_LD8(7, 0, C_CG + c, x); PB_LD8(8, 0, C_XB + c, y);
#pragma unroll
      for (int i = 0; i < 8; ++i) u0[i] = x[i] * y[i];
      const float* st = a.in[9] + ((size_t)(l * NBS + b) * 2) * 512 + c;
      if (t >= 1) { PB_LD8(9, -1, C_CG + c, x); PB_LD8(10, -1, C_XB + c, y);
#pragma unroll
          for (int i = 0; i < 8; ++i) u1[i] = x[i] * y[i]; }
      else if (smp) ld8f(st + 512, u1);
      else {
#pragma unroll
          for (int i = 0; i < 8; ++i) u1[i] = 0.f; }
      if (t >= 2) { PB_LD8(11, -2, C_CG + c, x); PB_LD8(12, -2, C_XB + c, y);
#pragma unroll
          for (int i = 0; i < 8; ++i) u2[i] = x[i] * y[i]; }
      else if (smp) ld8f(st + (size_t)t * 512, u2);
      else {
#pragma unroll
          for (int i = 0; i < 8; ++i) u2[i] = 0.f; }
      const float* cw = a.in[13] + (size_t)l * 3 * 512 + c; ld8f(cw, w0); ld8f(cw + 512, w1); ld8f(cw + 1024, w2);
#pragma unroll
      for (int i = 0; i < 8; ++i) z[i] = bgv[i] * (u2[i] * w0[i] + u1[i] * w1[i] + u0[i] * w2[i]);
      st16((bf16*)(ws + WS_MIX) + (size_t)r * D + 512 + c, pack8(z));
      if (t >= T - 2) { float* so = out + (smp ? O_SCB + ((size_t)(l * NBS + b) * 2 + (t - (T - 2))) * 512 : O_PCB + ((size_t)(l * NBP + b) * 2 + (t - (T - 2))) * 512) + c; st8f_nt(so, u0); } }
    if (parts & 64u) {
#pragma unroll
      for (int s = 0; s < 2; ++s) { const int pc = 512 * s + 8 * lane; PB_LD8(13 + s, 0, C_QCN + pc, x);
#pragma unroll
        for (int i = 0; i < 8; ++i) z[i] = x[i] * QS_C;
        st16((bf16*)(ws + WS_QC) + (size_t)r * 1536 + (pc >> 7) * 192 + (pc & 127), pack8(z)); }
      { float lo[4], hi4[4]; PB_LD8(15, 0, C_QCR + 8 * lane, x); PB_QROPE(QS_C, lo, hi4);
        bf16* qd = (bf16*)(ws + WS_QC) + (size_t)r * 1536 + (lane >> 3) * 192 + 128 + i0; PB_ST4(qd, lo); PB_ST4(qd + 32, hi4); } }
    if (parts & 128u) { PB_LD8(16, 0, C_LAT + 8 * lane, x); float ss = 0.f;
#pragma unroll
      for (int i = 0; i < 8; ++i) ss += x[i] * x[i];
      ss = wave_sum(ss); const float rsq = 1.0f / sqrtf(ss * (1.f / 512.f) + RMS_EPS);
      ld8f(a.in[14] + (size_t)l * 512 + 8 * lane, y);
#pragma unroll
      for (int i = 0; i < 8; ++i) z[i] = x[i] * rsq * y[i];
      st8f_nt(out + (smp ? O_SLAT : O_PLAT) + orow * 512 + 8 * lane, z);
      st16((bf16*)(ws + WS_LAT) + (size_t)krow * 512 + 8 * lane, pack8(z)); }
    if (parts & 256u) {
      if (lane < 8) { float lo[4], hi4[4]; PB_LD8(17, 0, C_KR + 8 * lane, x); PB_QROPE(1.f, lo, hi4);
          float* od = out + O_SKR + orow * 64 + i0; *(f32x4*)od = (f32x4){lo[0], lo[1], lo[2], lo[3]}; *(f32x4*)(od + 32) = (f32x4){hi4[0], hi4[1], hi4[2], hi4[3]};
          bf16* kd = (bf16*)(ws + WS_KR) + (size_t)krow * 64 + i0; PB_ST4(kd, lo); PB_ST4(kd + 32, hi4); } }
#undef PB_LD8
#undef PB_QROPE
#undef PB_ST4
}

__device__ __forceinline__ void pb_cache_row(const Args& a, int l, int cr, int lane) {
    unsigned char* ws = a.ws; const int b = cr >> 10, s = cr & 1023; const size_t krow = (size_t)MP + b * SKEYS + s; const size_t src = (size_t)(l * NBS + b) * PAST + s;
    float x[8];
    ld8f_nt(a.in[4] + src * 512 + 8 * lane, x); st16((bf16*)(ws + WS_KA) + krow * 512 + 8 * lane, pack8(x));
    ld8f_nt(a.in[7] + src * 512 + 8 * lane, x); st16((bf16*)(ws + WS_LAT) + krow * 512 + 8 * lane, pack8(x));
    if (lane < 8) { ld8f_nt(a.in[6] + src * 64 + 8 * lane, x); st16((bf16*)(ws + WS_KI) + krow * 64 + 8 * lane, pack8(x)); }
    else if (lane < 16) { ld8f_nt(a.in[8] + src * 64 + 8 * (lane - 8), x); st16((bf16*)(ws + WS_KR) + krow * 64 + 8 * (lane - 8), pack8(x)); }
}

__device__ __forceinline__ void pb_vat_prompt(const Args& a, int job, int lane) {
    unsigned char* ws = a.ws; const int rb = job >> 3, h = job & 7; const int krow0 = rb * 64, colv = h * 64 + lane;
    const bf16* src = (const bf16*)(ws + WS_PROJ) + (size_t)krow0 * NINP + C_VA + colv;
    unsigned pk[32];
#pragma unroll
    for (int i2 = 0; i2 < 32; ++i2) pk[i2] = (unsigned)src[(size_t)(2 * i2) * NINP] | ((unsigned)src[(size_t)(2 * i2 + 1) * NINP] << 16);
    bf16* dst = (bf16*)(ws + WS_VAT) + (size_t)colv * KROWS + krow0;
#pragma unroll
    for (int q = 0; q < 8; ++q) st16(dst + 8 * q, (u32x4){pk[4 * q], pk[4 * q + 1], pk[4 * q + 2], pk[4 * q + 3]});
}
__device__ __forceinline__ void pb_vat_cache(const Args& a, int l, int job, int lane) {
    unsigned char* ws = a.ws; const int b = job >> 7, j = (job >> 3) & 15, h = job & 7, colv = h * 64 + lane;
    const float* src = a.in[5] + ((size_t)(l * NBS + b) * PAST + 64 * j) * 512 + colv;
    unsigned pk[32];
#pragma unroll
    for (int i2 = 0; i2 < 32; ++i2) pk[i2] = cvtpk(__builtin_nontemporal_load(src + (size_t)(2 * i2) * 512), __builtin_nontemporal_load(src + (size_t)(2 * i2 + 1) * 512));
    bf16* dst = (bf16*)(ws + WS_VAT) + (size_t)colv * KROWS + MP + b * SKEYS + 64 * j;
#pragma unroll
    for (int q = 0; q < 8; ++q) st16(dst + 8 * q, (u32x4){pk[4 * q], pk[4 * q + 1], pk[4 * q + 2], pk[4 * q + 3]});
}
__device__ __forceinline__ void pb_vat_new(const Args& a, int job, int lane) {
    unsigned char* ws = a.ws; const int b = job >> 3, h = job & 7, colv = h * 64 + lane;
    const float* sp = (const float*)(ws + WS_SLAB) + (size_t)(b * TS) * NINP + C_VA + colv;
    unsigned pk[8];
#pragma unroll
    for (int i2 = 0; i2 < 8; ++i2) { float v[2];
#pragma unroll
        for (int e = 0; e < 2; ++e) { const float* q = sp + (size_t)(2 * i2 + e) * NINP; float acc = q[0];
#pragma unroll
            for (int pp = 1; pp < SP_A; ++pp) acc += q[(size_t)pp * 256 * NINP];
            v[e] = acc; }
        pk[i2] = cvtpk(v[0], v[1]); }
    bf16* dst = (bf16*)(ws + WS_VAT) + (size_t)colv * KROWS + MP + b * SKEYS + PAST;
    st16(dst, (u32x4){pk[0], pk[1], pk[2], pk[3]}); st16(dst + 8, (u32x4){pk[4], pk[5], pk[6], pk[7]});
}

__device__ __forceinline__ void pb_prompt_rows8(const Args& a, int l, int r0, int lane) {
    unsigned char* ws = a.ws; float* out = a.out;
    const int b = r0 >> 12, t0 = r0 & 4095, c = 8 * lane;
    const __amdgpu_buffer_rsrc_t rp = __builtin_amdgcn_make_buffer_rsrc((void*)((const bf16*)(ws + WS_PROJ) + (size_t)r0 * NINP), 0, 0x7fffffff, 0x00020000);
    const int vo = 16 * lane;
    float w0[8], w1[8], w2[8], kvn[8], u1[8], u2[8];
    { const float* cw = a.in[13] + (size_t)l * 3 * 512 + c; ld8f(cw, w0); ld8f(cw + 512, w1); ld8f(cw + 1024, w2); ld8f(a.in[14] + (size_t)l * 512 + c, kvn); }
    if (t0 > 0) { const bf16* Pm = (const bf16*)(ws + WS_PROJ) + (size_t)(r0 - 2) * NINP; float x[8], y[8];
        unpack8(ld16(Pm + C_CG + c), x); unpack8(ld16(Pm + C_XB + c), y);
#pragma unroll
        for (int i = 0; i < 8; ++i) u2[i] = x[i] * y[i];
        unpack8(ld16(Pm + NINP + C_CG + c), x); unpack8(ld16(Pm + NINP + C_XB + c), y);
#pragma unroll
        for (int i = 0; i < 8; ++i) u1[i] = x[i] * y[i]; }
    else {
#pragma unroll
        for (int i = 0; i < 8; ++i) { u1[i] = 0.f; u2[i] = 0.f; } }
    bf16* mix = (bf16*)(ws + WS_MIX) + (size_t)r0 * D + 512 + c; bf16* latb = (bf16*)(ws + WS_LAT) + (size_t)r0 * 512 + c; float* plat = out + O_PLAT + ((size_t)l * MP + r0) * 512 + c;
#define PB8_LOAD(S, row) do { S[0] = __builtin_amdgcn_raw_buffer_load_b128(rp, vo, (row) * (NINP * 2) + C_BG * 2, 0); S[1] = __builtin_amdgcn_raw_buffer_load_b128(rp, vo, (row) * (NINP * 2) + C_CG * 2, 0); \
        S[2] = __builtin_amdgcn_raw_buffer_load_b128(rp, vo, (row) * (NINP * 2) + C_XB * 2, 0); S[3] = __builtin_amdgcn_raw_buffer_load_b128(rp, vo, (row) * (NINP * 2) + C_LAT * 2, 0); } while (0)
#define PB8_ROW(S) do { float bgv[8], x[8], y[8], u0[8], z[8]; unpack8(S[0], bgv); unpack8(S[1], x); unpack8(S[2], y); \
        _Pragma("unroll") for (int i = 0; i < 8; ++i) { u0[i] = x[i] * y[i]; z[i] = bgv[i] * (u2[i] * w0[i] + u1[i] * w1[i] + u0[i] * w2[i]); u2[i] = u1[i]; u1[i] = u0[i]; } \
        st16(mix, pack8(z)); mix += D; \
        unpack8(S[3], x); float ss = 0.f; \
        _Pragma("unroll") for (int i = 0; i < 8; ++i) ss += x[i] * x[i]; \
        ss = wave_sum(ss); const float rsq = 1.0f / sqrtf(ss * (1.f / 512.f) + RMS_EPS); \
        _Pragma("unroll") for (int i = 0; i < 8; ++i) z[i] = x[i] * rsq * kvn[i]; \
        st8f_nt(plat, z); plat += 512; st16(latb, pack8(z)); latb += 512; } while (0)
    u32x4 A[4], B[4];
    PB8_LOAD(A, 0);
#pragma unroll 1
    for (int ii = 0; ii < 4; ++ii) {
        PB8_LOAD(B, 2 * ii + 1);
        PB8_ROW(A);
        { const int rn = (2 * ii + 2 < 8) ? 2 * ii + 2 : 7; PB8_LOAD(A, rn); }
        PB8_ROW(B);
    }
#undef PB8_LOAD
#undef PB8_ROW
    if (t0 == SEQ - 8) { float* so = out + O_PCB + ((size_t)(l * NBP + b) * 2) * 512 + c; st8f_nt(so, u2); st8f_nt(so + 512, u1); }
}

constexpr int PD_KEYS = 0, PD_TILE = 131072, PD_HIST = 147456;

__device__ __forceinline__ void radix_scan(const LAS unsigned* hist, unsigned need, int lane, unsigned& Tout, unsigned& above_out) {
    const u32x4 v = *(const LAS u32x4*)(hist + 4 * lane);
    const unsigned s = v.x + v.y + v.z + v.w;
    unsigned suf = s;
#pragma unroll
    for (int o = 1; o < 64; o <<= 1) { const unsigned t = __shfl_down(suf, o); suf += (lane + o < 64) ? t : 0u; }
    const unsigned above = suf - s;
    const bool hit = (above < need) && (above + s >= need);
    const unsigned long long bm = __ballot(hit);
    const int L = bm ? (int)__builtin_ctzll(bm) : 0;
    unsigned c = above, Tl, Al;
    if (c + v.w >= need) { Tl = 3u; Al = c; }
    else { c += v.w; if (c + v.z >= need) { Tl = 2u; Al = c; } else { c += v.z; if (c + v.y >= need) { Tl = 1u; Al = c; } else { c += v.y; Tl = 0u; Al = c; } } }
    Tout = (unsigned)__builtin_amdgcn_readlane((int)Tl, L) + 4u * (unsigned)L;
    above_out = (unsigned)__builtin_amdgcn_readlane((int)Al, L);
}

__device__ __forceinline__ void radix_scan3(const LAS unsigned* hist, unsigned need, int lane, unsigned& Tout, unsigned& above_out, unsigned& cnt_out) {
    const u32x4 v = *(const LAS u32x4*)(hist + 4 * lane);
    const unsigned s = v.x + v.y + v.z + v.w;
    unsigned suf = s;
#pragma unroll
    for (int o = 1; o < 64; o <<= 1) { const unsigned t = __shfl_down(suf, o); suf += (lane + o < 64) ? t : 0u; }
    const unsigned above = suf - s;
    const bool hit = (above < need) && (above + s >= need);
    const unsigned long long bm = __ballot(hit);
    const int L = bm ? (int)__builtin_ctzll(bm) : 0;
    unsigned c = above, Tl, Al, Cl;
    if (c + v.w >= need) { Tl = 3u; Al = c; Cl = v.w; }
    else { c += v.w; if (c + v.z >= need) { Tl = 2u; Al = c; Cl = v.z; } else { c += v.z; if (c + v.y >= need) { Tl = 1u; Al = c; Cl = v.y; } else { c += v.y; Tl = 0u; Al = c; Cl = v.x; } } }
    Tout = (unsigned)__builtin_amdgcn_readlane((int)Tl, L) + 4u * (unsigned)L;
    above_out = (unsigned)__builtin_amdgcn_readlane((int)Al, L);
    cnt_out = (unsigned)__builtin_amdgcn_readlane((int)Cl, L);
}

__device__ __forceinline__ float relu1(float x) { const int b = __float_as_int(x); return __int_as_float(b > 0 ? b : 0); }
__device__ __forceinline__ void pd_group(const Args& a, LAS unsigned char* lds, int q0, int tid) {
    unsigned char* ws = a.ws;
    const int lane = tid & 63, wid = __builtin_amdgcn_readfirstlane(tid >> 6);
    const int q = q0 + wid;
    unsigned long long* SEL = (unsigned long long*)(ws + WS_SEL) + (size_t)q * 64;
    int nsteps, nvalid; size_t krow0;
    if (q0 < MP) { const int t = q0 & 4095; nsteps = (t >> 6) + 1; nvalid = nsteps * 64; krow0 = (size_t)(q0 & ~4095); }
    else { const int b = (q0 - MP) >> 4; nsteps = 17; nvalid = SKEYS; krow0 = (size_t)MP + (size_t)b * SKEYS; }
    if (nsteps <= 4) { SEL[lane] = (lane < nsteps) ? ~0ull : 0ull; return; }
    const int kc = lane & 15, g = lane >> 4;
    bf16x8 af[2];
    { const bf16* qp = (const bf16*)(ws + WS_QI) + (size_t)q * 1024 + kc * 64 + 8 * g; af[0] = *(const bf16x8*)qp; af[1] = *(const bf16x8*)(qp + 32); }
    const f32x4 wv = *(const f32x4*)((const float*)(ws + WS_WI) + (size_t)q * 16 + 4 * g);
    LAS unsigned* keys = (LAS unsigned*)(lds + PD_KEYS + wid * 16384);
    LAS unsigned* hist = (LAS unsigned*)(lds + PD_HIST + wid * 1024);
    const bf16* ksrc = (const bf16*)(ws + WS_KI) + (krow0 + (tid >> 3)) * 64 + 8 * (tid & 7);
    const int sdst = PD_TILE + (tid >> 3) * 128 + (((tid & 7) ^ ((tid >> 4) & 7)) * 16);
    const int sw = (kc >> 1) & 7;
    const int boff0 = PD_TILE + kc * 128 + ((g ^ sw) * 16), boff1 = PD_TILE + kc * 128 + (((4 + g) ^ sw) * 16);
    constexpr int PFD = 8;
    u32x4 pf[PFD];
    for (int rr_ = 0; rr_ < 1 + (int)((MK_REP >> 16) & 1u); ++rr_) {
    __syncthreads();
    *(LAS u32x4*)(hist + 4 * lane) = (u32x4){0u, 0u, 0u, 0u};
    { const u32x4 t0 = ld16(ksrc);
#pragma unroll
      for (int i = 0; i < PFD; ++i) { const int ls = (1 + i < nsteps) ? 1 + i : nsteps - 1; pf[i] = ld16(ksrc + (size_t)ls * 4096); }
      *(LAS u32x4*)(lds + sdst) = t0; }
    __syncthreads();
    for (int st0 = 0; st0 < nsteps; st0 += PFD) {
#pragma unroll
      for (int j = 0; j < PFD; ++j) {
        const int st = st0 + j;
        if (st < nsteps) {
        const LAS unsigned char* tb = lds + (st & 1) * 8192;
        float pg[4];
        {
            bf16x8 bq[8];
#pragma unroll
            for (int grp = 0; grp < 4; ++grp) { bq[2 * grp] = *(const LAS bf16x8*)(tb + boff0 + grp * 2048); bq[2 * grp + 1] = *(const LAS bf16x8*)(tb + boff1 + grp * 2048); }
            __builtin_amdgcn_sched_barrier(0);
            f32x4 acc[4];
#pragma unroll
            for (int grp = 0; grp < 4; ++grp) acc[grp] = __builtin_amdgcn_mfma_f32_16x16x32_bf16(af[0], bq[2 * grp], (f32x4){0.f, 0.f, 0.f, 0.f}, 0, 0, 0);
#pragma unroll
            for (int grp = 0; grp < 4; ++grp) acc[grp] = __builtin_amdgcn_mfma_f32_16x16x32_bf16(af[1], bq[2 * grp + 1], acc[grp], 0, 0, 0);
            __builtin_amdgcn_sched_barrier(0);
#pragma unroll
            for (int grp = 0; grp < 4; ++grp) { float p = 0.f;
                p = fmaf(relu1(acc[grp].x), wv.x, p); p = fmaf(relu1(acc[grp].y), wv.y, p); p = fmaf(relu1(acc[grp].z), wv.z, p); p = fmaf(relu1(acc[grp].w), wv.w, p);
                pg[grp] = p; }
        }
        float mine;
        { const auto s02 = __builtin_amdgcn_permlane32_swap(__float_as_uint(pg[0]), __float_as_uint(pg[2]), false, false);
          const auto s13 = __builtin_amdgcn_permlane32_swap(__float_as_uint(pg[1]), __float_as_uint(pg[3]), false, false);
          const float e = __uint_as_float(s02[0]) + __uint_as_float(s02[1]);
          const float o = __uint_as_float(s13[0]) + __uint_as_float(s13[1]);
          const auto t = __builtin_amdgcn_permlane16_swap(__float_as_uint(e), __float_as_uint(o), false, false);
          mine = __uint_as_float(t[0]) + __uint_as_float(t[1]); }
        const unsigned u = __float_as_uint(mine); const unsigned ok = u ^ ((unsigned)((int)u >> 31) | 0x80000000u);
        const bool kvalid = 64 * st + lane < nvalid;
        keys[64 * st + lane] = kvalid ? ok : 0u;
        if (kvalid) __hip_atomic_fetch_add(hist + (ok >> 24), 1u, __ATOMIC_RELAXED, __HIP_MEMORY_SCOPE_WORKGROUP);
        *(LAS u32x4*)(lds + ((st + 1) & 1) * 8192 + sdst) = pf[j];
        { const int ls = (st + 1 + PFD < nsteps) ? st + 1 + PFD : nsteps - 1; pf[j] = ld16(ksrc + (size_t)ls * 4096); }
        __syncthreads();
        }
      }
    }
    }
    unsigned long long mymask = 0ull;
    for (int rr_ = 0; rr_ < 1 + (int)((MK_REP >> 17) & 1u); ++rr_) {
    if (rr_) { *(LAS u32x4*)(hist + 4 * lane) = (u32x4){0u, 0u, 0u, 0u}; for (int st = 0; st < nsteps; ++st) { const unsigned k = keys[64 * st + lane]; if (64 * st + lane < nvalid) __hip_atomic_fetch_add(hist + (k >> 24), 1u, __ATOMIC_RELAXED, __HIP_MEMORY_SCOPE_WORKGROUP); } }
    unsigned prefix = 0u, need = 256u;
    { unsigned T, ab; radix_scan(hist, need, lane, T, ab); prefix = T; need -= ab; }
#pragma unroll
    for (int pass = 1; pass < 4; ++pass) {
        const int sh = 24 - 8 * pass;
        *(LAS u32x4*)(hist + 4 * lane) = (u32x4){0u, 0u, 0u, 0u};
#pragma unroll 4
        for (int st = 0; st < nsteps; ++st) { const unsigned k = keys[64 * st + lane];
            if ((k >> (sh + 8)) == prefix) __hip_atomic_fetch_add(hist + ((k >> sh) & 0xffu), 1u, __ATOMIC_RELAXED, __HIP_MEMORY_SCOPE_WORKGROUP); }
        unsigned T, ab; radix_scan(hist, need, lane, T, ab);
        prefix = (prefix << 8) | T; need -= ab;
    }
    const unsigned tkey = prefix, take_eq = need;
    mymask = 0ull; unsigned run = 0u;
    const unsigned long long lt = (lane == 0) ? 0ull : (~0ull >> (64 - lane));
#pragma unroll 4
    for (int st = 0; st < nsteps; ++st) { const unsigned k = keys[64 * st + lane];
        const bool gt = k > tkey, eq = k == tkey;
        const unsigned long long em = __ballot(eq);
        const unsigned rank = run + (unsigned)__builtin_popcountll(em & lt);
        const bool sel = gt || (eq && rank < take_eq);
        run += (unsigned)__builtin_popcountll(em);
        const unsigned long long sm = __ballot(sel);
        mymask = (lane == st) ? sm : mymask;
    }
    }
    SEL[lane] = mymask;
}


constexpr int PD2_TILE = 0, PD2_TB = 32768, PD2_H8 = 65536;
__device__ __forceinline__ void pd_group256(const Args& a, LAS unsigned char* lds, int q0, int tid) {
    unsigned char* ws = a.ws;
    const int lane = tid & 63, wid = __builtin_amdgcn_readfirstlane(tid >> 6);
    const int q = q0 + wid;
    unsigned long long* SEL = (unsigned long long*)(ws + WS_SEL) + (size_t)q * 64;
    int nsteps, nvalid; size_t krow0;
    if (q0 < MP) { const int t = q0 & 4095; nsteps = (t >> 6) + 1; nvalid = nsteps * 64; krow0 = (size_t)(q0 & ~4095); }
    else { const int b = (q0 - MP) >> 4; nsteps = 17; nvalid = SKEYS; krow0 = (size_t)MP + (size_t)b * SKEYS; }
    if (nsteps <= 4) { SEL[lane] = (lane < nsteps) ? ~0ull : 0ull; return; }
    const int nbig = (nsteps + 3) >> 2;
    const int kc = lane & 15, g = lane >> 4;
    bf16x8 af[2];
    { const bf16* qp = (const bf16*)(ws + WS_QI) + (size_t)q * 1024 + kc * 64 + 8 * g; af[0] = *(const bf16x8*)qp; af[1] = *(const bf16x8*)(qp + 32); }
    const f32x4 wv = *(const f32x4*)((const float*)(ws + WS_WI) + (size_t)q * 16 + 4 * g);
    LAS unsigned* keys = (LAS unsigned*)(lds + PD_KEYS + wid * 16384);
    LAS unsigned* hist = (LAS unsigned*)(lds + PD_HIST + wid * 1024);
    LAS unsigned* hist8 = (LAS unsigned*)(lds + PD2_H8 + wid * (8 * 260 * 4)) + (lane & 7) * 260;
    const bf16* ksrc = (const bf16*)(ws + WS_KI) + (krow0 + (tid >> 3)) * 64 + 8 * (tid & 7);
    const int sdst = PD2_TILE + (tid >> 3) * 128 + (((tid & 7) ^ ((tid >> 4) & 7)) * 16);
    const int sw = (kc >> 1) & 7;
    const int boff0 = PD2_TILE + kc * 128 + ((g ^ sw) * 16), boff1 = PD2_TILE + kc * 128 + (((4 + g) ^ sw) * 16);
    constexpr int PFD = 2;
    u32x4 pf[PFD][4];
    unsigned key[64];
    __syncthreads();
    unsigned z0 = 0u; asm volatile("" : "+v"(z0));
    const u32x4 zz = (u32x4){z0, z0, z0, z0};
    { LAS unsigned* h8 = (LAS unsigned*)(lds + PD2_H8 + wid * (8 * 260 * 4));
#pragma unroll
      for (int c = 0; c < 8; ++c) *(LAS u32x4*)(h8 + c * 260 + 4 * lane) = zz;
      if (lane < 8) *(LAS u32x4*)(h8 + lane * 260 + 256) = zz; }
    { u32x4 t0[4];
#pragma unroll
      for (int i = 0; i < 4; ++i) t0[i] = ld16(ksrc + (size_t)i * 4096);
#pragma unroll
      for (int s = 0; s < PFD; ++s) { const int bl = (1 + s < nbig) ? 1 + s : nbig - 1;
#pragma unroll
          for (int i = 0; i < 4; ++i) pf[s][i] = ld16(ksrc + (size_t)bl * 16384 + (size_t)i * 4096); }
#pragma unroll
      for (int i = 0; i < 4; ++i) *(LAS u32x4*)(lds + sdst + i * 8192) = t0[i]; }
    __syncthreads();
#pragma unroll
    for (int bs = 0; bs < 16; ++bs) {
#pragma unroll
        for (int s4 = 0; s4 < 4; ++s4) key[4 * bs + s4] = 0u;
        if (bs < nbig) {
            const LAS unsigned char* tb = lds + (bs & 1) * PD2_TB;
#pragma unroll
            for (int s4 = 0; s4 < 4; ++s4) if (256 * bs + 64 * s4 < nvalid) {
                float pg[4];
                {   bf16x8 bq[8];
#pragma unroll
                    for (int grp = 0; grp < 4; ++grp) { bq[2 * grp] = *(const LAS bf16x8*)(tb + boff0 + s4 * 8192 + grp * 2048); bq[2 * grp + 1] = *(const LAS bf16x8*)(tb + boff1 + s4 * 8192 + grp * 2048); }
                    f32x4 acc[4];
#pragma unroll
                    for (int grp = 0; grp < 4; ++grp) acc[grp] = __builtin_amdgcn_mfma_f32_16x16x32_bf16(af[0], bq[2 * grp], (f32x4){0.f, 0.f, 0.f, 0.f}, 0, 0, 0);
#pragma unroll
                    for (int grp = 0; grp < 4; ++grp) acc[grp] = __builtin_amdgcn_mfma_f32_16x16x32_bf16(af[1], bq[2 * grp + 1], acc[grp], 0, 0, 0);
#pragma unroll
                    for (int grp = 0; grp < 4; ++grp) { float p = 0.f;
                        p = fmaf(relu1(acc[grp].x), wv.x, p); p = fmaf(relu1(acc[grp].y), wv.y, p); p = fmaf(relu1(acc[grp].z), wv.z, p); p = fmaf(relu1(acc[grp].w), wv.w, p);
                        pg[grp] = p; }
                }
                float mine;
                { const auto s02 = __builtin_amdgcn_permlane32_swap(__float_as_uint(pg[0]), __float_as_uint(pg[2]), false, false);
                  const auto s13 = __builtin_amdgcn_permlane32_swap(__float_as_uint(pg[1]), __float_as_uint(pg[3]), false, false);
                  const float e = __uint_as_float(s02[0]) + __uint_as_float(s02[1]);
                  const float o = __uint_as_float(s13[0]) + __uint_as_float(s13[1]);
                  const auto t = __builtin_amdgcn_permlane16_swap(__float_as_uint(e), __float_as_uint(o), false, false);
                  mine = __uint_as_float(t[0]) + __uint_as_float(t[1]); }
                const unsigned u = __float_as_uint(mine); const unsigned ok = u ^ ((unsigned)((int)u >> 31) | 0x80000000u);
                if (256 * bs + 64 * s4 + 64 <= nvalid) {
                    key[4 * bs + s4] = ok; __hip_atomic_fetch_add(hist8 + (ok >> 24), 1u, __ATOMIC_RELAXED, __HIP_MEMORY_SCOPE_WORKGROUP);
                } else { const bool kvalid = 256 * bs + 64 * s4 + lane < nvalid;
                    key[4 * bs + s4] = kvalid ? ok : 0u;
                    if (kvalid) __hip_atomic_fetch_add(hist8 + (ok >> 24), 1u, __ATOMIC_RELAXED, __HIP_MEMORY_SCOPE_WORKGROUP); }
            }
#pragma unroll
            for (int i = 0; i < 4; ++i) *(LAS u32x4*)(lds + ((bs + 1) & 1) * PD2_TB + sdst + i * 8192) = pf[bs % PFD][i];
            { const int bl = (bs + 1 + PFD < nbig) ? bs + 1 + PFD : nbig - 1;
#pragma unroll
              for (int i = 0; i < 4; ++i) pf[bs % PFD][i] = ld16(ksrc + (size_t)bl * 16384 + (size_t)i * 4096); }
            __syncthreads();
            __builtin_amdgcn_sched_barrier(0);
        }
    }
    { const LAS unsigned* h8 = (const LAS unsigned*)(lds + PD2_H8 + wid * (8 * 260 * 4)); u32x4 t = *(const LAS u32x4*)(h8 + 4 * lane);
#pragma unroll
      for (int c = 1; c < 8; ++c) { const u32x4 v = *(const LAS u32x4*)(h8 + c * 260 + 4 * lane); t.x += v.x; t.y += v.y; t.z += v.z; t.w += v.w; }
      *(LAS u32x4*)(hist + 4 * lane) = t; }
    __syncthreads();
#pragma unroll
    for (int J = 0; J < 16; ++J) *(LAS u32x4*)(keys + 256 * J + 4 * lane) = (u32x4){key[4 * J], key[4 * J + 1], key[4 * J + 2], key[4 * J + 3]};
    unsigned prefix = 0u, need = 256u, tkey = 0u, take_eq = 0u; bool done = false;
    { unsigned T, ab, cn; radix_scan3(hist, need, lane, T, ab, cn); prefix = T; need -= ab; if (cn == need && prefix != 0u) { tkey = (prefix << 24) - 1u; done = true; } }
#pragma unroll
    for (int pass = 1; pass < 4; ++pass) {
        if (!done) {
        const int sh = 24 - 8 * pass;
        *(LAS u32x4*)(hist + 4 * lane) = zz;
#pragma unroll 2
        for (int J = 0; J < nbig; ++J) { const u32x4 kk = *(const LAS u32x4*)(keys + 256 * J + 4 * lane);
            const bool m0 = (kk[0] >> (sh + 8)) == prefix, m1 = (kk[1] >> (sh + 8)) == prefix, m2 = (kk[2] >> (sh + 8)) == prefix, m3 = (kk[3] >> (sh + 8)) == prefix;
            if (__any(m0 | m1 | m2 | m3)) {
                if (m0) __hip_atomic_fetch_add(hist + ((kk[0] >> sh) & 0xffu), 1u, __ATOMIC_RELAXED, __HIP_MEMORY_SCOPE_WORKGROUP);
                if (m1) __hip_atomic_fetch_add(hist + ((kk[1] >> sh) & 0xffu), 1u, __ATOMIC_RELAXED, __HIP_MEMORY_SCOPE_WORKGROUP);
                if (m2) __hip_atomic_fetch_add(hist + ((kk[2] >> sh) & 0xffu), 1u, __ATOMIC_RELAXED, __HIP_MEMORY_SCOPE_WORKGROUP);
                if (m3) __hip_atomic_fetch_add(hist + ((kk[3] >> sh) & 0xffu), 1u, __ATOMIC_RELAXED, __HIP_MEMORY_SCOPE_WORKGROUP); } }
        unsigned T, ab, cn; radix_scan3(hist, need, lane, T, ab, cn);
        prefix = (prefix << 8) | T; need -= ab;
        if (pass < 3 && cn == need && prefix != 0u) { tkey = (prefix << sh) - 1u; done = true; }
        }
    }
    if (!done) { tkey = prefix; take_eq = need; }
    unsigned long long mymask = 0ull; unsigned run = 0u;
    const unsigned long long lt = (lane == 0) ? 0ull : (~0ull >> (64 - lane));
    if (take_eq == 0u) {
#pragma unroll 2
        for (int J = 0; J < nbig; ++J) { const u32x4 kk = *(const LAS u32x4*)(keys + 256 * J + 4 * lane);
#pragma unroll
            for (int c = 0; c < 4; ++c) { const unsigned long long sm = __ballot(kk[c] > tkey); mymask = (lane == 4 * J + c) ? sm : mymask; } }
    } else
#pragma unroll 2
    for (int J = 0; J < nbig; ++J) { const u32x4 kk = *(const LAS u32x4*)(keys + 256 * J + 4 * lane);
#pragma unroll
        for (int c = 0; c < 4; ++c) { const unsigned k = kk[c]; const int st = 4 * J + c;
            const bool gt = k > tkey, eq = k == tkey;
            const unsigned long long em = __ballot(eq);
            const unsigned rank = run + (unsigned)__builtin_popcountll(em & lt);
            const bool sel = gt || (eq && rank < take_eq);
            run += (unsigned)__builtin_popcountll(em);
            const unsigned long long sm = __ballot(sel);
            mymask = (lane == st) ? sm : mymask; }
    }
    SEL[lane] = mymask;
}

constexpr float ATT_THR = 8.0f, ATT_BIG = 4096.0f;
template <int DQK, int DK1, int DV, bool MASKED>
__device__ __forceinline__ void attn_unit(LAS unsigned char* lds, const bf16* Q, int qpitch, const bf16* K1, int k1p, const bf16* K2, int k2p, const bf16* Vt, int vp,
                                          const unsigned long long* SEL, bf16* O, int opitch, int qb, int tid) {
    constexpr int KP = DQK * 2 + 16, VP = 144, KBYTES = 64 * KP, VBYTES = DV * VP, BUF = KBYTES + VBYTES;
    constexpr int C1 = DK1 / 8, C2 = (DQK - DK1) / 8, NK1 = 64 * C1 / 512, NK2 = 64 * C2 / 512, NVC = DV * 8 / 512, NDS = DQK / 16, NDB = DV / 32;
    static_assert(64 * C1 % 512 == 0 && 64 * C2 % 512 == 0 && DV * 8 % 512 == 0 && 2 * BUF <= LDS_RING, "attention tile staging");
    const int lane = tid & 63, wid = __builtin_amdgcn_readfirstlane(tid >> 6), rho = lane & 31, hi = lane >> 5;
    const int prho = (rho & ~12) | ((rho & 8) >> 1) | ((rho & 4) << 1);
    const int NT = 4 * qb + 4, cw = 4 * qb + (wid >> 1);
    bf16x8 qf[NDS];
    { const bf16* qp = Q + (size_t)(32 * wid + rho) * qpitch + 8 * hi;
#pragma unroll
      for (int ds = 0; ds < NDS; ++ds) qf[ds] = *(const bf16x8*)(qp + 16 * ds); }
    const unsigned long long* selp = MASKED ? SEL + (size_t)(32 * wid + rho) * 64 : nullptr;
    const __amdgpu_buffer_rsrc_t r1 = __builtin_amdgcn_make_buffer_rsrc((void*)K1, 0, 0x7fffffff, 0x00020000);
    const __amdgpu_buffer_rsrc_t r2 = __builtin_amdgcn_make_buffer_rsrc((void*)(C2 ? K2 : K1), 0, 0x7fffffff, 0x00020000);
    const __amdgpu_buffer_rsrc_t rv = __builtin_amdgcn_make_buffer_rsrc((void*)Vt, 0, 0x7fffffff, 0x00020000);
    int ko1[NK1], kl1[NK1], ko2[NK2 ? NK2 : 1], kl2[NK2 ? NK2 : 1], vo[NVC], vl[NVC];
#pragma unroll
    for (int i = 0; i < NK1; ++i) { const int cid = tid + 512 * i, row = cid / C1, ch = cid % C1; ko1[i] = (row * k1p + 8 * ch) * 2; kl1[i] = row * KP + ch * 16; }
#pragma unroll
    for (int i = 0; i < NK2; ++i) { const int cid = tid + 512 * i, row = cid / (C2 ? C2 : 1), ch = cid % (C2 ? C2 : 1); ko2[i] = (row * k2p + 8 * ch) * 2; kl2[i] = row * KP + (C1 + ch) * 16; }
#pragma unroll
    for (int i = 0; i < NVC; ++i) { const int cid = tid + 512 * i, d = cid >> 3, ch = cid & 7; vo[i] = (d * vp + 8 * ch) * 2; vl[i] = KBYTES + d * VP + ch * 16; }
    u32x4 kreg1[NK1], kreg2[NK2 ? NK2 : 1], vreg[NVC];
#define AT_LOAD(t) do { \
        _Pragma("unroll") for (int i = 0; i < NK1; ++i) kreg1[i] = __builtin_amdgcn_raw_buffer_load_b128(r1, ko1[i], (t) * 64 * k1p * 2, 0); \
        _Pragma("unroll") for (int i = 0; i < NK2; ++i) kreg2[i] = __builtin_amdgcn_raw_buffer_load_b128(r2, ko2[i], (t) * 64 * k2p * 2, 0); \
        _Pragma("unroll") for (int i = 0; i < NVC; ++i) vreg[i] = __builtin_amdgcn_raw_buffer_load_b128(rv, vo[i], (t) * 128, 0); } while (0)
#define AT_STORE(buf) do { \
        _Pragma("unroll") for (int i = 0; i < NK1; ++i) *(LAS u32x4*)(lds + (buf) * BUF + kl1[i]) = kreg1[i]; \
        _Pragma("unroll") for (int i = 0; i < NK2; ++i) *(LAS u32x4*)(lds + (buf) * BUF + kl2[i]) = kreg2[i]; \
        _Pragma("unroll") for (int i = 0; i < NVC; ++i) *(LAS u32x4*)(lds + (buf) * BUF + vl[i]) = vreg[i]; } while (0)
    f32x16 o[NDB];
#pragma unroll
    for (int db = 0; db < NDB; ++db)
#pragma unroll
        for (int r = 0; r < 16; ++r) o[db][r] = 0.f;
    float m = -1e30f, l = 0.f;
    __syncthreads();
    AT_LOAD(0); AT_STORE(0);
    __syncthreads();
    for (int t = 0; t < NT; ++t) {
        const int buf = t & 1;
        if (t + 1 < NT) AT_LOAD(t + 1);
        if (t <= cw) {
            const LAS unsigned char* kb = lds + buf * BUF; const LAS unsigned char* vb = kb + KBYTES;
            unsigned long long sw = 0ull; if (MASKED) sw = selp[t];
            f32x16 sb[2];

#pragma unroll
            for (int kbk = 0; kbk < 2; ++kbk) {
#pragma unroll
                for (int r = 0; r < 16; ++r) sb[kbk][r] = 0.f;
                constexpr int PF = (NDS < 6) ? NDS : 6;
                const LAS unsigned char* kr = kb + (32 * kbk + prho) * KP + 16 * hi;
                bf16x8 af[PF];
#pragma unroll
                for (int i = 0; i < PF; ++i) af[i] = *(const LAS bf16x8*)(kr + 32 * i);
#pragma unroll
                for (int ds = 0; ds < NDS; ++ds) {
                    const bf16x8 a0 = af[ds % PF];
                    if (ds + PF < NDS) af[ds % PF] = *(const LAS bf16x8*)(kr + 32 * (ds + PF));
                    sb[kbk] = __builtin_amdgcn_mfma_f32_32x32x16_bf16(a0, qf[ds], sb[kbk], 0, 0, 0);
                }
            }

#pragma unroll
            for (int kbk = 0; kbk < 2; ++kbk) {
                f32x16 s0 = sb[kbk];
                bf16x8 vfr[2 * NDB];
#pragma unroll
                for (int db = 0; db < NDB; ++db) { vfr[2 * db] = *(const LAS bf16x8*)(vb + (32 * db + rho) * VP + (32 * kbk + 8 * hi) * 2); vfr[2 * db + 1] = *(const LAS bf16x8*)(vb + (32 * db + rho) * VP + (32 * kbk + 16 + 8 * hi) * 2); }
                asm volatile("" ::: "memory");
                if (MASKED) {
                    const unsigned w0 = (unsigned)(sw >> (32 * kbk)) >> (8 * hi);
#pragma unroll
                    for (int r = 0; r < 16; ++r) { const unsigned bit = 1u << (16 * (r >> 3) + (r & 7)); s0[r] = (w0 & bit) ? s0[r] : -INFINITY; }
                }
                float mx = s0[0];
#pragma unroll
                for (int r = 1; r < 16; ++r) mx = fmaxf(mx, s0[r]);
                { const auto rr = __builtin_amdgcn_permlane32_swap(__float_as_uint(mx), __float_as_uint(mx), false, false); mx = fmaxf(__uint_as_float(rr[0]), __uint_as_float(rr[1])); }
                if (__any(mx > m + ATT_THR)) {
                    const float mn = fmaxf(m, mx), alpha = __builtin_amdgcn_exp2f(m - mn); m = mn; l *= alpha;
#pragma unroll
                    for (int db = 0; db < NDB; ++db)
#pragma unroll
                        for (int r = 0; r < 16; ++r) o[db][r] *= alpha;
                }
                float ps = 0.f;
#pragma unroll
                for (int r = 0; r < 16; ++r) { s0[r] = __builtin_amdgcn_exp2f(s0[r] - m); ps += s0[r]; }
                l += ps;
                bf16x8 pf[2];
#pragma unroll
                for (int s = 0; s < 2; ++s) { u32x4 p0;
                    p0.x = cvtpk(s0[8 * s], s0[8 * s + 1]); p0.y = cvtpk(s0[8 * s + 2], s0[8 * s + 3]); p0.z = cvtpk(s0[8 * s + 4], s0[8 * s + 5]); p0.w = cvtpk(s0[8 * s + 6], s0[8 * s + 7]);
                    pf[s] = __builtin_bit_cast(bf16x8, p0); }

#pragma unroll
                for (int db = 0; db < NDB; ++db) {
                    o[db] = __builtin_amdgcn_mfma_f32_32x32x16_bf16(vfr[2 * db], pf[0], o[db], 0, 0, 0);
                    o[db] = __builtin_amdgcn_mfma_f32_32x32x16_bf16(vfr[2 * db + 1], pf[1], o[db], 0, 0, 0);
                }

            }
        }
        if (t + 1 < NT) AT_STORE(buf ^ 1);
        __syncthreads();
    }
#undef AT_LOAD
#undef AT_STORE
    const float lt = l + __shfl_xor(l, 32); const float inv = 1.0f / lt;
    bf16* op = O + (size_t)(32 * wid + rho) * opitch + 4 * hi;
#pragma unroll
    for (int db = 0; db < NDB; ++db)
#pragma unroll
        for (int g4 = 0; g4 < 4; ++g4) { u32x2 w; w.x = cvtpk(o[db][4 * g4] * inv, o[db][4 * g4 + 1] * inv); w.y = cvtpk(o[db][4 * g4 + 2] * inv, o[db][4 * g4 + 3] * inv);
            *(u32x2*)(op + 32 * db + 8 * g4) = w; }
}

template <int DQK, int DK1, int DV, bool MASKED>
__device__ __forceinline__ void attn_unit_deep(LAS unsigned char* lds, const bf16* Q, int qpitch, const bf16* K1, int k1p, const bf16* K2, int k2p, const bf16* Vt, int vp,
                                          const unsigned long long* SEL, bf16* O, int opitch, int qb, int tid) {
    constexpr int KP = DQK * 2 + 16, VP = 144, KBYTES = 64 * KP, VBYTES = DV * VP, BUF = KBYTES + VBYTES;
    constexpr int C1 = DK1 / 8, C2 = (DQK - DK1) / 8, NK1 = 64 * C1 / 512, NK2 = 64 * C2 / 512, NVC = DV * 8 / 512, NDS = DQK / 16, NDB = DV / 32;
    static_assert(64 * C1 % 512 == 0 && 64 * C2 % 512 == 0 && DV * 8 % 512 == 0 && 2 * BUF <= LDS_RING, "attention tile staging");
    const int lane = tid & 63, wid = __builtin_amdgcn_readfirstlane(tid >> 6), rho = lane & 31, hi = lane >> 5;
    const int prho = (rho & ~12) | ((rho & 8) >> 1) | ((rho & 4) << 1);
    const int NT = 4 * qb + 4, cw = 4 * qb + (wid >> 1);
    bf16x8 qf[NDS];
    { const bf16* qp = Q + (size_t)(32 * wid + rho) * qpitch + 8 * hi;
#pragma unroll
      for (int ds = 0; ds < NDS; ++ds) qf[ds] = *(const bf16x8*)(qp + 16 * ds); }
    const unsigned long long* selp = MASKED ? SEL + (size_t)(32 * wid + rho) * 64 : nullptr;
    const __amdgpu_buffer_rsrc_t r1 = __builtin_amdgcn_make_buffer_rsrc((void*)K1, 0, 0x7fffffff, 0x00020000);
    const __amdgpu_buffer_rsrc_t r2 = __builtin_amdgcn_make_buffer_rsrc((void*)(C2 ? K2 : K1), 0, 0x7fffffff, 0x00020000);
    const __amdgpu_buffer_rsrc_t rv = __builtin_amdgcn_make_buffer_rsrc((void*)Vt, 0, 0x7fffffff, 0x00020000);
    int ko1[NK1], kl1[NK1], ko2[NK2 ? NK2 : 1], kl2[NK2 ? NK2 : 1], vo[NVC], vl[NVC];
#pragma unroll
    for (int i = 0; i < NK1; ++i) { const int cid = tid + 512 * i, row = cid / C1, ch = cid % C1; ko1[i] = (row * k1p + 8 * ch) * 2; kl1[i] = row * KP + ch * 16; }
#pragma unroll
    for (int i = 0; i < NK2; ++i) { const int cid = tid + 512 * i, row = cid / (C2 ? C2 : 1), ch = cid % (C2 ? C2 : 1); ko2[i] = (row * k2p + 8 * ch) * 2; kl2[i] = row * KP + (C1 + ch) * 16; }
#pragma unroll
    for (int i = 0; i < NVC; ++i) { const int cid = tid + 512 * i, d = cid >> 3, ch = cid & 7; vo[i] = (d * vp + 8 * ch) * 2; vl[i] = KBYTES + d * VP + ch * 16; }
    u32x4 kreg1[4][NK1], kreg2[4][NK2 ? NK2 : 1], vreg[4][NVC];
#define AT_LOAD(t, S) do { \
        _Pragma("unroll") for (int i = 0; i < NK1; ++i) kreg1[S][i] = __builtin_amdgcn_raw_buffer_load_b128(r1, ko1[i], (t) * 64 * k1p * 2, 0); \
        _Pragma("unroll") for (int i = 0; i < NK2; ++i) kreg2[S][i] = __builtin_amdgcn_raw_buffer_load_b128(r2, ko2[i], (t) * 64 * k2p * 2, 0); \
        _Pragma("unroll") for (int i = 0; i < NVC; ++i) vreg[S][i] = __builtin_amdgcn_raw_buffer_load_b128(rv, vo[i], (t) * 128, 0); } while (0)
#define AT_STORE(buf, S) do { \
        _Pragma("unroll") for (int i = 0; i < NK1; ++i) *(LAS u32x4*)(lds + (buf) * BUF + kl1[i]) = kreg1[S][i]; \
        _Pragma("unroll") for (int i = 0; i < NK2; ++i) *(LAS u32x4*)(lds + (buf) * BUF + kl2[i]) = kreg2[S][i]; \
        _Pragma("unroll") for (int i = 0; i < NVC; ++i) *(LAS u32x4*)(lds + (buf) * BUF + vl[i]) = vreg[S][i]; } while (0)
    f32x16 o[NDB];
#pragma unroll
    for (int db = 0; db < NDB; ++db)
#pragma unroll
        for (int r = 0; r < 16; ++r) o[db][r] = 0.f;
    float m = -1e30f, l = 0.f;
    __syncthreads();
    AT_LOAD(0, 0); AT_STORE(0, 0);
    AT_LOAD(1, 1); AT_LOAD(2, 2);
    unsigned long long swn = 0ull; if (MASKED) swn = selp[0];
    __syncthreads();
    for (int t0 = 0; t0 < NT; t0 += 4) {
#pragma unroll
      for (int u = 0; u < 4; ++u) {
        const int t = t0 + u, buf = u & 1;
        { const int tl = (t + 3 < NT) ? t + 3 : NT - 1; AT_LOAD(tl, (u + 3) & 3); }
        const unsigned long long sw = swn; if (MASKED) swn = selp[(t + 1 < NT) ? t + 1 : NT - 1];
        if (t <= cw) {
            const LAS unsigned char* kb = lds + buf * BUF; const LAS unsigned char* vb = kb + KBYTES;
            f32x16 sb[2];

#pragma unroll
            for (int kbk = 0; kbk < 2; ++kbk) {
#pragma unroll
                for (int r = 0; r < 16; ++r) sb[kbk][r] = 0.f;
                constexpr int PF = (NDS < 6) ? NDS : 6;
                const LAS unsigned char* kr = kb + (32 * kbk + prho) * KP + 16 * hi;
                bf16x8 af[PF];
#pragma unroll
                for (int i = 0; i < PF; ++i) af[i] = *(const LAS bf16x8*)(kr + 32 * i);
#pragma unroll
                for (int ds = 0; ds < NDS; ++ds) {
                    const bf16x8 a0 = af[ds % PF];
                    if (ds + PF < NDS) af[ds % PF] = *(const LAS bf16x8*)(kr + 32 * (ds + PF));
                    sb[kbk] = __builtin_amdgcn_mfma_f32_32x32x16_bf16(a0, qf[ds], sb[kbk], 0, 0, 0);
                }
            }

#pragma unroll
            for (int kbk = 0; kbk < 2; ++kbk) {
                f32x16 s0 = sb[kbk];
                bf16x8 vfr[2 * NDB];
#pragma unroll
                for (int db = 0; db < NDB; ++db) { vfr[2 * db] = *(const LAS bf16x8*)(vb + (32 * db + rho) * VP + (32 * kbk + 8 * hi) * 2); vfr[2 * db + 1] = *(const LAS bf16x8*)(vb + (32 * db + rho) * VP + (32 * kbk + 16 + 8 * hi) * 2); }
                asm volatile("" ::: "memory");
                if (MASKED) {
                    const unsigned w0 = (unsigned)(sw >> (32 * kbk)) >> (8 * hi);
#pragma unroll
                    for (int r = 0; r < 16; ++r) { const unsigned mk = (unsigned)((int)(w0 << (31 - (16 * (r >> 3) + (r & 7)))) >> 31);
                        s0[r] = __uint_as_float((mk & __float_as_uint(s0[r])) | (~mk & 0xff800000u)); }
                }
                f32x16 pe; float ps = 0.f;
#pragma unroll
                for (int r = 0; r < 16; ++r) { pe[r] = __builtin_amdgcn_exp2f(s0[r] - m); ps += pe[r]; }
                if (__any(!(ps <= ATT_BIG))) {
                    float mx = s0[0];
#pragma unroll
                    for (int r = 1; r < 16; ++r) mx = fmaxf(mx, s0[r]);
                    { const auto rr = __builtin_amdgcn_permlane32_swap(__float_as_uint(mx), __float_as_uint(mx), false, false); mx = fmaxf(__uint_as_float(rr[0]), __uint_as_float(rr[1])); }
                    const float mn = fmaxf(m, mx), alpha = __builtin_amdgcn_exp2f(m - mn); m = mn; l *= alpha;
#pragma unroll
                    for (int db = 0; db < NDB; ++db)
#pragma unroll
                        for (int r = 0; r < 16; ++r) o[db][r] *= alpha;
                    ps = 0.f;
#pragma unroll
                    for (int r = 0; r < 16; ++r) { pe[r] = __builtin_amdgcn_exp2f(s0[r] - m); ps += pe[r]; }
                }
                l += ps;
                bf16x8 pf[2];
#pragma unroll
                for (int s = 0; s < 2; ++s) { u32x4 p0;
                    p0.x = cvtpk(pe[8 * s], pe[8 * s + 1]); p0.y = cvtpk(pe[8 * s + 2], pe[8 * s + 3]); p0.z = cvtpk(pe[8 * s + 4], pe[8 * s + 5]); p0.w = cvtpk(pe[8 * s + 6], pe[8 * s + 7]);
                    pf[s] = __builtin_bit_cast(bf16x8, p0); }

#pragma unroll
                for (int db = 0; db < NDB; ++db) {
                    o[db] = __builtin_amdgcn_mfma_f32_32x32x16_bf16(vfr[2 * db], pf[0], o[db], 0, 0, 0);
                    o[db] = __builtin_amdgcn_mfma_f32_32x32x16_bf16(vfr[2 * db + 1], pf[1], o[db], 0, 0, 0);
                }

            }
        }
        if (t + 1 < NT) AT_STORE(buf ^ 1, (u + 1) & 3);
        __syncthreads();
      }
    }
#undef AT_LOAD
#undef AT_STORE
    const float lt = l + __shfl_xor(l, 32); const float inv = 1.0f / lt;
    bf16* op = O + (size_t)(32 * wid + rho) * opitch + 4 * hi;
#pragma unroll
    for (int db = 0; db < NDB; ++db)
#pragma unroll
        for (int g4 = 0; g4 < 4; ++g4) { u32x2 w; w.x = cvtpk(o[db][4 * g4] * inv, o[db][4 * g4 + 1] * inv); w.y = cvtpk(o[db][4 * g4 + 2] * inv, o[db][4 * g4 + 3] * inv);
            *(u32x2*)(op + 32 * db + 8 * g4) = w; }
}

template <int DQK, int DK1, int DV, bool MASKED, bool QLDS>
__device__ __forceinline__ void attn_unit_pipe(LAS unsigned char* lds, const bf16* Q, int qpitch, const bf16* K1, int k1p, const bf16* K2, int k2p, const bf16* Vt, int vp,
                                          const unsigned long long* SEL, bf16* O, int opitch, int qb, int tid) {
    constexpr int KP = DQK * 2 + 16, VP = 144, KBYTES = 64 * KP, VBYTES = DV * VP, VOFF = 2 * KBYTES;
    constexpr int C1 = DK1 / 8, C2 = (DQK - DK1) / 8, NK1 = 64 * C1 / 512, NK2 = 64 * C2 / 512, NVC = DV * 8 / 512, NDS = DQK / 16, NDB = DV / 32;
    static_assert(64 * C1 % 512 == 0 && 64 * C2 % 512 == 0 && DV * 8 % 512 == 0 && 2 * KBYTES + 3 * VBYTES <= LDS_RING, "attention tile staging");
    const int lane = tid & 63, wid = __builtin_amdgcn_readfirstlane(tid >> 6), rho = lane & 31, hi = lane >> 5;
    const int prho = (rho & ~12) | ((rho & 8) >> 1) | ((rho & 4) << 1);
    const int NT = 4 * qb + 4, cw = 4 * qb + (wid >> 1);
    constexpr int NQR = QLDS ? DK1 / 16 : NDS, QOFF = VOFF + 3 * VBYTES;
    static_assert(!QLDS || QOFF + 8 * 32 * 144 <= LDS_BYTES - 8192, "Q image");
    bf16x8 qf[NQR];
    LAS unsigned char* const qlds = lds + QOFF + (32 * wid + rho) * 144 + 16 * hi;
    { const bf16* qp = Q + (size_t)(32 * wid + rho) * qpitch + 8 * hi;
#pragma unroll
      for (int ds = 0; ds < NDS; ++ds) { const bf16x8 v = *(const bf16x8*)(qp + 16 * ds); if (ds < NQR) qf[ds] = v; else *(LAS bf16x8*)(qlds + 32 * (ds - NQR)) = v; } }
    const unsigned long long* selp = MASKED ? SEL + (size_t)(32 * wid + rho) * 64 : nullptr;
    const __amdgpu_buffer_rsrc_t r1 = __builtin_amdgcn_make_buffer_rsrc((void*)K1, 0, 0x7fffffff, 0x00020000);
    const __amdgpu_buffer_rsrc_t r2 = __builtin_amdgcn_make_buffer_rsrc((void*)(C2 ? K2 : K1), 0, 0x7fffffff, 0x00020000);
    const __amdgpu_buffer_rsrc_t rv = __builtin_amdgcn_make_buffer_rsrc((void*)Vt, 0, 0x7fffffff, 0x00020000);
#define AT_OFFS() int tq_ = tid; asm volatile("" : "+v"(tq_)); int ko1[NK1], kl1[NK1], ko2[NK2 ? NK2 : 1], kl2[NK2 ? NK2 : 1], vo[NVC], vl[NVC]; \
        _Pragma("unroll") for (int i = 0; i < NK1; ++i) { const int cid = tq_ + 512 * i, row = cid / C1, ch = cid % C1; ko1[i] = (row * k1p + 8 * ch) * 2; kl1[i] = row * KP + ch * 16; } \
        _Pragma("unroll") for (int i = 0; i < NK2; ++i) { const int cid = tq_ + 512 * i, row = cid / (C2 ? C2 : 1), ch = cid % (C2 ? C2 : 1); ko2[i] = (row * k2p + 8 * ch) * 2; kl2[i] = row * KP + (C1 + ch) * 16; } \
        _Pragma("unroll") for (int i = 0; i < NVC; ++i) { const int cid = tq_ + 512 * i, d = cid >> 3, ch = cid & 7; vo[i] = (d * vp + 8 * ch) * 2; vl[i] = VOFF + d * VP + ch * 16; } \
        (void)ko1; (void)kl1; (void)ko2; (void)kl2; (void)vo; (void)vl
    u32x4 kreg1[NK1], kreg2[NK2 ? NK2 : 1], vreg[NVC];
#define AT_LOADK(t) do { AT_OFFS(); \
        _Pragma("unroll") for (int i = 0; i < NK1; ++i) kreg1[i] = __builtin_amdgcn_raw_buffer_load_b128(r1, ko1[i], (t) * 64 * k1p * 2, 0); \
        _Pragma("unroll") for (int i = 0; i < NK2; ++i) kreg2[i] = __builtin_amdgcn_raw_buffer_load_b128(r2, ko2[i], (t) * 64 * k2p * 2, 0); } while (0)
#define AT_LOADV(t) do { AT_OFFS(); \
        _Pragma("unroll") for (int i = 0; i < NVC; ++i) vreg[i] = __builtin_amdgcn_raw_buffer_load_b128(rv, vo[i], (t) * 128, 0); } while (0)
#define AT_STOREK(buf) do { AT_OFFS(); \
        _Pragma("unroll") for (int i = 0; i < NK1; ++i) *(LAS u32x4*)(lds + (buf) * KBYTES + kl1[i]) = kreg1[i]; \
        _Pragma("unroll") for (int i = 0; i < NK2; ++i) *(LAS u32x4*)(lds + (buf) * KBYTES + kl2[i]) = kreg2[i]; } while (0)
#define AT_STOREV(buf) do { AT_OFFS(); \
        _Pragma("unroll") for (int i = 0; i < NVC; ++i) *(LAS u32x4*)(lds + (buf) * VBYTES + vl[i]) = vreg[i]; } while (0)
    f32x16 o[NDB];
#pragma unroll
    for (int db = 0; db < NDB; ++db)
#pragma unroll
        for (int r = 0; r < 16; ++r) o[db][r] = 0.f;
    float m = -1e30f, l = 0.f;
    f32x16 sc;
    constexpr int PF = (NDS < 2) ? NDS : 2;
    constexpr int NCH = 12, CPM = NCH / NDS;
    static_assert(NCH % NDS == 0, "softmax chunking");
#define AT_QK_PLAIN(kbase) do { \
        _Pragma("unroll") for (int r = 0; r < 16; ++r) sc[r] = 0.f; \
        const LAS unsigned char* kr_ = (kbase) + prho * KP + 16 * hi; bf16x8 af_[PF]; \
        _Pragma("unroll") for (int i = 0; i < PF; ++i) af_[i] = *(const LAS bf16x8*)(kr_ + 32 * i); \
        _Pragma("unroll") for (int ds = 0; ds < NDS; ++ds) { const bf16x8 a0 = af_[ds % PF]; if (ds + PF < NDS) af_[ds % PF] = *(const LAS bf16x8*)(kr_ + 32 * (ds + PF)); \
            const bf16x8 qv = (ds < NQR) ? qf[ds < NQR ? ds : 0] : *(const LAS bf16x8*)(qlds + 32 * (ds - NQR)); \
            sc = __builtin_amdgcn_mfma_f32_32x32x16_bf16(a0, qv, sc, 0, 0, 0); } } while (0)
#define AT_STEP(HAVE_NEXT, knext, vbase, koff, mw) do { \
        f32x16 sn; \
        _Pragma("unroll") for (int r = 0; r < 16; ++r) sn[r] = 0.f; \
        const LAS unsigned char* kr_ = (knext) + prho * KP + 16 * hi; bf16x8 af_[PF]; \
        if (HAVE_NEXT) { _Pragma("unroll") for (int i = 0; i < PF; ++i) af_[i] = *(const LAS bf16x8*)(kr_ + 32 * i); } \
        bf16x8 va0 = *(const LAS bf16x8*)((vbase) + rho * VP + ((koff) + 8 * hi) * 2), va1 = *(const LAS bf16x8*)((vbase) + rho * VP + ((koff) + 16 + 8 * hi) * 2);     \
        float mx = 0.f, alpha = 1.f, ps = 0.f; u32x4 pw0, pw1; bf16x8 qn = af_[0]; \
        _Pragma("unroll") for (int c = 0; c < NCH; ++c) { \
            if (c == 0) { if (MASKED) { const unsigned w0_ = (mw) >> (8 * hi); \
                    _Pragma("unroll") for (int r = 0; r < 16; ++r) { const unsigned bit = 1u << (16 * (r >> 3) + (r & 7)); sc[r] = (w0_ & bit) ? sc[r] : -INFINITY; } } \
                mx = fmaxf(fmaxf(fmaxf(sc[0], sc[1]), fmaxf(sc[2], sc[3])), fmaxf(fmaxf(sc[4], sc[5]), fmaxf(sc[6], sc[7]))); } \
            else if (c == 1) { mx = fmaxf(mx, fmaxf(fmaxf(fmaxf(sc[8], sc[9]), fmaxf(sc[10], sc[11])), fmaxf(fmaxf(sc[12], sc[13]), fmaxf(sc[14], sc[15])))); \
                const auto rr = __builtin_amdgcn_permlane32_swap(__float_as_uint(mx), __float_as_uint(mx), false, false); mx = fmaxf(__uint_as_float(rr[0]), __uint_as_float(rr[1])); \
                const float mn = fmaxf(m, mx); alpha = __builtin_amdgcn_exp2f(m - mn); m = mn; l *= alpha; } \
            else if (c < 10) { const int e = 2 * (c - 2); sc[e] = __builtin_amdgcn_exp2f(sc[e] - m); sc[e + 1] = __builtin_amdgcn_exp2f(sc[e + 1] - m); ps += sc[e] + sc[e + 1]; } \
            else if (c == 10) { pw0.x = cvtpk(sc[0], sc[1]); pw0.y = cvtpk(sc[2], sc[3]); pw0.z = cvtpk(sc[4], sc[5]); pw0.w = cvtpk(sc[6], sc[7]); } \
            else { pw1.x = cvtpk(sc[8], sc[9]); pw1.y = cvtpk(sc[10], sc[11]); pw1.z = cvtpk(sc[12], sc[13]); pw1.w = cvtpk(sc[14], sc[15]); l += ps; } \
            if (HAVE_NEXT && (c % CPM) == 0) { const int ds = c / CPM; const bf16x8 a0 = af_[ds % PF]; if (ds + PF < NDS) af_[ds % PF] = *(const LAS bf16x8*)(kr_ + 32 * (ds + PF)); \
                const bf16x8 qv = (ds < NQR) ? qf[ds < NQR ? ds : 0] : qn; if (QLDS && ds + 1 >= NQR && ds + 1 < NDS) qn = *(const LAS bf16x8*)(qlds + 32 * (ds + 1 - NQR)); \
                sn = __builtin_amdgcn_mfma_f32_32x32x16_bf16(a0, qv, sn, 0, 0, 0); } \
            __builtin_amdgcn_sched_barrier(0); } \
        const bf16x8 pf0 = __builtin_bit_cast(bf16x8, pw0), pf1 = __builtin_bit_cast(bf16x8, pw1); \
        _Pragma("unroll") for (int r = 0; r < 16; ++r) o[0][r] *= alpha; \
        __builtin_amdgcn_sched_barrier(0); \
        _Pragma("unroll") for (int db = 0; db < NDB; ++db) { \
            bf16x8 vb0 = va0, vb1 = va1; \
            if (db + 1 < NDB) { vb0 = *(const LAS bf16x8*)((vbase) + (32 * (db + 1) + rho) * VP + ((koff) + 8 * hi) * 2); vb1 = *(const LAS bf16x8*)((vbase) + (32 * (db + 1) + rho) * VP + ((koff) + 16 + 8 * hi) * 2); } \
            o[db] = __builtin_amdgcn_mfma_f32_32x32x16_bf16(va0, pf0, o[db], 0, 0, 0); \
            if (db + 1 < NDB) { _Pragma("unroll") for (int r = 0; r < 8; ++r) o[db + 1][r] *= alpha; } \
            __builtin_amdgcn_sched_barrier(0); \
            o[db] = __builtin_amdgcn_mfma_f32_32x32x16_bf16(va1, pf1, o[db], 0, 0, 0); \
            if (db + 1 < NDB) { _Pragma("unroll") for (int r = 8; r < 16; ++r) o[db + 1][r] *= alpha; } \
            __builtin_amdgcn_sched_barrier(0); \
            va0 = vb0; va1 = vb1; } \
        if (HAVE_NEXT) sc = sn; } while (0)
    __syncthreads();
    AT_LOADK(0); AT_LOADV(0); AT_STOREK(0); AT_STOREV(0);
    __syncthreads();
    unsigned long long swp = 0ull;
    int v3 = 0;
    unsigned long long swn = 0ull; if (MASKED) swn = selp[0];
    for (int t = 0; t < NT; ++t) {
        const int buf = t & 1, v3n = (v3 == 2) ? 0 : v3 + 1, v3p = (v3 == 0) ? 2 : v3 - 1; const bool more = t + 1 < NT;
        if (more) AT_LOADK(t + 1);
        const LAS unsigned char* kb = lds + buf * KBYTES; const LAS unsigned char* vb = lds + VOFF + v3 * VBYTES; const LAS unsigned char* vbp = lds + VOFF + v3p * VBYTES;
        const unsigned long long sw = swn; if (MASKED && t + 1 <= cw) swn = selp[t + 1];
        if (t <= cw) {
            if (t == 0) AT_QK_PLAIN(kb);
            else AT_STEP(true, kb, vbp, 32, (unsigned)(swp >> 32));
        }
        if (more) { AT_STOREK(buf ^ 1); AT_LOADV(t + 1); }
        if (t <= cw) {
            AT_STEP(true, kb + 32 * KP, vb, 0, (unsigned)sw);
            if (t == cw) AT_STEP(false, kb, vb, 32, (unsigned)(sw >> 32));
            swp = sw;
        }
        if (more) AT_STOREV(v3n);
        v3 = v3n;
        __syncthreads();
    }
#undef AT_QK_PLAIN
#undef AT_STEP
#undef AT_LOAD
#undef AT_STORE
#undef AT_LOADK
#undef AT_LOADV
#undef AT_STOREK
#undef AT_STOREV
#undef AT_OFFS
    const float lt = l + __shfl_xor(l, 32); const float inv = 1.0f / lt;
    bf16* op = O + (size_t)(32 * wid + rho) * opitch + 4 * hi;
#pragma unroll
    for (int db = 0; db < NDB; ++db)
#pragma unroll
        for (int g4 = 0; g4 < 4; ++g4) { u32x2 w; w.x = cvtpk(o[db][4 * g4] * inv, o[db][4 * g4 + 1] * inv); w.y = cvtpk(o[db][4 * g4 + 2] * inv, o[db][4 * g4 + 3] * inv);
            *(u32x2*)(op + 32 * db + 8 * g4) = w; }
}

template <int DQK, int DK1, int DV, bool MASKED>
__device__ __forceinline__ void sattn_block(LAS unsigned char* lds, const bf16* Q, int qpitch, const bf16* K1, int k1p, const bf16* K2, int k2p, const bf16* Vt, int vp,
                                            const unsigned long long* SEL, bf16* O, int opitch, int tid) {
    constexpr int NDS = DQK / 16, NDS1 = DK1 / 16, NDB = DV / 32, NT = (SKEYS + 63) / 64;
    const int lane = tid & 63, wid = __builtin_amdgcn_readfirstlane(tid >> 6), rho = lane & 31, hi = lane >> 5, qr = rho & 15;
    const int prho = (rho & ~12) | ((rho & 8) >> 1) | ((rho & 4) << 1);
    bf16x8 qf[NDS];
    { const bf16* qp = Q + (size_t)qr * qpitch + 8 * hi;
#pragma unroll
      for (int ds = 0; ds < NDS; ++ds) qf[ds] = *(const bf16x8*)(qp + 16 * ds); }
    const unsigned long long* selp = MASKED ? SEL + (size_t)qr * 64 : nullptr;
    f32x16 o[NDB];
#pragma unroll
    for (int db = 0; db < NDB; ++db)
#pragma unroll
        for (int r = 0; r < 16; ++r) o[db][r] = 0.f;
    float m = -1e30f, l = 0.f;
    for (int t = wid; t < NT; t += 8) {
        unsigned long long sw = 0ull; if (MASKED) sw = selp[t];
#pragma unroll
        for (int kbk = 0; kbk < 2; ++kbk) {
            const int kb0 = 64 * t + 32 * kbk;
            if (kb0 < SKEYS) {
                const int krow = (kb0 + prho < SKEYS) ? kb0 + prho : 0;
                const bf16* k1 = K1 + (size_t)krow * k1p + 8 * hi; const bf16* k2 = (NDS > NDS1) ? K2 + (size_t)krow * k2p + 8 * hi : K1;
                bf16x8 af[NDS];
#pragma unroll
                for (int ds = 0; ds < NDS; ++ds) af[ds] = (ds < NDS1) ? *(const bf16x8*)(k1 + 16 * ds) : *(const bf16x8*)(k2 + 16 * (ds - NDS1));
                bf16x8 vf[2][NDB];
#pragma unroll
                for (int s = 0; s < 2; ++s)
#pragma unroll
                    for (int db = 0; db < NDB; ++db) vf[s][db] = *(const bf16x8*)(Vt + (size_t)(32 * db + rho) * vp + kb0 + ((kb0 + 16 * s < SKEYS) ? 16 * s : 0) + 8 * hi);
                f32x16 s0;
#pragma unroll
                for (int r = 0; r < 16; ++r) s0[r] = 0.f;
#pragma unroll
                for (int ds = 0; ds < NDS; ++ds) s0 = __builtin_amdgcn_mfma_f32_32x32x16_bf16(af[ds], qf[ds], s0, 0, 0, 0);
                const unsigned w0 = MASKED ? ((unsigned)(sw >> (32 * kbk)) >> (8 * hi)) : 0xffffffffu;
#pragma unroll
                for (int r = 0; r < 16; ++r) { const int kl = 16 * (r >> 3) + (r & 7); const bool on = (w0 & (1u << kl)) && (kb0 + kl + 8 * hi < SKEYS); s0[r] = on ? s0[r] : -INFINITY; }
                float mx = s0[0];
#pragma unroll
                for (int r = 1; r < 16; ++r) mx = fmaxf(mx, s0[r]);
                mx = fmaxf(mx, __shfl_xor(mx, 32));
                if (__any(mx > m + ATT_THR)) {
                  const float mn = fmaxf(m, mx), alpha = __builtin_amdgcn_exp2f(m - mn); m = mn; l *= alpha;
#pragma unroll
                  for (int db = 0; db < NDB; ++db)
#pragma unroll
                      for (int r = 0; r < 16; ++r) o[db][r] *= alpha; }
                float ps = 0.f;
#pragma unroll
                for (int r = 0; r < 16; ++r) { s0[r] = __builtin_amdgcn_exp2f(s0[r] - m); ps += s0[r]; }
                l += ps;
#pragma unroll
                for (int s = 0; s < 2; ++s) {
                    if (kb0 + 16 * s < SKEYS) {
                        u32x4 p0;
                        p0.x = cvtpk(s0[8 * s], s0[8 * s + 1]); p0.y = cvtpk(s0[8 * s + 2], s0[8 * s + 3]); p0.z = cvtpk(s0[8 * s + 4], s0[8 * s + 5]); p0.w = cvtpk(s0[8 * s + 6], s0[8 * s + 7]);
                        const bf16x8 pf = __builtin_bit_cast(bf16x8, p0);
#pragma unroll
                        for (int db = 0; db < NDB; ++db) o[db] = __builtin_amdgcn_mfma_f32_32x32x16_bf16(vf[s][db], pf, o[db], 0, 0, 0);
                    }
                }
            }
        }
    }
    LAS float* ML = (LAS float*)lds; LAS float* OS = (LAS float*)(lds + 1024);
    const float lt = l + __shfl_xor(l, 32);
    __syncthreads();
    if (lane < 16) { ML[(wid * 16 + lane) * 2] = m; ML[(wid * 16 + lane) * 2 + 1] = lt; }
    if (rho < 16) {
#pragma unroll
        for (int db = 0; db < NDB; ++db)
#pragma unroll
            for (int r = 0; r < 16; ++r) { const int d = 32 * db + (r & 3) + 8 * (r >> 2) + 4 * hi; OS[(wid * DV + d) * 16 + rho] = o[db][r]; }
    }
    __syncthreads();
    { const int q = tid & 15, d0 = tid >> 4;
      float mw[8], mm = -1e30f;
#pragma unroll
      for (int w = 0; w < 8; ++w) { mw[w] = ML[(w * 16 + q) * 2]; mm = fmaxf(mm, mw[w]); }
      float den = 0.f;
#pragma unroll
      for (int w = 0; w < 8; ++w) { mw[w] = __builtin_amdgcn_exp2f(mw[w] - mm); den += ML[(w * 16 + q) * 2 + 1] * mw[w]; }
      const float inv = 1.0f / den;
#pragma unroll
      for (int j = 0; j < DV / 32; ++j) { const int d = d0 + 32 * j; float num = 0.f;
#pragma unroll
          for (int w = 0; w < 8; ++w) num += OS[(w * DV + d) * 16 + q] * mw[w];
          O[(size_t)q * opitch + d] = (bf16)(cvtpk(num * inv, 0.f) & 0xffffu); } }
    __syncthreads();
}

template <int P> __device__ __forceinline__ void ln_row(const bf16* xin, const bf16* trow, const float* slab  , const float* gate, const float* lng, const float* lnb, bf16* xout, float* yout  , const float* sc, const float* sh, bf16* hrow, int lane) {
    f32x4 y[8]; float s = 0.f;
#pragma unroll
    for (int j = 0; j < 8; ++j) { const int col = 4 * lane + 256 * j; const u32x2 xw = *(const u32x2*)(xin + col); const f32x4 x = (f32x4){bflo(xw.x), bfhi(xw.x), bflo(xw.y), bfhi(xw.y)}, g = *(const f32x4*)(gate + col);
        f32x4 tv;
        if (!slab) { const u32x2 tw = *(const u32x2*)(trow + col); tv = (f32x4){bflo(tw.x), bfhi(tw.x), bflo(tw.y), bfhi(tw.y)}; }
        else { tv = *(const f32x4*)(slab + col);
#pragma unroll
            for (int pp = 1; pp < P; ++pp) tv += *(const f32x4*)(slab + (size_t)pp * 256 * D + col); }
        y[j] = x * ALPHA_RES + (1.f + g) * tv; s += (y[j].x + y[j].y) + (y[j].z + y[j].w); }
    const float mean = wave_sum(s) * (1.f / D); float s2 = 0.f;
#pragma unroll
    for (int j = 0; j < 8; ++j) { y[j] = y[j] - mean; s2 += (y[j].x * y[j].x + y[j].y * y[j].y) + (y[j].z * y[j].z + y[j].w * y[j].w); }
    const float rstd = 1.0f / sqrtf(wave_sum(s2) * (1.f / D) + LN_EPS);
#pragma unroll
    for (int j = 0; j < 8; ++j) { const int col = 4 * lane + 256 * j; const f32x4 g = *(const f32x4*)(lng + col), b = *(const f32x4*)(lnb + col);
        const f32x4 xn = y[j] * rstd * g + b;
        if (yout) *(f32x4*)(yout + col) = xn; else { u32x2 xo; xo.x = cvtpk(xn.x, xn.y); xo.y = cvtpk(xn.z, xn.w); *(u32x2*)(xout + col) = xo; }
        if (sc) { const f32x4 c = *(const f32x4*)(sc + col), h = *(const f32x4*)(sh + col); const f32x4 o = xn * (1.f + c) + h; u32x2 w; w.x = cvtpk(o.x, o.y); w.y = cvtpk(o.z, o.w); *(u32x2*)(hrow + col) = w; } }
}

__device__ __forceinline__ void ln_row2(const bf16* xin0, const bf16* xin1, const bf16* trow0, const bf16* trow1, const float* gate0, const float* gate1, const float* lng, const float* lnb,
                                        bf16* xout0, bf16* xout1, float* yout0, float* yout1, const float* sc0, const float* sc1, const float* sh0, const float* sh1, bf16* hrow0, bf16* hrow1, int lane) {
    f32x4 y0[8], y1[8]; float s0 = 0.f, s1 = 0.f;
#pragma unroll
    for (int j = 0; j < 8; ++j) { const int col = 4 * lane + 256 * j;
        const u32x2 xwa = *(const u32x2*)(xin0 + col), xwb = *(const u32x2*)(xin1 + col); const f32x4 xa = (f32x4){bflo(xwa.x), bfhi(xwa.x), bflo(xwa.y), bfhi(xwa.y)}, xb = (f32x4){bflo(xwb.x), bfhi(xwb.x), bflo(xwb.y), bfhi(xwb.y)};
        const f32x4 ga = *(const f32x4*)(gate0 + col), gb = *(const f32x4*)(gate1 + col);
        const u32x2 ta = *(const u32x2*)(trow0 + col), tb = *(const u32x2*)(trow1 + col);
        y0[j] = xa * ALPHA_RES + (1.f + ga) * (f32x4){bflo(ta.x), bfhi(ta.x), bflo(ta.y), bfhi(ta.y)}; s0 += (y0[j].x + y0[j].y) + (y0[j].z + y0[j].w);
        y1[j] = xb * ALPHA_RES + (1.f + gb) * (f32x4){bflo(tb.x), bfhi(tb.x), bflo(tb.y), bfhi(tb.y)}; s1 += (y1[j].x + y1[j].y) + (y1[j].z + y1[j].w); }
#pragma unroll
    for (int o = 1; o < 64; o <<= 1) { s0 += __shfl_xor(s0, o); s1 += __shfl_xor(s1, o); }
    const float mean0 = s0 * (1.f / D), mean1 = s1 * (1.f / D); float q0 = 0.f, q1 = 0.f;
#pragma unroll
    for (int j = 0; j < 8; ++j) { y0[j] = y0[j] - mean0; q0 += (y0[j].x * y0[j].x + y0[j].y * y0[j].y) + (y0[j].z * y0[j].z + y0[j].w * y0[j].w);
        y1[j] = y1[j] - mean1; q1 += (y1[j].x * y1[j].x + y1[j].y * y1[j].y) + (y1[j].z * y1[j].z + y1[j].w * y1[j].w); }
#pragma unroll
    for (int o = 1; o < 64; o <<= 1) { q0 += __shfl_xor(q0, o); q1 += __shfl_xor(q1, o); }
    const float r0 = 1.0f / sqrtf(q0 * (1.f / D) + LN_EPS), r1 = 1.0f / sqrtf(q1 * (1.f / D) + LN_EPS);
#pragma unroll
    for (int j = 0; j < 8; ++j) { const int col = 4 * lane + 256 * j; const f32x4 g = *(const f32x4*)(lng + col), b = *(const f32x4*)(lnb + col);
        const f32x4 xa = y0[j] * r0 * g + b, xb = y1[j] * r1 * g + b;
        if (yout0) { *(f32x4*)(yout0 + col) = xa; *(f32x4*)(yout1 + col) = xb; }
        else { u32x2 pa, pb; pa.x = cvtpk(xa.x, xa.y); pa.y = cvtpk(xa.z, xa.w); pb.x = cvtpk(xb.x, xb.y); pb.y = cvtpk(xb.z, xb.w); *(u32x2*)(xout0 + col) = pa; *(u32x2*)(xout1 + col) = pb; }
        if (sc0) { const f32x4 ca = *(const f32x4*)(sc0 + col), ha = *(const f32x4*)(sh0 + col), cb = *(const f32x4*)(sc1 + col), hb = *(const f32x4*)(sh1 + col);
            const f32x4 oa = xa * (1.f + ca) + ha, ob = xb * (1.f + cb) + hb; u32x2 wa, wb; wa.x = cvtpk(oa.x, oa.y); wa.y = cvtpk(oa.z, oa.w); wb.x = cvtpk(ob.x, ob.y); wb.y = cvtpk(ob.z, ob.w);
            *(u32x2*)(hrow0 + col) = wa; *(u32x2*)(hrow1 + col) = wb; } }
}

__device__ __forceinline__ void pi_row(const Args& a, int l, int r, int lane, int s_lo, int s_hi) {
    unsigned char* ws = a.ws;
    const bf16* G0 = (const bf16*)(ws + WS_GU) + (size_t)r * NGU;
    const bool smp = r >= MP; int b, t, T;
    if (!smp) { b = r >> 12; t = r & 4095; T = SEQ; } else { const int rs = r - MP; b = rs >> 4; t = rs & 15; T = TS; }
    const float* st = a.in[10] + ((size_t)(l * NBS + b) * 2) * DFF;
    const float* cw = a.in[24] + (size_t)l * 3 * DFF;
    bf16* arow = (bf16*)(ws + WS_ACT) + (size_t)r * DFF;
    float* so = (t >= T - 2) ? a.out + (smp ? O_SCF + ((size_t)(l * NBS + b) * 2 + (t - (T - 2))) * DFF : O_PCF + ((size_t)(l * NBP + b) * 2 + (t - (T - 2))) * DFF) : nullptr;
    const float* SH = (const float*)(ws + WS_SLAB); const int rs = r - MP;
#define PI_LD8(dr, col, dst) do { const int c_ = (col) < DFF ? (col) : (col) - DFF; slab_ld8<SP_H>(SH, NGU, rs + (dr), 256 * (c_ / 128) + c_ % 128 + ((col) < DFF ? 0 : 128), dst); } while (0)
    for (int s = s_lo; s < s_hi; ++s) {
        const int c = 8 * (lane + 64 * s);
        float g0[8], g1[8], g2[8], up[8], w0[8], w1[8], w2[8], z[8];
        PI_LD8(0, c, g0); PI_LD8(0, DFF + c, up);
        if (t >= 1) PI_LD8(-1, c, g1); else if (smp) ld8f(st + DFF + c, g1); else {
#pragma unroll
            for (int i = 0; i < 8; ++i) g1[i] = 0.f; }
        if (t >= 2) PI_LD8(-2, c, g2); else if (smp) ld8f(st + (size_t)t * DFF + c, g2); else {
#pragma unroll
            for (int i = 0; i < 8; ++i) g2[i] = 0.f; }
        ld8f(cw + c, w0); ld8f(cw + DFF + c, w1); ld8f(cw + 2 * DFF + c, w2);
#pragma unroll
        for (int i = 0; i < 8; ++i) { const float gc = g2[i] * w0[i] + g1[i] * w1[i] + g0[i] * w2[i]; z[i] = gc / (1.f + __expf(-gc)) * up[i]; }
        st16(arow + c, pack8(z));
        if (so) st8f_nt(so + c, g0);
    }
#undef PI_LD8
}

__device__ __forceinline__ void pi_block(const Args& a, int l, int item, int lane) {
    unsigned char* ws = a.ws;
    const int rb = item / 11, strip = item - rb * 11, r0 = rb * 16, c = 512 * strip + 8 * lane;
    const int b = r0 >> 12, t0 = r0 & 4095;
    const bf16* G0 = (const bf16*)(ws + WS_GU) + (size_t)r0 * NGU + c;
    bf16* arow = (bf16*)(ws + WS_ACT) + (size_t)r0 * DFF + c;
    float w0[8], w1[8], w2[8], g1[8], g2[8];
    { const float* cw = a.in[24] + (size_t)l * 3 * DFF + c; ld8f(cw, w0); ld8f(cw + DFF, w1); ld8f(cw + 2 * DFF, w2); }
    if (t0 > 0) { unpack8(ld16(G0 - NGU), g1); unpack8(ld16(G0 - 2 * NGU), g2); }
    else {
#pragma unroll
        for (int i = 0; i < 8; ++i) { g1[i] = 0.f; g2[i] = 0.f; } }
#pragma unroll
    for (int hb = 0; hb < 2; ++hb) {
        u32x4 gq[8], uq[8];
#pragma unroll
        for (int i = 0; i < 8; ++i) { gq[i] = ld16(G0 + (size_t)(8 * hb + i) * NGU); uq[i] = ld16(G0 + (size_t)(8 * hb + i) * NGU + DFF); }
#pragma unroll
        for (int i = 0; i < 8; ++i) { float g0[8], up[8], z[8]; unpack8(gq[i], g0); unpack8(uq[i], up);
#pragma unroll
            for (int e = 0; e < 8; ++e) { const float gc = g2[e] * w0[e] + g1[e] * w1[e] + g0[e] * w2[e]; z[e] = gc / (1.f + __expf(-gc)) * up[e]; }
            st16(arow + (size_t)(8 * hb + i) * DFF, pack8(z));
            const int t = t0 + 8 * hb + i;
            if (t >= SEQ - 2) st8f(a.out + O_PCF + ((size_t)(l * NBP + b) * 2 + (t - (SEQ - 2))) * DFF + c, g0);
#pragma unroll
            for (int e = 0; e < 8; ++e) { g2[e] = g1[e]; g1[e] = g0[e]; } }
    }
}

__device__ __forceinline__ void pi_fix(const Args& a, int l, int item, int lane) {
    unsigned char* ws = a.ws; const int pm = item / 11, strip = item - pm * 11, c = 512 * strip + 8 * lane;
    const float* GH = (const float*)(ws + WS_GH); const float* G01 = (const float*)(ws + WS_G01) + (size_t)pm * 4 * DFF + c;
    float w0[8], w1[8], w2[8], ga[8], gb[8], ua[8], ub[8], p14[8], p15[8], z[8];
    { const float* cw = a.in[24] + (size_t)l * 3 * DFF + c; ld8f(cw, w0); ld8f(cw + DFF, w1); ld8f(cw + 2 * DFF, w2); }
    ld8f(G01, ga); ld8f(G01 + DFF, ua); ld8f(G01 + 2 * DFF, gb); ld8f(G01 + 3 * DFF, ub);
    if (pm & 15) { ld8f(GH + ((size_t)(pm - 1) * 2) * DFF + c, p14); ld8f(GH + ((size_t)(pm - 1) * 2 + 1) * DFF + c, p15); }
    else {
#pragma unroll
        for (int i = 0; i < 8; ++i) { p14[i] = 0.f; p15[i] = 0.f; } }
    bf16* arow = (bf16*)(ws + WS_ACT) + (size_t)pm * 256 * DFF + c;
#pragma unroll
    for (int i = 0; i < 8; ++i) { const float gc = p14[i] * w0[i] + p15[i] * w1[i] + ga[i] * w2[i]; z[i] = gc / (1.f + __expf(-gc)) * ua[i]; }
    st16(arow, pack8(z));
#pragma unroll
    for (int i = 0; i < 8; ++i) { const float gc = p15[i] * w0[i] + ga[i] * w1[i] + gb[i] * w2[i]; z[i] = gc / (1.f + __expf(-gc)) * ub[i]; }
    st16(arow + DFF, pack8(z));
    if ((pm & 15) == 15) { const int b = pm >> 4; float* so = a.out + O_PCF + ((size_t)(l * NBP + b) * 2) * DFF + c;
        float g[8]; ld8f(GH + ((size_t)pm * 2) * DFF + c, g); st8f_nt(so, g); ld8f(GH + ((size_t)pm * 2 + 1) * DFF + c, g); st8f_nt(so + DFF, g); }
}


constexpr int LNV_G1 = 0, LNV_LG = 8192, LNV_LB = 16384, LNV_S1 = 24576, LNV_SH = 32768, LNV_RED = 40960;
template <bool HOUT> __device__ __forceinline__ void ln_stage_vectors(LAS unsigned char* lds, const float* gate, const float* lng, const float* lnb, const float* sc, const float* sh, int tid) {
    const int c = 4 * tid, p = (((c >> 9) * 2 + ((c >> 2) & 1)) * 64 + ((c & 511) >> 3)) * 16;
    const f32x4 g = *(const f32x4*)(gate + c), a = *(const f32x4*)(lng + c), b = *(const f32x4*)(lnb + c);
    *(LAS f32x4*)(lds + LNV_G1 + p) = 1.f + g; *(LAS f32x4*)(lds + LNV_LG + p) = a; *(LAS f32x4*)(lds + LNV_LB + p) = b;
    if constexpr (HOUT) { const f32x4 s = *(const f32x4*)(sc + c), h = *(const f32x4*)(sh + c); *(LAS f32x4*)(lds + LNV_S1 + p) = 1.f + s; *(LAS f32x4*)(lds + LNV_SH + p) = h; }
}
__device__ __forceinline__ void lnv_ld8(const LAS unsigned char* lds, int base, int j, int lane, float (&f)[8]) {
    const f32x4 a = *(const LAS f32x4*)(lds + base + ((2 * j) * 64 + lane) * 16), b = *(const LAS f32x4*)(lds + base + ((2 * j + 1) * 64 + lane) * 16);
    f[0] = a.x; f[1] = a.y; f[2] = a.z; f[3] = a.w; f[4] = b.x; f[5] = b.y; f[6] = b.z; f[7] = b.w;
}
#ifdef LNV_GLOBAL
struct LnVec { const float* v[5]; };
__device__ __forceinline__ void lnv_gl8(const float* base, int j, int lane, float (&f)[8]) {
    const __amdgpu_buffer_rsrc_t r = __builtin_amdgcn_make_buffer_rsrc((void*)base, 0, 0x7fffffff, 0x00020000);
    const u32x4 a = __builtin_amdgcn_raw_buffer_load_b128(r, 32 * lane, 2048 * j, 0), b = __builtin_amdgcn_raw_buffer_load_b128(r, 32 * lane, 2048 * j + 16, 0);
    f[0] = __uint_as_float(a.x); f[1] = __uint_as_float(a.y); f[2] = __uint_as_float(a.z); f[3] = __uint_as_float(a.w); f[4] = __uint_as_float(b.x); f[5] = __uint_as_float(b.y); f[6] = __uint_as_float(b.z); f[7] = __uint_as_float(b.w);
}
#define LNV(idx, base, j, ll, dst) do { lnv_gl8(lv.v[idx], j, ll, dst); if ((idx) == 0 || (idx) == 3) { _Pragma("unroll") for (int e_ = 0; e_ < 8; ++e_) dst[e_] += 1.f; } } while (0)
#define LNV_PARAM , const LnVec lv
#else
#define LNV(idx, base, j, ll, dst) lnv_ld8(lds, base, j, ll, dst)
#define LNV_PARAM
#endif
template <bool YOUT, bool HOUT>
__device__ __forceinline__ void ln_rows8(const LAS unsigned char* lds, const bf16* Xi, const bf16* Ti, bf16* Xo, float* Yo, bf16* Ho, size_t row0, int lane LNV_PARAM) {
    const __amdgpu_buffer_rsrc_t rx = __builtin_amdgcn_make_buffer_rsrc((void*)(Xi + row0 * D), 0, 0x7fffffff, 0x00020000), rt = __builtin_amdgcn_make_buffer_rsrc((void*)(Ti + row0 * D), 0, 0x7fffffff, 0x00020000);
    const __amdgpu_buffer_rsrc_t ro = __builtin_amdgcn_make_buffer_rsrc(YOUT ? (void*)(Yo + row0 * D) : (void*)(Xo + row0 * D), 0, 0x7fffffff, 0x00020000);
    const __amdgpu_buffer_rsrc_t rh = __builtin_amdgcn_make_buffer_rsrc(HOUT ? (void*)(Ho + row0 * D) : (void*)(Ti + row0 * D), 0, 0x7fffffff, 0x00020000);
    const int vo = 16 * lane;
#ifdef LN_GLOBAL
#define LN_LDX(o) ld16((const char*)(Xi + row0 * D) + vo + (o))
#define LN_LDT(o) ld16((const char*)(Ti + row0 * D) + vo + (o))
#define LN_STX(v, o) st16((char*)(Xo + row0 * D) + vo + (o), v)
#define LN_STH(v, o) st16((char*)(Ho + row0 * D) + vo + (o), v)
#else
#define LN_LDX(o) __builtin_amdgcn_raw_buffer_load_b128(rx, vo + ((o) & 4095), (o) & ~4095, 0)
#define LN_LDT(o) __builtin_amdgcn_raw_buffer_load_b128(rt, vo + ((o) & 4095), (o) & ~4095, 0)
#define LN_STX(v, o) __builtin_amdgcn_raw_buffer_store_b128(v, ro, vrow + ((o) & 4095), 0, 0)
#define LN_STH(v, o) __builtin_amdgcn_raw_buffer_store_b128(v, rh, vrow + ((o) & 4095), 0, 0)
#endif
    u32x4 xr[2][4], tr[2][4];
#pragma unroll
    for (int rr = 0; rr < 2; ++rr)
#pragma unroll
        for (int j = 0; j < 4; ++j) { xr[rr][j] = LN_LDX((rr * D + 512 * j) * 2); tr[rr][j] = LN_LDT((rr * D + 512 * j) * 2); }
#pragma unroll
    for (int p = 0; p < 4; ++p) {
        float y[2][32]; float s[2] = {0.f, 0.f};
        int ll = lane; asm volatile("" : "+v"(ll));
#pragma unroll
        for (int j = 0; j < 4; ++j) { float g[8]; LNV(0, LNV_G1, j, ll, g);
#pragma unroll
            for (int rr = 0; rr < 2; ++rr) { float xf[8], tf[8]; unpack8(xr[rr][j], xf); unpack8(tr[rr][j], tf);
#pragma unroll
                for (int e = 0; e < 8; ++e) { const float v = xf[e] * ALPHA_RES + g[e] * tf[e]; y[rr][8 * j + e] = v; s[rr] += v; } } }
        __builtin_amdgcn_sched_barrier(0);
        if (p < 3) {
#pragma unroll
            for (int rr = 0; rr < 2; ++rr)
#pragma unroll
                for (int j = 0; j < 4; ++j) { xr[rr][j] = LN_LDX(((2 * (p + 1) + rr) * D + 512 * j) * 2); tr[rr][j] = LN_LDT(((2 * (p + 1) + rr) * D + 512 * j) * 2); }
        }
        __builtin_amdgcn_sched_barrier(0);
#pragma unroll
        for (int o = 1; o < 64; o <<= 1) { s[0] += __shfl_xor(s[0], o); s[1] += __shfl_xor(s[1], o); }
        const float m0 = s[0] * (1.f / D), m1 = s[1] * (1.f / D); float q0 = 0.f, q1 = 0.f;
#pragma unroll
        for (int e = 0; e < 32; ++e) { y[0][e] -= m0; q0 += y[0][e] * y[0][e]; y[1][e] -= m1; q1 += y[1][e] * y[1][e]; }
#pragma unroll
        for (int o = 1; o < 64; o <<= 1) { q0 += __shfl_xor(q0, o); q1 += __shfl_xor(q1, o); }
        const float r[2] = {1.0f / sqrtf(q0 * (1.f / D) + LN_EPS), 1.0f / sqrtf(q1 * (1.f / D) + LN_EPS)};
#pragma unroll
        for (int j = 0; j < 4; ++j) { float lg[8], lb[8], s1[8], sh[8]; LNV(1, LNV_LG, j, ll, lg); LNV(2, LNV_LB, j, ll, lb);
            if constexpr (HOUT) { LNV(3, LNV_S1, j, ll, s1); LNV(4, LNV_SH, j, ll, sh); }
#pragma unroll
            for (int rr = 0; rr < 2; ++rr) { const int off = (2 * p + rr) * D + 512 * j; float xn[8]; const int vrow = vo + (2 * p + rr) * D * 2, vrow4 = 2 * vo + (2 * p + rr) * D * 4; (void)vrow; (void)vrow4;
#pragma unroll
                for (int e = 0; e < 8; ++e) xn[e] = y[rr][8 * j + e] * r[rr] * lg[e] + lb[e];
                if constexpr (YOUT) { __builtin_amdgcn_raw_buffer_store_b128((u32x4){__float_as_uint(xn[0]), __float_as_uint(xn[1]), __float_as_uint(xn[2]), __float_as_uint(xn[3])}, ro, vrow4 + 2048 * j, 0, 0);
                                      __builtin_amdgcn_raw_buffer_store_b128((u32x4){__float_as_uint(xn[4]), __float_as_uint(xn[5]), __float_as_uint(xn[6]), __float_as_uint(xn[7])}, ro, vrow4 + 2048 * j + 16, 0, 0); }
                else LN_STX(pack8(xn), off * 2);
                if constexpr (HOUT) { float h[8];
#pragma unroll
                    for (int e = 0; e < 8; ++e) h[e] = xn[e] * s1[e] + sh[e];
                    LN_STH(pack8(h), off * 2); } } }
    }
#undef LN_LDX
#undef LN_LDT
#undef LN_STX
#undef LN_STH
}
template <int P, bool YOUT, bool HOUT>
__device__ __forceinline__ void ln_sample_coop(LAS unsigned char* lds, const bf16* xin, const float* slab, const float* gate, const float* lng, const float* lnb, bf16* xout, float* yout, const float* sc, const float* sh, bf16* hrow, int tid) {
    const int col = 4 * tid, lane = tid & 63, w = tid >> 6; LAS float* red = (LAS float*)(lds + LNV_RED);
    const u32x2 xw = *(const u32x2*)(xin + col); const f32x4 g = *(const f32x4*)(gate + col);
    f32x4 tv = *(const f32x4*)(slab + col);
#pragma unroll
    for (int pp = 1; pp < P; ++pp) tv += *(const f32x4*)(slab + (size_t)pp * 256 * D + col);
    const f32x4 a = *(const f32x4*)(lng + col), b = *(const f32x4*)(lnb + col);
    f32x4 y = (f32x4){bflo(xw.x), bfhi(xw.x), bflo(xw.y), bfhi(xw.y)} * ALPHA_RES + (1.f + g) * tv;
    const float s = wave_sum((y.x + y.y) + (y.z + y.w));
    if (lane == 0) red[w] = s;
    __syncthreads();
    float m = 0.f;
#pragma unroll
    for (int i = 0; i < 8; ++i) m += red[i];
    y = y - m * (1.f / D);
    const float q = wave_sum((y.x * y.x + y.y * y.y) + (y.z * y.z + y.w * y.w));
    if (lane == 0) red[8 + w] = q;
    __syncthreads();
    float v = 0.f;
#pragma unroll
    for (int i = 0; i < 8; ++i) v += red[8 + i];
    const float rstd = 1.0f / sqrtf(v * (1.f / D) + LN_EPS);
    const f32x4 xn = y * rstd * a + b;
    if constexpr (YOUT) *(f32x4*)(yout + col) = xn; else { u32x2 xo; xo.x = cvtpk(xn.x, xn.y); xo.y = cvtpk(xn.z, xn.w); *(u32x2*)(xout + col) = xo; }
    if constexpr (HOUT) { const f32x4 c = *(const f32x4*)(sc + col), h = *(const f32x4*)(sh + col); const f32x4 o = xn * (1.f + c) + h; u32x2 wv; wv.x = cvtpk(o.x, o.y); wv.y = cvtpk(o.z, o.w); *(u32x2*)(hrow + col) = wv; }
}

constexpr int N_PHASES = 2 + 10 * NL;
#ifndef MK_PHMASK
#define MK_PHMASK 0xFFFFu
#endif
#define EN(k) (((MK_PHMASK) >> (k)) & 1u)
#ifndef MK_REP
#define MK_REP 0u
#endif
#define REP(k) for (int rep_ = 0; rep_ < 1 + (int)(((MK_REP) >> (k)) & 1u); ++rep_)
__global__ void __launch_bounds__(512, 2) mk_fwd(Args args) {
    extern __shared__ __attribute__((aligned(16))) unsigned char lds_raw[];
    LAS unsigned char* lds = (LAS unsigned char*)lds_raw;
    const int tid = threadIdx.x, lane = tid & 63, wave = __builtin_amdgcn_readfirstlane(tid >> 6);
    const int G = gridDim.x, bx = blockIdx.x; const int vcu = (G % 8 == 0) ? (bx % 8) * (G / 8) + bx / 8 : bx;
    const int gw = vcu * 8 + wave, NGW = G * 8;
    for (int u = tid; u < (LDS_BYTES - LDS_CTL) / 4; u += 512) ((LAS unsigned*)(lds + LDS_CTL))[u] = 0u;
    __syncthreads();
#if !MK_MULTI
    XcdBarrier bar = xcd_barrier_post((unsigned*)(args.ws + WS_CTL) + CW_BAR, (volatile LAS unsigned*)(lds + LDS_MISC) + 8);
#define GRID_BAR() do { xcd_barrier(bar, wave); if ((MK_REP >> 19) & 1u) xcd_barrier(bar, wave); } while (0)
#else
#define GRID_BAR() do { } while (0)
#endif
    const int lo = args.ph_lo, hi = args.ph_hi;
#define IN(k) (lo <= (k) && (k) < hi)
#define SEAM(k) do { if (IN(k) && IN((k) + 1)) GRID_BAR(); } while (0)
#define GEMM_PHASE(Ap, Bp, Mv, Nv, Kv, Op, ldcv) do { pg8::Gemm g_{(const bf16*)(Ap), (const bf16*)(Bp), (Mv), (Nv), (Kv), (Kv)}; pg8::StaticOrder S_; S_.init((Mv), (Nv), G, bx); \
        pg8::EpiStoreBf16 E_{(bf16*)(Op), (ldcv)}; pg8::gemm_phase<pg8::EpiStoreBf16, pg8::StaticOrder, true, true>(lds, g_, S_, E_, wave); } while (0)
#define FRESH() const int lane_p = fresh_lane(); const int tid_p = wave * 64 + lane_p; (void)lane_p
#define GEMM_RESID(Ap, Bp, Kv, gatep) do { pg8::Gemm g_{(const bf16*)(Ap), (const bf16*)(Bp), MP, D, (Kv), (Kv)}; pg8::StaticOrder S_; S_.init(MP, D, G, bx); \
        pg8::EpiResid E_{(bf16*)(ws + WS_X), D, (gatep), NMOD, ALPHA_RES}; pg8::gemm_phase<pg8::EpiResid, pg8::StaticOrder, true, true>(lds, g_, S_, E_, wave); } while (0)
#define GEMM_SPLIT(Ap, Bp, Nv, Klen, ldv, Pv) for (int rs_ = 0; rs_ < 1 + (int)((MK_REP >> 18) & 1u); ++rs_) { pg8::Gemm g_{(const bf16*)(Ap), (const bf16*)(Bp), 256, (Nv), (Klen), (ldv)}; pg8::SplitOrder S_; S_.init((Pv), (Nv), G, bx); \
        pg8::EpiSlabF32 E_{(float*)(ws + WS_SLAB), (Nv)}; pg8::gemm_phase<pg8::EpiSlabF32, pg8::SplitOrder, true, true, true>(lds, g_, S_, E_, wave); }
    unsigned char* ws = args.ws;
    const float* MOD = (const float*)(ws + WS_MOD);
    float* Y = args.out + O_Y; bf16* X = (bf16*)(ws + WS_X);

    if (EN(0) && IN(0)) REP(0) p0a_prologue(args, lds, tid, lane, wave, vcu, G);
    SEAM(0);
    if (EN(1) && IN(1)) p0b_h0(args, lane, gw, NGW);
    SEAM(1);
    for (int l = 0; l < NL; ++l) {
        const int pb = 2 + 10 * l;
        unsigned char* wl = ws + WS_W + (size_t)l * W_LAYER;
        if (EN(2) && IN(pb)) { { { pg8::Gemm g_{(const bf16*)(ws + WS_H), (const bf16*)(wl + WO_IN), MP, NINP, D, D}; pg8::StaticOrder S_; S_.init(MP, NINP, G, bx);
              pg8::EpiProj E_{(bf16*)(ws + WS_PROJ), NINP, (bf16*)(ws + WS_QA), (bf16*)(ws + WS_QI), (bf16*)(ws + WS_QC), (bf16*)(ws + WS_KA), (bf16*)(ws + WS_KI), (bf16*)(ws + WS_KR), (float*)(ws + WS_WI),
                                 (const float*)(ws + WS_ROPE), QS_A, QS_C, WI_SCALE,
                                 args.out + O_PAK + (size_t)l * MP * 512, args.out + O_PAV + (size_t)l * MP * 512, args.out + O_PIK + (size_t)l * MP * 64, args.out + O_PKR + (size_t)l * MP * 64};
              pg8::gemm_phase<pg8::EpiProj, pg8::StaticOrder, true, true>(lds, g_, S_, E_, wave); }
            GEMM_SPLIT(ws + WS_H + (size_t)MP * D * 2, wl + WO_IN, NINP, D / SP_A, D, SP_A); }
            { FRESH(); unsigned* tk = (unsigned*)(ws + WS_CTL) + CW_TICKET + 64 * l;
              for (;;) { unsigned j = 0u; if (lane_p == 0) j = __hip_atomic_fetch_add(tk, 1u, __ATOMIC_RELAXED, __HIP_MEMORY_SCOPE_AGENT); j = (unsigned)__builtin_amdgcn_readfirstlane((int)j);
                  if (j >= 4096u) break;
                  if (j < 2048u) { for (int i = 0; i < 8; ++i) pb_cache_row(args, l, (int)j * 8 + i, lane_p); } else pb_vat_cache(args, l, (int)j - 2048, lane_p); } } }
        SEAM(pb);
        if (EN(3) && IN(pb + 1)) REP(3) { FRESH();
            for (int blk = vcu; blk < MP / 64; blk += G) pb_prompt_rows8(args, l, blk * 64 + 8 * wave, lane_p);
            for (int i = gw; i < MS * 9; i += NGW) pb_token_row(args, l, MP + i / 9, lane_p, 1u << (i % 9));
            for (int jv = gw; jv < (MP / 64) * 8; jv += NGW) pb_vat_prompt(args, jv, lane_p);
            for (int jv = gw; jv < NBS * 8; jv += NGW) pb_vat_new(args, jv, lane_p);
        }
        SEAM(pb + 1);
        if (IN(pb + 2)) {
            if (EN(4)) REP(4) { GEMM_PHASE(ws + WS_LAT, wl + WO_UK, KROWS, 1024, 512, ws + WS_KN, 1024);
            { pg8::Gemm g_{(const bf16*)(wl + WO_UV), (const bf16*)(ws + WS_LAT), 1024, KROWS, 512, 512}; pg8::StaticOrder S_; S_.init(1024, KROWS, G, (bx + G / 2) % G);
              pg8::EpiStoreBf16 E_{(bf16*)(ws + WS_VCT), KROWS}; pg8::gemm_phase<pg8::EpiStoreBf16, pg8::StaticOrder, true, true>(lds, g_, S_, E_, wave); } }
            if (EN(5)) REP(5) { FRESH();
            for (int i = vcu; i < 2048 + 256; i += G) { int q0;
                if (i < 2048) { const int b = i >> 9, r = i & 511, j = (r < 256) ? r : 767 - r; q0 = b * SEQ + 8 * j; }
                else { if ((i - 2048) & 7) continue; q0 = MP + 8 * ((i - 2048) >> 3); }
                pd_group256(args, lds, q0, tid_p); } }
        }
        SEAM(pb + 2);
        if (IN(pb + 3)) { FRESH();
            const bf16* QC = (const bf16*)(ws + WS_QC); const bf16* KN = (const bf16*)(ws + WS_KN); const bf16* KR = (const bf16*)(ws + WS_KR); const bf16* VCT = (const bf16*)(ws + WS_VCT);
            const bf16* QA = (const bf16*)(ws + WS_QA); const bf16* KA = (const bf16*)(ws + WS_KA); const bf16* VAT = (const bf16*)(ws + WS_VAT);
            const unsigned long long* SEL = (const unsigned long long*)(ws + WS_SEL); bf16* MIX = (bf16*)(ws + WS_MIX);
            if (EN(6)) REP(6) { FRESH(); for (int u = vcu; u < 256; u += G) { const int bh = u >> 3, s = u & 7, b = bh >> 3, h = bh & 7;
                for (int k = 0; k < 2; ++k) { const int qb = k ? 15 - s : s; const size_t row0 = (size_t)b * SEQ + 256 * qb;
                    attn_unit<192, 128, 128, false>(lds, QC + row0 * 1536 + h * 192, 1536, KN + (size_t)b * SEQ * 1024 + h * 128, 1024, KR + (size_t)b * SEQ * 64, 64,
                                                    VCT + (size_t)(h * 128) * KROWS + (size_t)b * SEQ, KROWS, nullptr, MIX + row0 * D + 1024 + h * 128, D, qb, tid_p); } } }
            if (EN(7)) REP(7) { FRESH(); for (int u = vcu; u < 256; u += G) { const int bh = u >> 3, s = u & 7, b = bh >> 3, h = bh & 7;
                for (int k = 0; k < 2; ++k) { const int qb = k ? 15 - s : s; const size_t row0 = (size_t)b * SEQ + 256 * qb;
                    attn_unit_deep<64, 64, 64, true>(lds, QA + row0 * 512 + h * 64, 512, KA + (size_t)b * SEQ * 512 + h * 64, 512, nullptr, 0,
                                                VAT + (size_t)(h * 64) * KROWS + (size_t)b * SEQ, KROWS, SEL + row0 * 64, MIX + row0 * D + h * 64, D, qb, tid_p); } } }
            if (EN(8)) REP(8) { FRESH(); for (int u = vcu; u < 2 * NBS * 8; u += G) { const int b = (u >> 3) & 15, h = u & 7; const size_t r0 = (size_t)MP + b * TS, kr0 = (size_t)MP + (size_t)b * SKEYS;
                if (u < NBS * 8) sattn_block<192, 128, 128, false>(lds, QC + r0 * 1536 + h * 192, 1536, KN + kr0 * 1024 + h * 128, 1024, KR + kr0 * 64, 64, VCT + (size_t)(h * 128) * KROWS + kr0, KROWS, nullptr, MIX + r0 * D + 1024 + h * 128, D, tid_p);
                else sattn_block<64, 64, 64, true>(lds, QA + r0 * 512 + h * 64, 512, KA + kr0 * 512 + h * 64, 512, nullptr, 0, VAT + (size_t)(h * 64) * KROWS + kr0, KROWS, SEL + r0 * 64, MIX + r0 * D + h * 64, D, tid_p); } }
        }
        SEAM(pb + 3);
        if (EN(9) && IN(pb + 4)) REP(9) { GEMM_PHASE(ws + WS_MIX, wl + WO_OUT, MP, D, D, ws + WS_T, D); GEMM_SPLIT(ws + WS_MIX + (size_t)MP * D * 2, wl + WO_OUT, D, D / SP_F, D, SP_F); }
        SEAM(pb + 4);
        if (EN(10) && IN(pb + 5)) REP(10) { FRESH();
            const bool dry = ((MK_REP >> 10) & 1u) && rep_ == 0;
            const bf16* Tb = (const bf16*)(ws + WS_T); bf16* Hb = dry ? (bf16*)(ws + WS_PROJ + 70 * MiB) : (bf16*)(ws + WS_H); bf16* Xo = dry ? (bf16*)(ws + WS_PROJ) : X;
            const float* lng = args.in[19] + (size_t)l * D; const float* lnb = args.in[20] + (size_t)l * D;
            for (int rs = vcu; rs < MS; rs += G) { const int r = MP + rs; const float* mod = MOD + ((size_t)l * NCOND + cond_idx(r)) * NMOD;
                if (rs != vcu) __syncthreads();
                ln_sample_coop<SP_F, false, true>(lds, X + (size_t)r * D, (const float*)(ws + WS_SLAB) + (size_t)rs * D, mod + 2 * D, lng, lnb, Xo + (size_t)r * D, nullptr, mod + 4 * D, mod + 3 * D, Hb + (size_t)r * D, tid_p); }
            for (int blk = vcu; blk < MP / 64; blk += G) { const int r0 = blk * 64; const float* mod = MOD + ((size_t)l * NCOND + cond_idx(r0)) * NMOD;
                __syncthreads(); ln_stage_vectors<true>(lds, mod + 2 * D, lng, lnb, mod + 4 * D, mod + 3 * D, tid_p); __syncthreads();
                ln_rows8<false, true>(lds, X, Tb, Xo, nullptr, Hb, (size_t)r0 + 8 * wave, lane_p); }
        }
        SEAM(pb + 5);
        if (EN(11) && IN(pb + 6)) REP(11) {
            { pg8::Gemm g_{(const bf16*)(ws + WS_H), (const bf16*)(wl + WO_GU), MP, NGU, D, D}; pg8::StaticOrder S_; S_.init(MP, NGU, G, bx);
              pg8::EpiAct E_{(bf16*)(ws + WS_ACT), DFF, (float*)(ws + WS_GH), (float*)(ws + WS_G01), args.in[24] + (size_t)l * 3 * DFF, (PG8_LAS float*)(lds + LDS_HALO)};
              pg8::gemm_phase<pg8::EpiAct, pg8::StaticOrder, true, true>(lds, g_, S_, E_, wave); }
            GEMM_SPLIT(ws + WS_H + (size_t)MP * D * 2, wl + WO_GU, NGU, D / SP_H, D, SP_H); }
        SEAM(pb + 6);
        if (EN(12) && IN(pb + 7)) REP(12) { FRESH(); for (int it = gw; it < (MP / 256) * 11; it += NGW) pi_fix(args, l, it, lane_p); for (int i = NGW - 1 - gw; i < MS * 11; i += NGW) pi_row(args, l, MP + i / 11, lane_p, i % 11, i % 11 + 1); }
        SEAM(pb + 7);
        if (EN(13) && IN(pb + 8)) REP(13) { GEMM_PHASE(ws + WS_ACT, wl + WO_DN, MP, D, DFF, ws + WS_T, D); GEMM_SPLIT(ws + WS_ACT + (size_t)MP * DFF * 2, wl + WO_DN, D, DFF / SP_J, DFF, SP_J); }
        SEAM(pb + 8);
        if (EN(14) && IN(pb + 9)) { FRESH();
            const bf16* Tb = (const bf16*)(ws + WS_T); bf16* Hb = (bf16*)(ws + WS_H); const bool more = l + 1 < NL;
            const float* lng = args.in[21] + (size_t)l * D; const float* lnb = args.in[22] + (size_t)l * D;
            for (int rs = vcu; rs < MS; rs += G) { const int r = MP + rs, m = cond_idx(r); const float* mod = MOD + ((size_t)l * NCOND + m) * NMOD; const float* modn = MOD + ((size_t)(more ? l + 1 : l) * NCOND + m) * NMOD;
                if (rs != vcu) __syncthreads();
                const float* sl = (const float*)(ws + WS_SLAB) + (size_t)rs * D;
                if (more) ln_sample_coop<SP_J, false, true>(lds, X + (size_t)r * D, sl, mod + 5 * D, lng, lnb, X + (size_t)r * D, nullptr, modn + D, modn, Hb + (size_t)r * D, tid_p);
                else ln_sample_coop<SP_J, true, false>(lds, X + (size_t)r * D, sl, mod + 5 * D, lng, lnb, nullptr, Y + (size_t)r * D, nullptr, nullptr, nullptr, tid_p); }
            for (int blk = vcu; blk < MP / 64; blk += G) { const int r0 = blk * 64, m = cond_idx(r0); const float* mod = MOD + ((size_t)l * NCOND + m) * NMOD; const float* modn = MOD + ((size_t)(more ? l + 1 : l) * NCOND + m) * NMOD;
                __syncthreads();
                if (more) { ln_stage_vectors<true>(lds, mod + 5 * D, lng, lnb, modn + D, modn, tid_p); __syncthreads(); ln_rows8<false, true>(lds, X, Tb, X, nullptr, Hb, (size_t)r0 + 8 * wave, lane_p); }
                else { ln_stage_vectors<false>(lds, mod + 5 * D, lng, lnb, nullptr, nullptr, tid_p); __syncthreads(); ln_rows8<true, false>(lds, X, Tb, nullptr, Y, nullptr, (size_t)r0 + 8 * wave, lane_p); } }
        }
        SEAM(pb + 9);
    }
#undef IN
#undef SEAM
#undef GEMM_PHASE
#undef GEMM_SPLIT
#undef GRID_BAR
}

extern "C" void kernel_launch(void* const* d_in, const int* in_sizes, int n_in, void* d_out, int out_size, void* d_ws, size_t ws_size, hipStream_t stream) {
    static int grid = 0;
    if (grid == 0) {
        if (n_in != 26 || (size_t)out_size != O_END || ws_size < WS_END || in_sizes[0] != MP * D || in_sizes[11] != NL * D * NIN) {
            fprintf(stderr, "kernel_launch: unexpected shapes (n_in %d, out %d, ws %zu); nothing launched\n", n_in, out_size, ws_size); grid = -1; return; }
        int dev = 0, cus = 0, per_cu = 0;
        if (hipGetDevice(&dev) != hipSuccess || hipDeviceGetAttribute(&cus, hipDeviceAttributeMultiprocessorCount, dev) != hipSuccess) { grid = -1; return; }
        if (hipFuncSetAttribute((const void*)mk_fwd, hipFuncAttributeMaxDynamicSharedMemorySize, LDS_BYTES) != hipSuccess) { fprintf(stderr, "kernel_launch: hipFuncSetAttribute failed\n"); grid = -1; return; }
        if (hipOccupancyMaxActiveBlocksPerMultiprocessor(&per_cu, (const void*)mk_fwd, 512, LDS_BYTES) != hipSuccess || per_cu < 1) fprintf(stderr, "kernel_launch: occupancy query reports %d\n", per_cu);
        (void)hipGetLastError();
        grid = cus;
    }
    if (grid < 0) return;
    if (hipMemsetAsync((char*)d_ws + WS_CTL, 0, CTL_ZERO_BYTES, stream) != hipSuccess) { fprintf(stderr, "kernel_launch: memset failed\n"); return; }
    Args a{};
    for (int i = 0; i < 26; ++i) a.in[i] = (const float*)d_in[i];
    a.out = (float*)d_out; a.ws = (unsigned char*)d_ws;
#if !MK_MULTI
    a.ph_lo = 0; a.ph_hi = N_PHASES;
    hipLaunchKernelGGL(mk_fwd, dim3(grid), dim3(512), LDS_BYTES, stream, a);
#else
    for (int p = 0; p < N_PHASES; ++p) { a.ph_lo = p; a.ph_hi = p + 1; hipLaunchKernelGGL(mk_fwd, dim3(grid), dim3(512), LDS_BYTES, stream, a); }
#endif
    const hipError_t le = hipPeekAtLastError();
    if (le != hipSuccess) fprintf(stderr, "kernel_launch: launch failed: %s\n", hipGetErrorName(le));
}
```

```cpp
#include <hip/hip_runtime.h>
#include <cstdio>
#include <cstdint>

#ifndef MK_MULTI
#define MK_MULTI 0
#endif

__device__ __forceinline__ int pg8_fresh_lane() { int l; asm volatile("v_mbcnt_lo_u32_b32 %0, -1, 0\n\tv_mbcnt_hi_u32_b32 %0, -1, %0" : "=v"(l)); return l; }
namespace pg8 {
#define PG8_LAS __attribute__((address_space(3)))
typedef unsigned short bf16_t;
typedef short bf16x8 __attribute__((ext_vector_type(8)));
typedef float f32x4 __attribute__((ext_vector_type(4)));
typedef unsigned u32x4 __attribute__((ext_vector_type(4)));
constexpr int BM = 256, BK = 64, HALF = 128, HTB = HALF * BK * 2  , STAGE_BYTES = 8 * HTB, NXCD = 8, WGM = 8;

__host__ __device__ __forceinline__ int lds_byte(int r, int c) { const int st = (r >> 4) * 2 + (c >> 5), rr = r & 15, cc = c & 31, ob = rr * 64 + cc * 2; return st * 1024 + (ob ^ (((ob >> 9) & 1) << 5)); }
__host__ __device__ __forceinline__ void stage_rc(int b, int& R, int& C) { const int st = b / 1024, sb = b % 1024, swz = sb ^ (((sb >> 9) & 1) << 5); R = (st >> 1) * 16 + swz / 64; C = (st & 1) * 32 + (swz % 64) / 2; }
__host__ __device__ __forceinline__ int perm32(int rho) { const int n = rho >> 4, i = rho & 15; return 8 * (i >> 2) + 4 * n + (i & 3); }

struct Unit { int pm, pn; };
struct Gemm { const bf16_t* A; const bf16_t* Bt; int M, N, K, ld; };

struct StaticOrder {
    int nM, nN, nwg, G, c;
    __host__ __device__ void init(int M, int N, int G_, int c_) { nM = M / BM; nN = N / BM; nwg = nM * nN; G = G_; c = c_; }
    __host__ __device__ bool next(int i, Unit& u) const {
        const long L = (long)i * G + c; if (L >= nwg) return false;
        int wgid = (int)L; { const int q = nwg / NXCD, r = nwg % NXCD, xcd = wgid % NXCD, off = wgid / NXCD; wgid = (xcd < r ? xcd * (q + 1) : r * (q + 1) + (xcd - r) * q) + off; }
        const int nig = WGM * nN, gid = wgid / nig, fm = gid * WGM, gsz = (nM - fm) < WGM ? (nM - fm) : WGM;
        u.pm = fm + ((wgid % nig) % gsz); u.pn = (wgid % nig) / gsz; return true;
    }
    __device__ __forceinline__ void a_ready(const Unit&) const {}
    __device__ __forceinline__ void done(const Unit&) const {}
};

__device__ __forceinline__ unsigned cvt_pk_bf16(float lo, float hi) { unsigned r; asm volatile("v_cvt_pk_bf16_f32 %0, %1, %2" : "=v"(r) : "v"(lo), "v"(hi)); return r; }

struct EpiStoreBf16 {
    static constexpr bool PERM = true, AFTER_DRAIN = false;
    bf16_t* O; int ldc;
    __device__ __forceinline__ void operator()(const f32x4 (&acc)[2][2][4][2], const Unit& u, int wr, int wc, int fr, int fq) const {
        const int row0 = u.pm * BM + wr * 64 + fr; const int col0 = u.pn * BM + wc * 32 + 8 * fq;
#pragma unroll
        for (int ai = 0; ai < 2; ++ai)
#pragma unroll
            for (int m = 0; m < 4; ++m) { bf16_t* rowp = O + (size_t)(row0 + ai * HALF + m * 16) * ldc + col0;
#pragma unroll
                for (int bj = 0; bj < 2; ++bj) { const f32x4 v0 = acc[ai][bj][m][0], v1 = acc[ai][bj][m][1];
                    u32x4 w; w.x = cvt_pk_bf16(v0[0], v0[1]); w.y = cvt_pk_bf16(v0[2], v0[3]); w.z = cvt_pk_bf16(v1[0], v1[1]); w.w = cvt_pk_bf16(v1[2], v1[3]);
                    *(u32x4*)(rowp + bj * HALF) = w; } }
    }
};
struct SplitOrder {
    int P, nwg, G, c;
    __host__ __device__ void init(int P_, int N, int G_, int c_) { P = P_; nwg = P_ * (N / BM); G = G_; c = c_; }
    __host__ __device__ bool next(int i, Unit& u) const { const long L = (long)i * G + c; if (L >= nwg) return false; u.pm = (int)(L % P); u.pn = (int)(L / P); return true; }
    __device__ __forceinline__ void a_ready(const Unit&) const {}
    __device__ __forceinline__ void done(const Unit&) const {}
};
struct EpiSlabF32 {
    static constexpr bool PERM = false, AFTER_DRAIN = false;
    float* S; int N;
    __device__ __forceinline__ void operator()(const f32x4 (&acc)[2][2][4][2], const Unit& u, int wr, int wc, int fr, int fq) const {
        const int row0 = wr * 64 + fr, col0 = u.pn * BM + wc * 32 + 4 * fq;
#pragma unroll
        for (int ai = 0; ai < 2; ++ai)
#pragma unroll
            for (int m = 0; m < 4; ++m) { float* rowp = S + ((size_t)u.pm * BM + row0 + ai * HALF + m * 16) * N + col0;
#pragma unroll
                for (int bj = 0; bj < 2; ++bj)
#pragma unroll
                    for (int n = 0; n < 2; ++n) *(f32x4*)(rowp + bj * HALF + n * 16) = acc[ai][bj][m][n]; }
    }
};

struct EpiAct {
    static constexpr bool PERM = true, AFTER_DRAIN = false;
    bf16_t* ACT; int dff;
    float* GH;
    float* G01;
    const float* cw;
    PG8_LAS float* halo;
    __device__ __forceinline__ void operator()(const f32x4 (&acc)[2][2][4][2], const Unit& u, int wr, int wc, int fr, int fq) const {
        const int chl = wc * 32 + 8 * fq, ch = u.pn * 128 + chl;
#pragma unroll
        for (int ai = 0; ai < 2; ++ai) if (fr >= 14) {
#pragma unroll
            for (int n = 0; n < 2; ++n) { *(PG8_LAS f32x4*)(halo + ((2 * ai + wr) * 2 + (fr - 14)) * 128 + chl + 4 * n) = acc[ai][0][3][n];
                if (ai == 1 && wr == 1) *(f32x4*)(GH + ((u.pm * 2 + (fr - 14)) * dff + ch + 4 * n)) = acc[ai][0][3][n]; } }
        asm volatile("s_waitcnt lgkmcnt(0)" ::: "memory"); __builtin_amdgcn_s_barrier(); asm volatile("" ::: "memory");
#pragma unroll
        for (int n = 0; n < 2; ++n) {
            const f32x4 w0 = *(const f32x4*)(cw + ch + 4 * n), w1 = *(const f32x4*)(cw + dff + ch + 4 * n), w2 = *(const f32x4*)(cw + 2 * dff + ch + 4 * n);
#pragma unroll
            for (int ai = 0; ai < 2; ++ai) {
                const int grp = 2 * ai + wr;
                f32x4 h14 = (f32x4){0.f, 0.f, 0.f, 0.f}, h15 = h14;
                if (grp > 0) { h14 = *(const PG8_LAS f32x4*)(halo + ((grp - 1) * 2 + 0) * 128 + chl + 4 * n); h15 = *(const PG8_LAS f32x4*)(halo + ((grp - 1) * 2 + 1) * 128 + chl + 4 * n); }
#pragma unroll
                for (int m = 0; m < 4; ++m) {
                    const f32x4 cur = acc[ai][0][m][n], upv = acc[ai][1][m][n]; f32x4 z;
#pragma unroll
                    for (int j = 0; j < 4; ++j) {
                        float t1, t2;
                        if (m > 0) { const int pv = __float_as_int(acc[ai][0][m - 1][n][j]);
                            t1 = __int_as_float(__builtin_amdgcn_update_dpp(pv, pv, 0x121, 0xf, 0xf, false)); t2 = __int_as_float(__builtin_amdgcn_update_dpp(pv, pv, 0x122, 0xf, 0xf, false)); }
                        else { t1 = h15[j]; t2 = (fr == 0) ? h14[j] : h15[j]; }
                        const int cv = __float_as_int(cur[j]);
                        const float g1 = __int_as_float(__builtin_amdgcn_update_dpp(__float_as_int(t1), cv, 0x111, 0xf, 0xf, false));
                        const float g2 = __int_as_float(__builtin_amdgcn_update_dpp(__float_as_int(t2), cv, 0x112, 0xf, 0xf, false));
                        const float gc = g2 * w0[j] + g1 * w1[j] + cur[j] * w2[j];
                        z[j] = gc * __builtin_amdgcn_rcpf(1.f + __expf(-gc)) * upv[j];
                    }
                    const int row = u.pm * BM + ai * HALF + wr * 64 + m * 16 + fr;
                    if (grp == 0 && m == 0 && fr < 2) {
                        *(f32x4*)(G01 + (((u.pm * 2 + fr) * 2 + 0) * dff + ch + 4 * n)) = cur;
                        *(f32x4*)(G01 + (((u.pm * 2 + fr) * 2 + 1) * dff + ch + 4 * n)) = upv;
                    } else {
                        unsigned w[2]; w[0] = cvt_pk_bf16(z[0], z[1]); w[1] = cvt_pk_bf16(z[2], z[3]);
                        *(unsigned long long*)(ACT + (size_t)row * dff + ch + 4 * n) = (unsigned long long)w[0] | ((unsigned long long)w[1] << 32);
                    }
                }
            }
        }
    }
};

struct EpiResid {
    static constexpr bool PERM = true, AFTER_DRAIN = false;
    bf16_t* X; int ldc; const float* gate_base; int gate_stride; float alpha;
    __device__ __forceinline__ void operator()(const f32x4 (&acc)[2][2][4][2], const Unit& u, int wr, int wc, int fr, int fq) const {
        const int row0 = u.pm * BM + wr * 64 + fr, col0 = u.pn * BM + wc * 32 + 8 * fq;
        const float* gp = gate_base + (size_t)(u.pm >> 4) * gate_stride + col0;
        f32x4 gv[2][2];
#pragma unroll
        for (int bj = 0; bj < 2; ++bj)
#pragma unroll
            for (int n = 0; n < 2; ++n) gv[bj][n] = *(const f32x4*)(gp + bj * HALF + 4 * n) + 1.f;
#pragma unroll
        for (int ai = 0; ai < 2; ++ai)
#pragma unroll
            for (int m = 0; m < 4; ++m) { bf16_t* rowp = X + (size_t)(row0 + ai * HALF + m * 16) * ldc + col0;
#pragma unroll
                for (int bj = 0; bj < 2; ++bj) { const u32x4 xw = *(const u32x4*)(rowp + bj * HALF);
                    const f32x4 x0 = (f32x4){__uint_as_float(xw.x << 16), __uint_as_float(xw.x & 0xffff0000u), __uint_as_float(xw.y << 16), __uint_as_float(xw.y & 0xffff0000u)};
                    const f32x4 x1 = (f32x4){__uint_as_float(xw.z << 16), __uint_as_float(xw.z & 0xffff0000u), __uint_as_float(xw.w << 16), __uint_as_float(xw.w & 0xffff0000u)};
                    const f32x4 v0 = x0 * alpha + gv[bj][0] * acc[ai][bj][m][0], v1 = x1 * alpha + gv[bj][1] * acc[ai][bj][m][1];
                    u32x4 w; w.x = cvt_pk_bf16(v0[0], v0[1]); w.y = cvt_pk_bf16(v0[2], v0[3]); w.z = cvt_pk_bf16(v1[0], v1[1]); w.w = cvt_pk_bf16(v1[2], v1[3]);
                    *(u32x4*)(rowp + bj * HALF) = w; } }
    }
};

struct EpiProj {
    static constexpr bool PERM = true, AFTER_DRAIN = false;
    bf16_t* PROJ; int ldp; bf16_t* QA; bf16_t* QI; bf16_t* QC; bf16_t* KA; bf16_t* KI; bf16_t* KR; float* WI; const float* rope; float qs_a, qs_c, wi_scale;
    float* o_ak; float* o_av; float* o_ik; float* o_kr;
    __device__ __forceinline__ void rope4(const f32x4& v0, const f32x4& v1, const f32x4& cs0, const f32x4& cs1, float sc, f32x4& lo, f32x4& hi) const {
        lo[0] = (v0[0] * cs0[0] - v0[1] * cs0[1]) * sc; hi[0] = (v0[0] * cs0[1] + v0[1] * cs0[0]) * sc;
        lo[1] = (v0[2] * cs0[2] - v0[3] * cs0[3]) * sc; hi[1] = (v0[2] * cs0[3] + v0[3] * cs0[2]) * sc;
        lo[2] = (v1[0] * cs1[0] - v1[1] * cs1[1]) * sc; hi[2] = (v1[0] * cs1[1] + v1[1] * cs1[0]) * sc;
        lo[3] = (v1[2] * cs1[2] - v1[3] * cs1[3]) * sc; hi[3] = (v1[2] * cs1[3] + v1[3] * cs1[2]) * sc; }
    static __device__ __forceinline__ void st4bf(bf16_t* p, const f32x4& v) { *(unsigned long long*)p = (unsigned long long)cvt_pk_bf16(v[0], v[1]) | ((unsigned long long)cvt_pk_bf16(v[2], v[3]) << 32); }
    __device__ __forceinline__ void operator()(const f32x4 (&acc)[2][2][4][2], const Unit& u, int wr, int wc, int fr, int fq) const {
        const int row0 = u.pm * BM + wr * 64 + fr, pn = u.pn;
        const int i0 = 16 * (wc & 1) + 4 * fq;
        if (pn >= 14 && pn < 24) {
            const int col0 = pn * BM + wc * 32 + 8 * fq;
#pragma unroll
            for (int ai = 0; ai < 2; ++ai)
#pragma unroll
                for (int m = 0; m < 4; ++m) { const int row = row0 + ai * HALF + m * 16; bf16_t* rowp = PROJ + (size_t)row * ldp + col0;
#pragma unroll
                    for (int bj = 0; bj < 2; ++bj) { const f32x4 v0 = acc[ai][bj][m][0], v1 = acc[ai][bj][m][1];
                        u32x4 w; w.x = cvt_pk_bf16(v0[0], v0[1]); w.y = cvt_pk_bf16(v0[2], v0[3]); w.z = cvt_pk_bf16(v1[0], v1[1]); w.w = cvt_pk_bf16(v1[2], v1[3]);
                        *(u32x4*)(rowp + bj * HALF) = w;
                        if (pn < 16) { float* op = o_av + (size_t)row * 512 + (pn - 14) * BM + bj * HALF + wc * 32 + 8 * fq; __builtin_nontemporal_store(v0, (f32x4*)op); __builtin_nontemporal_store(v1, (f32x4*)(op + 4)); } } }
        } else if (pn >= 6 && pn < 10) {
            const int d0 = wc * 32 + 8 * fq;
#pragma unroll
            for (int ai = 0; ai < 2; ++ai)
#pragma unroll
                for (int m = 0; m < 4; ++m) { bf16_t* rowp = QC + (size_t)(row0 + ai * HALF + m * 16) * 1536 + (2 * (pn - 6)) * 192 + d0;
#pragma unroll
                    for (int bj = 0; bj < 2; ++bj) { const f32x4 v0 = acc[ai][bj][m][0] * qs_c, v1 = acc[ai][bj][m][1] * qs_c;
                        u32x4 w; w.x = cvt_pk_bf16(v0[0], v0[1]); w.y = cvt_pk_bf16(v0[2], v0[3]); w.z = cvt_pk_bf16(v1[0], v1[1]); w.w = cvt_pk_bf16(v1[2], v1[3]);
                        *(u32x4*)(rowp + bj * 192) = w; } }
        } else if (pn == 24) {
#pragma unroll
            for (int ai = 0; ai < 2; ++ai)
#pragma unroll
                for (int m = 0; m < 4; ++m) { const int row = row0 + ai * HALF + m * 16; const float* cp = rope + ((size_t)(row & 4095) * 32 + i0) * 2;
                    const f32x4 cs0 = *(const f32x4*)cp, cs1 = *(const f32x4*)(cp + 4);
                    { f32x4 lo, hi; rope4(acc[ai][0][m][0], acc[ai][0][m][1], cs0, cs1, 1.f, lo, hi);
                      float* op = ((wc >> 1) ? o_kr : o_ik) + (size_t)row * 64 + i0; __builtin_nontemporal_store(lo, (f32x4*)op); __builtin_nontemporal_store(hi, (f32x4*)(op + 32));
                      bf16_t* kp = ((wc >> 1) ? KR : KI) + (size_t)row * 64 + i0; st4bf(kp, lo); st4bf(kp + 32, hi); }
                    if (wc == 0 && fq < 2) { float* wp = WI + (size_t)row * 16 + 8 * fq; *(f32x4*)wp = acc[ai][1][m][0] * wi_scale; *(f32x4*)(wp + 4) = acc[ai][1][m][1] * wi_scale; } }
        } else {
            bf16_t* dst; int pitch, hbase, hstride, coff; float sc;
            if (pn < 2) { dst = QA; pitch = 512; hbase = 4 * pn; hstride = 64; coff = 0; sc = qs_a; }
            else if (pn < 6) { dst = QI; pitch = 1024; hbase = 4 * (pn - 2); hstride = 64; coff = 0; sc = 1.f; }
            else if (pn < 12) { dst = QC; pitch = 1536; hbase = 4 * (pn - 10); hstride = 192; coff = 128; sc = qs_c; }
            else { dst = KA; pitch = 512; hbase = 4 * (pn - 12); hstride = 64; coff = 0; sc = 1.f; }
#pragma unroll
            for (int ai = 0; ai < 2; ++ai)
#pragma unroll
                for (int m = 0; m < 4; ++m) { const int row = row0 + ai * HALF + m * 16; const float* cp = rope + ((size_t)(row & 4095) * 32 + i0) * 2;
                    const f32x4 cs0 = *(const f32x4*)cp, cs1 = *(const f32x4*)(cp + 4);
#pragma unroll
                    for (int bj = 0; bj < 2; ++bj) { f32x4 lo, hi; rope4(acc[ai][bj][m][0], acc[ai][bj][m][1], cs0, cs1, sc, lo, hi);
                        const int hc = (hbase + 2 * bj + (wc >> 1)) * hstride + coff + i0;
                        bf16_t* hp = dst + (size_t)row * pitch + hc; st4bf(hp, lo); st4bf(hp + 32, hi);
                        if (pn >= 12) { float* op = o_ak + (size_t)row * 512 + hc; __builtin_nontemporal_store(lo, (f32x4*)op); __builtin_nontemporal_store(hi, (f32x4*)(op + 32)); } } }
        }
    }
};

template <class Epi, class Sched, bool ALIGN_EPI = false, bool SP2 = false, bool SPLITK = false>
__device__ __forceinline__ void gemm_phase(PG8_LAS unsigned char* lds, const Gemm g, const Sched& S, const Epi& E, const int wave_s) {
    int tid_ = wave_s * 64 + pg8_fresh_lane();
    const int tid = tid_, wid = __builtin_amdgcn_readfirstlane(tid >> 6), lane = tid & 63, wr = wid >> 2, wc = wid & 3, fr = lane & 15, fq = lane >> 4;
    const int K = g.ld, nt = g.K / BK;
    unsigned voffA[2], voffB[2];
#pragma unroll
    for (int i = 0; i < 2; ++i) { int R, C; stage_rc(tid * 16 + i * 8192, R, C); const int Rb = Epi::PERM ? ((R & ~31) + perm32(R & 31)) : R;
        voffA[i] = (unsigned)(R * K + C) * 2u; voffB[i] = (unsigned)(Rb * K + C) * 2u; }
    const size_t kstep = (size_t)(BK * 2);
    const size_t hstep = (size_t)HALF * K * 2;
    const size_t tstep = 2 * hstep;
    const unsigned ldsw = (unsigned)wid * 1024u;
    const int aoff = lds_byte(wr * 64 + fr, fq * 8), boff = lds_byte(wc * 32 + fr, fq * 8);
#define PG8_SA(b, h) (((b) * 2 + (h)) * HTB)
#define PG8_SB(b, h) ((4 + (b) * 2 + (h)) * HTB)
#define PG8_STAGE(bufoff, gbase, voff) do { _Pragma("unroll") for (int _i = 0; _i < 2; ++_i) \
        __builtin_amdgcn_global_load_lds((const unsigned*)((const char*)(gbase) + (voff)[_i]), (PG8_LAS unsigned*)(lds + (bufoff) + ldsw + _i * 8192), 16, 0, 0); } while (0)
#define PG8_LDA(dst, b, h) do { _Pragma("unroll") for (int m = 0; m < 4; ++m) _Pragma("unroll") for (int k = 0; k < 2; ++k) dst[m][k] = *(const PG8_LAS bf16x8*)(lds + PG8_SA(b, h) + aoff + m * 2048 + k * 1024); } while (0)
#define PG8_LDB(dst, b, h) do { _Pragma("unroll") for (int n = 0; n < 2; ++n) _Pragma("unroll") for (int k = 0; k < 2; ++k) dst[n][k] = *(const PG8_LAS bf16x8*)(lds + PG8_SB(b, h) + boff + n * 2048 + k * 1024); } while (0)
#define PG8_MMA(ai, bj, At, Bt) do { __builtin_amdgcn_s_setprio(1); _Pragma("unroll") for (int m = 0; m < 4; ++m) _Pragma("unroll") for (int n = 0; n < 2; ++n) _Pragma("unroll") for (int k = 0; k < 2; ++k) \
        acc[ai][bj][m][n] = __builtin_amdgcn_mfma_f32_16x16x32_bf16(Bt[n][k], At[m][k], acc[ai][bj][m][n], 0, 0, 0); __builtin_amdgcn_s_setprio(0); } while (0)
#define PG8_WAIT_V(n) asm volatile("s_waitcnt vmcnt(" #n ")" ::: "memory")
#define PG8_WAIT_L(n) asm volatile("s_waitcnt lgkmcnt(" #n ")" ::: "memory")
#define PG8_BAR __builtin_amdgcn_s_barrier()
#define PG8_SCHED __builtin_amdgcn_sched_barrier(0)
    Unit cur, nxt; int ui = 0;
    if (!S.next(0, cur)) return;
    f32x4 acc[2][2][4][2];
#pragma unroll
    for (int a = 0; a < 2; ++a)
#pragma unroll
        for (int b = 0; b < 2; ++b)
#pragma unroll
            for (int m = 0; m < 4; ++m)
#pragma unroll
                for (int n = 0; n < 2; ++n) acc[a][b][m][n] = (f32x4){0.f, 0.f, 0.f, 0.f};
    bf16x8 At[4][2], B0[2][2], B1[2][2];
    const size_t kpart = (size_t)g.K * 2;
    const char* cA = SPLITK ? (const char*)g.A + (size_t)cur.pm * kpart : (const char*)g.A + (size_t)cur.pm * tstep; const char* cB = (const char*)g.Bt + (size_t)cur.pn * tstep + (SPLITK ? (size_t)cur.pm * kpart : (size_t)0);
    S.a_ready(cur);
    if constexpr (SP2) {
        PG8_STAGE(PG8_SB(0, 0), cB, voffB); PG8_STAGE(PG8_SB(0, 1), cB + hstep, voffB); PG8_STAGE(PG8_SA(0, 0), cA, voffA); PG8_STAGE(PG8_SA(0, 1), cA + hstep, voffA);
        if (wr == 1) PG8_BAR;
        PG8_WAIT_V(2); PG8_BAR;
        PG8_STAGE(PG8_SB(1, 0), cB + kstep, voffB); PG8_STAGE(PG8_SA(1, 0), cA + kstep, voffA); PG8_STAGE(PG8_SB(1, 1), cB + hstep + kstep, voffB);
        PG8_WAIT_V(6); PG8_BAR;
    } else {
        PG8_STAGE(PG8_SB(0, 0), cB, voffB); PG8_STAGE(PG8_SA(0, 0), cA, voffA); PG8_STAGE(PG8_SB(0, 1), cB + hstep, voffB); PG8_STAGE(PG8_SA(0, 1), cA + hstep, voffA);
        if (wr == 1) PG8_BAR;
        PG8_WAIT_V(4); PG8_BAR;
        PG8_STAGE(PG8_SB(1, 0), cB + kstep, voffB); PG8_STAGE(PG8_SA(1, 0), cA + kstep, voffA); PG8_STAGE(PG8_SB(1, 1), cB + hstep + kstep, voffB);
        PG8_WAIT_V(6); PG8_BAR;
    }
    for (;;) {
        const bool has_next = S.next(ui + 1, nxt);
        const char* nA = has_next ? (SPLITK ? (const char*)g.A + (size_t)nxt.pm * kpart : (const char*)g.A + (size_t)nxt.pm * tstep) : cA; const char* nB = has_next ? (const char*)g.Bt + (size_t)nxt.pn * tstep + (SPLITK ? (size_t)nxt.pm * kpart : (size_t)0) : cB;
        for (int t = 0; t < nt; t += 2) {
            const bool last = (t == nt - 2);
            const char* a1 = cA + (size_t)(t + 1) * kstep;
            const char* a2 = last ? nA : cA + (size_t)(t + 2) * kstep; const char* b2 = last ? nB : cB + (size_t)(t + 2) * kstep;
            const char* a3 = a2 + kstep; const char* b3 = b2 + kstep;
            if (last && has_next) S.a_ready(nxt);
            if constexpr (SP2) {
            PG8_LDB(B0, 0, 0); PG8_LDB(B1, 0, 1); PG8_SCHED; PG8_LDA(At, 0, 0); PG8_STAGE(PG8_SA(1, 1), a1 + hstep, voffA);
            PG8_WAIT_V(8); PG8_WAIT_L(0); PG8_BAR; PG8_MMA(0, 0, At, B0); PG8_MMA(0, 1, At, B1); PG8_BAR; PG8_SCHED;
            PG8_LDA(At, 0, 1); PG8_STAGE(PG8_SB(0, 0), b2, voffB); PG8_STAGE(PG8_SB(0, 1), b2 + hstep, voffB); PG8_STAGE(PG8_SA(0, 0), a2, voffA);
            PG8_WAIT_V(8); PG8_WAIT_L(0); PG8_BAR; PG8_MMA(1, 0, At, B0); PG8_MMA(1, 1, At, B1); PG8_BAR; PG8_SCHED;
            PG8_LDB(B0, 1, 0); PG8_LDB(B1, 1, 1); PG8_SCHED; PG8_LDA(At, 1, 0); PG8_STAGE(PG8_SA(0, 1), a2 + hstep, voffA);
            PG8_WAIT_V(8); PG8_WAIT_L(0); PG8_BAR; PG8_MMA(0, 0, At, B0); PG8_MMA(0, 1, At, B1); PG8_BAR; PG8_SCHED;
            PG8_LDA(At, 1, 1); PG8_STAGE(PG8_SB(1, 0), b3, voffB); PG8_STAGE(PG8_SB(1, 1), b3 + hstep, voffB); PG8_STAGE(PG8_SA(1, 0), a3, voffA);
            PG8_WAIT_V(8); PG8_WAIT_L(0); PG8_BAR; PG8_MMA(1, 0, At, B0); PG8_MMA(1, 1, At, B1); PG8_BAR; PG8_SCHED;
            } else {
            PG8_LDB(B0, 0, 0); PG8_SCHED; PG8_LDA(At, 0, 0); PG8_STAGE(PG8_SA(1, 1), a1 + hstep, voffA);
            PG8_WAIT_L(8); PG8_BAR; PG8_WAIT_L(0); PG8_MMA(0, 0, At, B0); PG8_BAR; PG8_SCHED;
            PG8_LDB(B1, 0, 1); PG8_STAGE(PG8_SB(0, 0), b2, voffB);
            PG8_BAR; PG8_WAIT_L(0); PG8_MMA(0, 1, At, B1); PG8_BAR;
            PG8_LDA(At, 0, 1); PG8_STAGE(PG8_SA(0, 0), a2, voffA);
            PG8_BAR; PG8_WAIT_L(0); PG8_MMA(1, 0, At, B0); PG8_BAR; PG8_SCHED;
            PG8_STAGE(PG8_SB(0, 1), b2 + hstep, voffB);
            PG8_WAIT_V(6); PG8_BAR; PG8_MMA(1, 1, At, B1); PG8_BAR;
            PG8_LDB(B0, 1, 0); PG8_SCHED; PG8_LDA(At, 1, 0); PG8_STAGE(PG8_SA(0, 1), a2 + hstep, voffA);
            PG8_WAIT_L(8); PG8_BAR; PG8_WAIT_L(0); PG8_MMA(0, 0, At, B0); PG8_BAR; PG8_SCHED;
            PG8_LDB(B1, 1, 1); PG8_STAGE(PG8_SB(1, 0), b3, voffB);
            PG8_BAR; PG8_WAIT_L(0); PG8_MMA(0, 1, At, B1); PG8_BAR;
            PG8_LDA(At, 1, 1); PG8_STAGE(PG8_SA(1, 0), a3, voffA);
            PG8_BAR; PG8_WAIT_L(0); PG8_MMA(1, 0, At, B0); PG8_BAR; PG8_SCHED;
            PG8_STAGE(PG8_SB(1, 1), b3 + hstep, voffB);
            PG8_WAIT_V(6); PG8_BAR; PG8_MMA(1, 1, At, B1); PG8_BAR;
            }
        }
        if constexpr (ALIGN_EPI) { if (wr == 0) PG8_BAR; }
        if constexpr (!Epi::AFTER_DRAIN) { E(acc, cur, wr, wc, fr, fq); S.done(cur); }
        if (!has_next) break;
#pragma unroll
        for (int a = 0; a < 2; ++a)
#pragma unroll
            for (int b = 0; b < 2; ++b)
#pragma unroll
                for (int m = 0; m < 4; ++m)
#pragma unroll
                    for (int n = 0; n < 2; ++n) acc[a][b][m][n] = (f32x4){0.f, 0.f, 0.f, 0.f};
        cur = nxt; cA = nA; cB = nB; ++ui;
        if constexpr (ALIGN_EPI) { if (wr == 1) PG8_BAR; }
    }
    PG8_WAIT_V(0);
    if constexpr (!ALIGN_EPI) { if (wr == 0) PG8_BAR; }
    PG8_BAR;
    if constexpr (Epi::AFTER_DRAIN) { E.fused(acc, cur, wr, wc, fr, fq, lds, wid, lane); S.done(cur); }
#undef PG8_SA
#undef PG8_SB
#undef PG8_STAGE
#undef PG8_LDA
#undef PG8_LDB
#undef PG8_MMA
#undef PG8_WAIT_V
#undef PG8_WAIT_L
#undef PG8_BAR
#undef PG8_SCHED
}
}
#define GAS __attribute__((address_space(1)))
#define LAS __attribute__((address_space(3)))
typedef unsigned short bf16;
typedef unsigned v4u __attribute__((ext_vector_type(4)));
typedef float f32x4 __attribute__((ext_vector_type(4)));
typedef short bf16x8 __attribute__((ext_vector_type(8)));
typedef GAS unsigned gu32;
typedef GAS unsigned long long gu64;
#define RLX_AGENT __ATOMIC_RELAXED, __HIP_MEMORY_SCOPE_AGENT
#define LDS_WAIT() asm volatile("s_waitcnt lgkmcnt(0)" ::: "memory")
#define VM_WAIT() asm volatile("s_waitcnt vmcnt(0)" ::: "memory")
__device__ __forceinline__ unsigned long long rt() { return __builtin_amdgcn_s_memrealtime(); }
__device__ __forceinline__ unsigned f2bf(float f) { unsigned u = __builtin_bit_cast(unsigned, f); return (u + 0x7fffu + ((u >> 16) & 1u)) >> 16; }
__device__ __forceinline__ unsigned pk2(float lo, float hi) { return f2bf(lo) | (f2bf(hi) << 16); }

__device__ __forceinline__ int fresh_lane() { int l; asm volatile("v_mbcnt_lo_u32_b32 %0, -1, 0\n\tv_mbcnt_hi_u32_b32 %0, -1, %0" : "=v"(l)); return l; }
#define XB_TMO      128
#define XB_XCNT(j)  (256  + 64 * (j))
#define XB_XSUB(j)  (1280 + 64 * (j))
#define XB_XGEN(j)  (2304 + 64 * (j))
#define XB_TOP      3328
#define XB_TOPGEN   3392
#define XCD_BAR_WORDS 3456
#define XB_SPIN_CAP (1u << 18)

__device__ __forceinline__ unsigned xb_ld(unsigned* p)              { return __hip_atomic_load(p, __ATOMIC_RELAXED, __HIP_MEMORY_SCOPE_AGENT); }
__device__ __forceinline__ unsigned xb_add(unsigned* p, unsigned v) { return __hip_atomic_fetch_add(p, v, __ATOMIC_RELAXED, __HIP_MEMORY_SCOPE_AGENT); }
__device__ __forceinline__ unsigned xb_xcc_id() { return (unsigned)__builtin_amdgcn_s_getreg((3 << 11) | 20) & 0xFu; }
#define XB_SPIN(cond, bar) do { unsigned _sp = 0; while (cond) { __builtin_amdgcn_s_sleep(1); \
    if ((++_sp & 255u) == 0u) { if (xb_ld(&(bar)[XB_TMO])) break; if (_sp > XB_SPIN_CAP) { atomicAdd(&(bar)[XB_TMO], 1u); break; } } } } while (0)

struct XcdBarrier {
    unsigned* bar; unsigned x;
    volatile LAS unsigned* st;
};

__device__ __forceinline__ XcdBarrier xcd_barrier_post(unsigned* bar, volatile LAS unsigned* st) {
    XcdBarrier b; b.bar = bar; b.x = xb_xcc_id(); b.st = st;
    if (threadIdx.x == 0) (void)xb_add(&bar[XB_XCNT(b.x)], 1u);
    return b;
}
__device__ __forceinline__ void xcd_barrier_complete(unsigned* bar, unsigned x, unsigned& nloc, unsigned& nx) {
    const unsigned G = gridDim.x * gridDim.y * gridDim.z;
    unsigned sum, cnt, mine, sp = 0u;
    for (;;) {
        sum = 0u; cnt = 0u; mine = 0u;
#pragma unroll
        for (unsigned j = 0; j < 16; ++j) { const unsigned c = xb_ld(&bar[XB_XCNT(j)]); sum += c; cnt += (c > 0u) ? 1u : 0u; mine = (j == x) ? c : mine; }
        if (sum == G) break;
        __builtin_amdgcn_s_sleep(1);
        if ((++sp & 255u) == 0u) { if (xb_ld(&bar[XB_TMO])) break; if (sp > XB_SPIN_CAP) { atomicAdd(&bar[XB_TMO], 1u); break; } }
    }
    nloc = mine > 0u ? mine : 1u; nx = cnt > 0u ? cnt : 1u;
}

__device__ __forceinline__ void xcd_barrier(const XcdBarrier& b, const int wave_s) {
    asm volatile("s_waitcnt vmcnt(0)" ::: "memory");
    __syncthreads();
    if (wave_s == 0 && pg8_fresh_lane() == 0) {
        unsigned* bar = b.bar;
        __builtin_amdgcn_s_waitcnt(0);
        unsigned nloc = b.st[0], nx = b.st[1];
        if (nloc == 0u) { xcd_barrier_complete(bar, b.x, nloc, nx); b.st[0] = nloc; b.st[1] = nx; }
        const unsigned old = xb_add(&bar[XB_XSUB(b.x)], 1u);
        const unsigned gen = old / nloc;
        if (old + 1u == (gen + 1u) * nloc) {
            __builtin_amdgcn_fence(__ATOMIC_RELEASE, "agent");
            asm volatile("s_waitcnt vmcnt(0)" ::: "memory");
            const unsigned og = xb_add(&bar[XB_TOP], 1u);
            const unsigned tg = og / nx;
            if (og + 1u == (tg + 1u) * nx) xb_add(&bar[XB_TOPGEN], 1u);
            else XB_SPIN(xb_ld(&bar[XB_TOPGEN]) == tg, bar);
            __builtin_amdgcn_fence(__ATOMIC_ACQUIRE, "agent");
            xb_add(&bar[XB_XGEN(b.x)], 1u);
            asm volatile("s_waitcnt vmcnt(0)" ::: "memory");
        } else {
            XB_SPIN(xb_ld(&bar[XB_XGEN(b.x)]) == gen, bar);
            __builtin_amdgcn_fence(__ATOMIC_ACQUIRE, "agent");
            asm volatile("s_waitcnt vmcnt(0)" ::: "memory");
        }
    }
    __syncthreads();
}

typedef unsigned short bf16;
typedef float f32x2 __attribute__((ext_vector_type(2)));
typedef float f32x4 __attribute__((ext_vector_type(4)));
typedef float f32x16 __attribute__((ext_vector_type(16)));
typedef short bf16x8 __attribute__((ext_vector_type(8)));
typedef unsigned u32x2 __attribute__((ext_vector_type(2)));
typedef unsigned u32x4 __attribute__((ext_vector_type(4)));

constexpr int NL = 4, D = 2048, SEQ = 4096, NBP = 4, MP = 16384, NBS = 16, TS = 16, MS = 256, M = 16640, PAST = 1024, SKEYS = 1040;
constexpr int NIN = 6288, NINP = 6400, DFF = 5632, NGU = 11264, NMOD = 12288, NCOND = 20, KROWS = 33024;
constexpr int C_QA = 0, C_QI = 512, C_QCN = 1536, C_QCR = 2560, C_KA = 3072, C_VA = 3584, C_BG = 4096, C_CG = 4608, C_XB = 5120, C_LAT = 5632, C_KI = 6144, C_KR = 6208, C_WI = 6272;
__host__ __device__ __forceinline__ int win_il(int d) { return d < 32 ? 2 * d : 2 * (d - 32) + 1; }
__host__ __device__ __forceinline__ int win_row(int n) {
    if (n < 512) return (n & ~63) + win_il(n & 63);
    if (n < 1024) { const int i = n - 512; return C_KA + (i & ~63) + win_il(i & 63); }
    if (n < 1536) return C_VA + (n - 1024);
    if (n < 2560) { const int i = n - 1536; return C_QI + (i & ~63) + win_il(i & 63); }
    if (n < 2624) return C_KI + win_il(n - 2560);
    if (n < 2640) return C_WI + (n - 2624);
    if (n < 3152) return C_BG + (n - 2640);
    if (n < 3664) return C_CG + (n - 3152);
    if (n < 4176) return C_XB + (n - 3664);
    if (n < 5712) { const int i = n - 4176, h = i / 192, o = i - h * 192; return o < 128 ? C_QCN + h * 128 + o : C_QCR + h * 64 + win_il(o - 128); }
    if (n < 6224) return C_LAT + (n - 5712);
    if (n < 6288) return C_KR + win_il(n - 6224);
    return n;
}
constexpr float ALPHA_RES = 1.681792830507429f;
constexpr float LN_EPS = 1e-5f, RMS_EPS = 1e-6f;
constexpr float LOG2E = 1.4426950408889634f;
constexpr float QS_A = 0.125f * LOG2E;
constexpr float QS_C = 0.07216878364870322f * LOG2E;
constexpr float WI_SCALE = 0.25f * 0.125f;

constexpr size_t O_Y = 0, O_PAK = 34078720, O_PAV = 67633152, O_PIK = 101187584, O_PLAT = 105381888, O_PKR = 138936320, O_PCB = 143130624, O_PCF = 143147008,
                 O_SAK = 143327232, O_SAV = 143851520, O_SIK = 144375808, O_SLAT = 144441344, O_SKR = 144965632, O_SCB = 145031168, O_SCF = 145096704, O_END = 145817600;

constexpr size_t MiB = 1u << 20;
constexpr size_t WS_CTL = 0, CTL_ZERO_BYTES = 1 * MiB;
constexpr size_t WS_ROPE = 1 * MiB;
constexpr size_t WS_MOD = 2 * MiB;
constexpr size_t WS_WI = 6 * MiB;
constexpr size_t WS_W = 8 * MiB, W_LAYER = 101 * MiB;
constexpr size_t WO_IN = 0, WO_OUT = 25 * MiB, WO_GU = 33 * MiB, WO_DN = 77 * MiB, WO_UK = 99 * MiB, WO_UV = 100 * MiB;
constexpr size_t WS_H = 412 * MiB;
constexpr size_t WS_T = 477 * MiB;
constexpr size_t WS_MIX = 542 * MiB;
constexpr size_t WS_ACT = 607 * MiB;
constexpr size_t WS_PROJ = 786 * MiB;
constexpr size_t WS_QA = 990 * MiB;
constexpr size_t WS_KA = 1007 * MiB;
constexpr size_t WS_VAT = 1040 * MiB;
constexpr size_t WS_QI = 1073 * MiB;
constexpr size_t WS_KI = 1106 * MiB;
constexpr size_t WS_QC = 1111 * MiB;
constexpr size_t WS_LAT = 1160 * MiB;
constexpr size_t WS_KR = 1193 * MiB;
constexpr size_t WS_KN = 1198 * MiB;
constexpr size_t WS_VCT = 1263 * MiB;
constexpr size_t WS_SEL = 1328 * MiB;
constexpr size_t WS_GU = 786 * MiB;
constexpr size_t WS_SLAB = 1337 * MiB;
constexpr size_t WS_X = 1387 * MiB;
constexpr size_t WS_GH = 1452 * MiB;
constexpr size_t WS_G01 = 1455 * MiB;
constexpr size_t WS_END = 1461 * MiB;
static_assert(WS_GH + (size_t)64 * 2 * DFF * 4 <= WS_G01 && WS_G01 + (size_t)64 * 4 * DFF * 4 <= WS_END, "ws map 6");
constexpr int LDS_HALO = 131072;
constexpr int SP_A = 4, SP_F = 4, SP_H = 4, SP_J = 11;
static_assert(WS_GU + (size_t)M * NGU * 2 <= WS_LAT, "GU overlay must stay clear of buffers that are live later");
static_assert(WS_PROJ + (size_t)M * NINP * 2 <= WS_QA && WS_KA + (size_t)KROWS * 512 * 2 <= WS_VAT && WS_VAT + (size_t)KROWS * 512 * 2 <= WS_QI && WS_QI + (size_t)M * 1024 * 2 <= WS_KI, "ws map 1");
static_assert(WS_KI + (size_t)KROWS * 64 * 2 <= WS_QC && WS_QC + (size_t)M * 1536 * 2 <= WS_LAT && WS_LAT + (size_t)KROWS * 512 * 2 <= WS_KR && WS_KR + (size_t)KROWS * 64 * 2 <= WS_KN, "ws map 2");
static_assert(WS_KN + (size_t)KROWS * 1024 * 2 <= WS_VCT && WS_VCT + (size_t)KROWS * 1024 * 2 <= WS_SEL && WS_SEL + (size_t)M * 512 <= WS_END, "ws map 3");
static_assert(WS_ACT + (size_t)M * DFF * 2 <= WS_PROJ && WS_MIX + (size_t)M * D * 2 <= WS_ACT && WS_T + (size_t)M * D * 2 <= WS_MIX && WS_H + (size_t)M * D * 2 <= WS_T && WS_W + 4 * W_LAYER <= WS_H, "ws map 4");
static_assert(WS_QA + (size_t)M * 512 * 2 <= WS_KA && WS_WI + (size_t)M * 16 * 4 <= WS_W && WS_MOD + (size_t)NL * NCOND * NMOD * 4 <= WS_WI, "ws map 5");

constexpr int CW_TICKET = 1024;
constexpr int CW_BAR = 4096;
constexpr int LDS_RING = 131072, LDS_CTL = 155648, LDS_MISC = LDS_CTL + 320, LDS_BYTES = 163840;

#ifndef MK_REP
#define MK_REP 0u
#endif
__device__ __forceinline__ float bflo(unsigned w) { return __uint_as_float(w << 16); }
__device__ __forceinline__ float bfhi(unsigned w) { return __uint_as_float(w & 0xffff0000u); }
typedef __bf16 bf16x2_t __attribute__((ext_vector_type(2)));
__device__ __forceinline__ unsigned cvtpk(float lo, float hi) { const f32x2 v = {lo, hi}; const bf16x2_t b = __builtin_convertvector(v, bf16x2_t); return __builtin_bit_cast(unsigned, b); }
__device__ __forceinline__ void unpack8(const u32x4 w, float (&f)[8]) { f[0] = bflo(w.x); f[1] = bfhi(w.x); f[2] = bflo(w.y); f[3] = bfhi(w.y); f[4] = bflo(w.z); f[5] = bfhi(w.z); f[6] = bflo(w.w); f[7] = bfhi(w.w); }
__device__ __forceinline__ u32x4 pack8(const float (&f)[8]) { u32x4 w; w.x = cvtpk(f[0], f[1]); w.y = cvtpk(f[2], f[3]); w.z = cvtpk(f[4], f[5]); w.w = cvtpk(f[6], f[7]); return w; }
__device__ __forceinline__ u32x4 ld16(const void* p) { return *(const u32x4*)p; }
__device__ __forceinline__ void st16(void* p, u32x4 v) { *(u32x4*)p = v; }
__device__ __forceinline__ void ld8f(const float* p, float (&f)[8]) { const f32x4 a = *(const f32x4*)p, b = *(const f32x4*)(p + 4); f[0] = a.x; f[1] = a.y; f[2] = a.z; f[3] = a.w; f[4] = b.x; f[5] = b.y; f[6] = b.z; f[7] = b.w; }
__device__ __forceinline__ void st8f(float* p, const float (&f)[8]) { *(f32x4*)p = (f32x4){f[0], f[1], f[2], f[3]}; *(f32x4*)(p + 4) = (f32x4){f[4], f[5], f[6], f[7]}; }
__device__ __forceinline__ void st8f_nt(float* p, const float (&f)[8]) { __builtin_nontemporal_store((f32x4){f[0], f[1], f[2], f[3]}, (f32x4*)p); __builtin_nontemporal_store((f32x4){f[4], f[5], f[6], f[7]}, (f32x4*)(p + 4)); }
__device__ __forceinline__ void ld8f_nt(const float* p, float (&f)[8]) { const f32x4 a = __builtin_nontemporal_load((const f32x4*)p), b = __builtin_nontemporal_load((const f32x4*)(p + 4)); f[0] = a.x; f[1] = a.y; f[2] = a.z; f[3] = a.w; f[4] = b.x; f[5] = b.y; f[6] = b.z; f[7] = b.w; }
__device__ __forceinline__ u32x4 shx4(u32x4 w, int m) { u32x4 o; o.x = __shfl_xor(w.x, m); o.y = __shfl_xor(w.y, m); o.z = __shfl_xor(w.z, m); o.w = __shfl_xor(w.w, m); return o; }
__device__ __forceinline__ float wave_sum(float v) {
#pragma unroll
    for (int o = 1; o < 64; o <<= 1) v += __shfl_xor(v, o);
    return v;
}
__device__ __forceinline__ float wave_max(float v) {
#pragma unroll
    for (int o = 1; o < 64; o <<= 1) v = fmaxf(v, __shfl_xor(v, o));
    return v;
}
__device__ __forceinline__ int cond_idx(int r) { return r < MP ? (r >> 12) : 4 + ((r - MP) >> 4); }
template <int P> __device__ __forceinline__ void slab_ld8(const float* S, int N, int rs, int col, float (&f)[8]) {
    ld8f(S + (size_t)rs * N + col, f);
#pragma unroll
    for (int p = 1; p < P; ++p) { float t[8]; ld8f(S + ((size_t)p * 256 + rs) * N + col, t);
#pragma unroll
        for (int i = 0; i < 8; ++i) f[i] += t[i]; }
}
#define LDS_WAIT() asm volatile("s_waitcnt lgkmcnt(0)" ::: "memory")

struct Args { const float* in[26]; float* out; unsigned char* ws; int ph_lo, ph_hi; };
static_assert(sizeof(Args) == 26 * 8 + 8 + 8 + 8, "Args has no padding");

template <int MODE = 0  > __device__ __forceinline__ void p0_transpose_item(const float* W, int K, int N, int nblk, bf16* WT, LAS float* scr, int item, int lane) {
    const int kb = item / nblk, nb = item % nblk, k0 = 64 * kb, n0 = 32 * nb;
    constexpr bool GU = MODE == 1;
    const int r0 = GU ? ((n0 < DFF) ? 256 * (n0 / 128) + n0 % 128 : 256 * ((n0 - DFF) / 128) + 128 + (n0 - DFF) % 128) : n0;
    const int k8 = lane >> 3, n4 = lane & 7; const bool ok = n0 + 4 * n4 < N;
    f32x4 wv[8];
#pragma unroll
    for (int i = 0; i < 8; ++i) wv[i] = ok ? __builtin_nontemporal_load((const f32x4*)(W + (size_t)(k0 + 8 * i + k8) * N + n0 + 4 * n4)) : (f32x4){0.f, 0.f, 0.f, 0.f};
#pragma unroll
    for (int i = 0; i < 8; ++i) { LAS float* d = scr + (8 * i + k8) * 33 + 4 * n4; d[0] = wv[i].x; d[1] = wv[i].y; d[2] = wv[i].z; d[3] = wv[i].w; }
    LDS_WAIT(); asm volatile("" ::: "memory");
    const int c = lane & 7;
#pragma unroll
    for (int j = 0; j < 4; ++j) { const int nn = (lane >> 3) + 8 * j; const LAS float* s = scr + (8 * c) * 33 + nn;
        u32x4 o; o.x = cvtpk(s[0 * 33], s[1 * 33]); o.y = cvtpk(s[2 * 33], s[3 * 33]); o.z = cvtpk(s[4 * 33], s[5 * 33]); o.w = cvtpk(s[6 * 33], s[7 * 33]);
        const int rowd = (MODE == 2) ? win_row(n0 + nn) : r0 + nn;
        *(u32x4*)(WT + (size_t)rowd * K + k0 + 8 * c) = o; }
    LDS_WAIT(); asm volatile("" ::: "memory");
}

struct TItem { const float* W; bf16* WT; int K, N, nblk, mode, r; };
__device__ __forceinline__ void p0_tload(const TItem& t, int lane, f32x4 (&wv)[8]) {
    const int kb = t.r / t.nblk, nb = t.r - kb * t.nblk, k0 = 64 * kb, n0 = 32 * nb, k8 = lane >> 3, n4 = lane & 7;
    const int col = (n0 + 4 * n4 < t.N) ? n0 + 4 * n4 : 0;
#pragma unroll
    for (int i = 0; i < 8; ++i) wv[i] = __builtin_nontemporal_load((const f32x4*)(t.W + (size_t)(k0 + 8 * i + k8) * t.N + col));
}
__device__ __forceinline__ void p0_tstore(const TItem& t, int lane, const f32x4 (&wv)[8], LAS float* scr) {
    const int kb = t.r / t.nblk, nb = t.r - kb * t.nblk, k0 = 64 * kb, n0 = 32 * nb, k8 = lane >> 3, n4 = lane & 7; const bool ok = n0 + 4 * n4 < t.N;
    const int r0 = (t.mode == 1) ? ((n0 < DFF) ? 256 * (n0 / 128) + n0 % 128 : 256 * ((n0 - DFF) / 128) + 128 + (n0 - DFF) % 128) : n0;
#pragma unroll
    for (int i = 0; i < 8; ++i) { LAS float* d = scr + (8 * i + k8) * 33 + 4 * n4; d[0] = ok ? wv[i].x : 0.f; d[1] = ok ? wv[i].y : 0.f; d[2] = ok ? wv[i].z : 0.f; d[3] = ok ? wv[i].w : 0.f; }
    LDS_WAIT(); asm volatile("" ::: "memory");
    const int c = lane & 7;
#pragma unroll
    for (int j = 0; j < 4; ++j) { const int nn = (lane >> 3) + 8 * j; const LAS float* s = scr + (8 * c) * 33 + nn;
        u32x4 o; o.x = cvtpk(s[0 * 33], s[1 * 33]); o.y = cvtpk(s[2 * 33], s[3 * 33]); o.z = cvtpk(s[4 * 33], s[5 * 33]); o.w = cvtpk(s[6 * 33], s[7 * 33]);
        const int rowd = (t.mode == 2) ? win_row(n0 + nn) : r0 + nn;
        *(u32x4*)(t.WT + (size_t)rowd * t.K + k0 + 8 * c) = o; }
    LDS_WAIT(); asm volatile("" ::: "memory");
}
__device__ __forceinline__ TItem p0_decode(const Args& a, int it) {
    constexpr int I_IN = 32 * 200, I_OUT = 32 * 64, I_GU = 32 * 352, I_DN = 88 * 64, I_UK = 8 * 32, I_UV = 8 * 32, I_L = I_IN + I_OUT + I_GU + I_DN + I_UK + I_UV;
    const int l = it / I_L; int r = it - l * I_L; unsigned char* wl = a.ws + WS_W + (size_t)l * W_LAYER;
    if (r < I_IN) return TItem{a.in[11] + (size_t)l * D * NIN, (bf16*)(wl + WO_IN), D, NIN, 200, 2, r}; r -= I_IN;
    if (r < I_OUT) return TItem{a.in[12] + (size_t)l * D * D, (bf16*)(wl + WO_OUT), D, D, 64, 0, r}; r -= I_OUT;
    if (r < I_GU) return TItem{a.in[23] + (size_t)l * D * NGU, (bf16*)(wl + WO_GU), D, NGU, 352, 1, r}; r -= I_GU;
    if (r < I_DN) return TItem{a.in[25] + (size_t)l * DFF * D, (bf16*)(wl + WO_DN), DFF, D, 64, 0, r}; r -= I_DN;
    if (r < I_UK) return TItem{a.in[15] + (size_t)l * 512 * 1024, (bf16*)(wl + WO_UK), 512, 1024, 32, 0, r}; r -= I_UK;
    return TItem{a.in[16] + (size_t)l * 512 * 1024, (bf16*)(wl + WO_UV), 512, 1024, 32, 0, r};
}

__device__ __forceinline__ void p0a_prologue(const Args& a, LAS unsigned char* lds, int tid, int lane, int wave, int vcu, int G) {
    unsigned char* ws = a.ws;
    {
        f32x2* rope = (f32x2*)(ws + WS_ROPE);
        for (int e = (vcu * 8 + wave) * 64 + lane; e < 4096 * 32; e += G * 512) {
            const int pos = e >> 5, i = e & 31;
            double inv = 1.0; for (int q = 0; q < i; ++q) inv *= 0.74989420933245582730;
            const float ang = (float)pos * (float)inv;
            double x = (double)ang * 0.15915494309189533577; x -= __builtin_rint(x);
            const float xf = (float)x;
            rope[e] = (f32x2){__builtin_amdgcn_cosf(xf), __builtin_amdgcn_sinf(xf)};
        }
    }
    {
        LAS float* tab = (LAS float*)lds;
        LAS float* red = (LAS float*)(lds + 81920);
        LAS float* part = (LAS float*)(lds + 122880);
        float* MOD = (float*)(ws + WS_MOD);
        const int nq = (vcu < 768) ? (768 - vcu + G - 1) / G : 0, g = lane >> 4, c4 = (lane & 15) * 4;
        for (int qb = 0; qb < nq; qb += 3) {
            for (int half = 0; half < 2; ++half) {
                __syncthreads();
                for (int e = tid; e < 20 * 1024; e += 512) { const int m = e >> 10, k = (e & 1023) + half * 1024;
                    const float c = (m < 4) ? a.in[2][m * D + k] : a.in[3][(m - 4) * D + k]; tab[e] = c / (1.f + __expf(-c)); }
                __syncthreads();
                for (int qi = 0; qi < 3 && qb + qi < nq; ++qi) {
                    const int it = vcu + (qb + qi) * G, l = it / 192, strip = it % 192, k0 = wave * 128;
                    const __amdgpu_buffer_rsrc_t rw = __builtin_amdgcn_make_buffer_rsrc((void*)(a.in[17] + (size_t)l * D * NMOD + (size_t)(half * 1024 + k0) * NMOD + strip * 64), 0, 0x7fffffff, 0x00020000);
                    const int wvo = (8 * g * NMOD + c4) * 4;
                    f32x4 acc[20];
#pragma unroll
                    for (int m = 0; m < 20; ++m) acc[m] = (f32x4){0.f, 0.f, 0.f, 0.f};
                    u32x4 wa[8], wb[8];
#define P0_WLD(dst, step) do { _Pragma("unroll") for (int i = 0; i < 8; ++i) dst[i] = __builtin_amdgcn_raw_buffer_load_b128(rw, wvo, ((step) * 32 + i) * (NMOD * 4), 0); } while (0)
#define P0_WF(v) ((f32x4){__uint_as_float((v).x), __uint_as_float((v).y), __uint_as_float((v).z), __uint_as_float((v).w)})
#define P0_WFMA(src, step) do { _Pragma("unroll") for (int m = 0; m < 20; ++m) { const LAS float* tp = tab + m * 1024 + k0 + (step) * 32 + 8 * g; const f32x4 t0 = *(const LAS f32x4*)tp, t1 = *(const LAS f32x4*)(tp + 4); \
                            acc[m] += t0.x * P0_WF(src[0]) + t0.y * P0_WF(src[1]) + t0.z * P0_WF(src[2]) + t0.w * P0_WF(src[3]) + t1.x * P0_WF(src[4]) + t1.y * P0_WF(src[5]) + t1.z * P0_WF(src[6]) + t1.w * P0_WF(src[7]); } } while (0)
                    P0_WLD(wa, 0);
#pragma unroll 1
                    for (int st = 0; st < 4; st += 2) {
                        P0_WLD(wb, st + 1);
                        P0_WFMA(wa, st);
                        P0_WLD(wa, (st + 2 < 4 ? st + 2 : st));
                        P0_WFMA(wb, st + 1);
                    }
#undef P0_WLD
#undef P0_WF
#undef P0_WFMA
#pragma unroll
                    for (int m = 0; m < 20; ++m) {
#pragma unroll
                        for (int e = 0; e < 4; ++e) { float v = acc[m][e]; v += __shfl_xor(v, 16); v += __shfl_xor(v, 32); acc[m][e] = v; }
                        if (g == 0) *(LAS f32x4*)(red + (wave * 20 + m) * 64 + c4) = acc[m]; }
                    __syncthreads();
                    for (int e = tid; e < 20 * 64; e += 512) { const int m = e >> 6, ln = e & 63; float sum = 0.f;
#pragma unroll
                        for (int w8 = 0; w8 < 8; ++w8) sum += red[(w8 * 20 + m) * 64 + ln];
                        if (half == 0) part[qi * 1280 + e] = sum;
                        else MOD[((size_t)l * NCOND + m) * NMOD + strip * 64 + ln] = sum + part[qi * 1280 + e] + a.in[18][(size_t)l * NMOD + strip * 64 + ln]; }
                    __syncthreads();
                }
            }
        }
        __syncthreads();
    }
    {
        LAS float* scr = (LAS float*)(lds + wave * 16384);
        const int gw = vcu * 8 + wave, NGW = G * 8;
        constexpr int I_TOT = NL * (32 * 200 + 32 * 64 + 32 * 352 + 88 * 64 + 8 * 32 + 8 * 32);
        if (gw < I_TOT) {
            f32x4 wa[8], wb[8];
            p0_tload(p0_decode(a, gw), lane, wa);
            for (int it = gw; it < I_TOT; it += 2 * NGW) {
                const int i1 = it + NGW, i2 = it + 2 * NGW; const bool h1 = i1 < I_TOT;
                const TItem t0 = p0_decode(a, it), t1 = p0_decode(a, h1 ? i1 : it), t2 = p0_decode(a, i2 < I_TOT ? i2 : it);
                p0_tload(t1, lane, wb);
                p0_tstore(t0, lane, wa, scr);
                p0_tload(t2, lane, wa);
                if (h1) p0_tstore(t1, lane, wb, scr);
            }
        }
    }
}

__device__ __forceinline__ void modulate_row(const float* xrow, const float* sc, const float* sh, bf16* hrow, bf16* xbrow, int lane) {
#pragma unroll
    for (int j = 0; j < 8; ++j) { const int col = 4 * lane + 256 * j;
        const f32x4 x = __builtin_nontemporal_load((const f32x4*)(xrow + col)), s = *(const f32x4*)(sc + col), h = *(const f32x4*)(sh + col);
        const f32x4 o = x * (1.f + s) + h; u32x2 w; w.x = cvtpk(o.x, o.y); w.y = cvtpk(o.z, o.w); *(u32x2*)(hrow + col) = w;
        u32x2 xw; xw.x = cvtpk(x.x, x.y); xw.y = cvtpk(x.z, x.w); *(u32x2*)(xbrow + col) = xw; }
}
__device__ __forceinline__ void p0b_h0(const Args& a, int lane, int gw, int NGW) {
    const float* MOD = (const float*)(a.ws + WS_MOD); bf16* H = (bf16*)(a.ws + WS_H); bf16* XB = (bf16*)(a.ws + WS_X);
    for (int r = gw; r < M; r += NGW) {
        const float* xrow = r < MP ? a.in[0] + (size_t)r * D : a.in[1] + (size_t)(r - MP) * D;
        const float* mod = MOD + (size_t)cond_idx(r) * NMOD;
        modulate_row(xrow, mod + D, mod, H + (size_t)r * D, XB + (size_t)r * D, lane);
    }
}

__device__ __forceinline__ void rope8(const float (&own)[8], const float (&oth)[8], const float (&cs)[16], float sgn, float (&o)[8]) {
#pragma unroll
    for (int i = 0; i < 8; ++i) o[i] = own[i] * cs[2 * i] + sgn * (oth[i] * cs[2 * i + 1]);
}

__device__ __forceinline__ void shf8(const float (&x)[8], float (&y)[8]) {
#pragma unroll
    for (int i = 0; i < 8; ++i) y[i] = __shfl_xor(x[i], 4);
}
__device__ __forceinline__ void pb_token_row(const Args& a, int l, int r, int lane, unsigned parts) {
    unsigned char* ws = a.ws;
    const bf16* P = (const bf16*)(ws + WS_PROJ) + (size_t)r * NINP;
    const float* SA = (const float*)(ws + WS_SLAB);
    const bool smp = r >= MP; const int rs = r - MP;
    int b, t, pos, krow, T;
    if (!smp) { b = r >> 12; t = r & 4095; pos = t; krow = r; T = SEQ; }
    else { b = rs >> 4; t = rs & 15; pos = PAST + t; krow = MP + b * SKEYS + PAST + t; T = TS; }
    u32x4 L[18];
    if (!smp) { const bf16* P1 = (t >= 1) ? P - NINP : P; const bf16* P2 = (t >= 2) ? P - 2 * NINP : P;
        L[6] = ld16(P + C_BG + 8 * lane); L[7] = ld16(P + C_CG + 8 * lane); L[8] = ld16(P + C_XB + 8 * lane);
        L[9] = ld16(P1 + C_CG + 8 * lane); L[10] = ld16(P1 + C_XB + 8 * lane); L[11] = ld16(P2 + C_CG + 8 * lane); L[12] = ld16(P2 + C_XB + 8 * lane);
        L[16] = ld16(P + C_LAT + 8 * lane); }
#define PB_LD8(k, dr, col, dst) do { if (!smp) unpack8(L[k], dst); else slab_ld8<SP_A>(SA, NINP, rs + (dr), (col), dst); } while (0)
    float* out = a.out;
    const size_t orow = smp ? (size_t)l * MS + rs : (size_t)l * MP + r;
    float x[8], y[8], z[8];
    const int i0 = 4 * (lane & 7);
    float cq[8]; ld8f((const float*)(ws + WS_ROPE) + ((size_t)pos * 32 + i0) * 2, cq);
#define PB_QROPE(scale, lo, hi) do { _Pragma("unroll") for (int k = 0; k < 4; ++k) { lo[k] = (x[2 * k] * cq[2 * k] - x[2 * k + 1] * cq[2 * k + 1]) * (scale); hi[k] = (x[2 * k] * cq[2 * k + 1] + x[2 * k + 1] * cq[2 * k]) * (scale); } } while (0)
#define PB_ST4(ptr, v) do { u32x2 w_; w_.x = cvtpk(v[0], v[1]); w_.y = cvtpk(v[2], v[3]); *(u32x2*)(ptr) = w_; } while (0)
    if (parts & 1u) { float lo[4], hi4[4]; PB_LD8(0, 0, C_QA + 8 * lane, x); PB_QROPE(QS_A, lo, hi4);
      bf16* qd = (bf16*)(ws + WS_QA) + (size_t)r * 512 + (lane >> 3) * 64 + i0; PB_ST4(qd, lo); PB_ST4(qd + 32, hi4); }
    if (parts & 2u) { float lo[4], hi4[4]; PB_LD8(1, 0, C_KA + 8 * lane, x); PB_QROPE(1.f, lo, hi4);
      float* od = out + O_SAK + orow * 512 + (lane >> 3) * 64 + i0; *(f32x4*)od = (f32x4){lo[0], lo[1], lo[2], lo[3]}; *(f32x4*)(od + 32) = (f32x4){hi4[0], hi4[1], hi4[2], hi4[3]};
      bf16* kd = (bf16*)(ws + WS_KA) + (size_t)krow * 512 + (lane >> 3) * 64 + i0; PB_ST4(kd, lo); PB_ST4(kd + 32, hi4); }
    if (parts & 4u) { PB_LD8(2, 0, C_VA + 8 * lane, x); st8f_nt(out + (smp ? O_SAV : O_PAV) + orow * 512 + 8 * lane, x); }
    if (parts & 8u)
#pragma unroll
    for (int s = 0; s < 2; ++s) { float lo[4], hi4[4]; PB_LD8(3 + s, 0, C_QI + 512 * s + 8 * lane, x); PB_QROPE(1.f, lo, hi4);
      bf16* qd = (bf16*)(ws + WS_QI) + (size_t)r * 1024 + 512 * s + (lane >> 3) * 64 + i0; PB_ST4(qd, lo); PB_ST4(qd + 32, hi4); }
    if (parts & 16u) {
      if (lane < 8) { float lo[4], hi4[4]; PB_LD8(5, 0, C_KI + 8 * lane, x); PB_QROPE(1.f, lo, hi4);
          float* od = out + O_SIK + orow * 64 + i0; *(f32x4*)od = (f32x4){lo[0], lo[1], lo[2], lo[3]}; *(f32x4*)(od + 32) = (f32x4){hi4[0], hi4[1], hi4[2], hi4[3]};
          bf16* kd = (bf16*)(ws + WS_KI) + (size_t)krow * 64 + i0; PB_ST4(kd, lo); PB_ST4(kd + 32, hi4); }
      else if (lane < 10) { PB_LD8(5, 0, C_WI + 8 * (lane - 8), x);
#pragma unroll
          for (int i = 0; i < 8; ++i) z[i] = x[i] * WI_SCALE;
          st8f((float*)(ws + WS_WI) + (size_t)r * 16 + 8 * (lane - 8), z); } }
    if (parts & 32u) { const int c = 8 * lane; float bgv[8], u0[8], u1[8], u2[8], w0[8], w1[8], w2[8];
      PB_LD8(6, 0, C_BG + c, bgv); PB_LD8(7, 0, C_CG + c, x); PB_LD8(8, 0, C_XB + c, y);
#pragma unroll
      for (int i = 0; i < 8; ++i) u0[i] = x[i] * y[i];
      const float* st = a.in[9] + ((size_t)(l * NBS + b) * 2) * 512 + c;
      if (t >= 1) { PB_LD8(9, -1, C_CG + c, x); PB_LD8(10, -1, C_XB + c, y);
#pragma unroll
          for (int i = 0; i < 8; ++i) u1[i] = x[i] * y[i]; }
      else if (smp) ld8f(st + 512, u1);
      else {
#pragma unroll
          for (int i = 0; i < 8; ++i) u1[i] = 0.f; }
      if (t >= 2) { PB_LD8(11, -2, C_CG + c, x); PB_LD8(12, -2, C_XB + c, y);
#pragma unroll
          for (int i = 0; i < 8; ++i) u2[i] = x[i] * y[i]; }
      else if (smp) ld8f(st + (size_t)t * 512, u2);
      else {
#pragma unroll
          for (int i = 0; i < 8; ++i) u2[i] = 0.f; }
      const float* cw = a.in[13] + (size_t)l * 3 * 512 + c; ld8f(cw, w0); ld8f(cw + 512, w1); ld8f(cw + 1024, w2);
#pragma unroll
      for (int i = 0; i < 8; ++i) z[i] = bgv[i] * (u2[i] * w0[i] + u1[i] * w1[i] + u0[i] * w2[i]);
      st16((bf16*)(ws + WS_MIX) + (size_t)r * D + 512 + c, pack8(z));
      if (t >= T - 2) { float* so = out + (smp ? O_SCB + ((size_t)(l * NBS + b) * 2 + (t - (T - 2))) * 512 : O_PCB + ((size_t)(l * NBP + b) * 2 + (t - (T - 2))) * 512) + c; st8f_nt(so, u0); } }
    if (parts & 64u) {
#pragma unroll
      for (int s = 0; s < 2; ++s) { const int pc = 512 * s + 8 * lane; PB_LD8(13 + s, 0, C_QCN + pc, x);
#pragma unroll
        for (int i = 0; i < 8; ++i) z[i] = x[i] * QS_C;
        st16((bf16*)(ws + WS_QC) + (size_t)r * 1536 + (pc >> 7) * 192 + (pc & 127), pack8(z)); }
      { float lo[4], hi4[4]; PB_LD8(15, 0, C_QCR + 8 * lane, x); PB_QROPE(QS_C, lo, hi4);
        bf16* qd = (bf16*)(ws + WS_QC) + (size_t)r * 1536 + (lane >> 3) * 192 + 128 + i0; PB_ST4(qd, lo); PB_ST4(qd + 32, hi4); } }
    if (parts & 128u) { PB_LD8(16, 0, C_LAT + 8 * lane, x); float ss = 0.f;
#pragma unroll
      for (int i = 0; i < 8; ++i) ss += x[i] * x[i];
      ss = wave_sum(ss); const float rsq = 1.0f / sqrtf(ss * (1.f / 512.f) + RMS_EPS);
      ld8f(a.in[14] + (size_t)l * 512 + 8 * lane, y);
#pragma unroll
      for (int i = 0; i < 8; ++i) z[i] = x[i] * rsq * y[i];
      st8f_nt(out + (smp ? O_SLAT : O_PLAT) + orow * 512 + 8 * lane, z);
      st16((bf16*)(ws + WS_LAT) + (size_t)krow * 512 + 8 * lane, pack8(z)); }
    if (parts & 256u) {
      if (lane < 8) { float lo[4], hi4[4]; PB_LD8(17, 0, C_KR + 8 * lane, x); PB_QROPE(1.f, lo, hi4);
          float* od = out + O_SKR + orow * 64 + i0; *(f32x4*)od = (f32x4){lo[0], lo[1], lo[2], lo[3]}; *(f32x4*)(od + 32) = (f32x4){hi4[0], hi4[1], hi4[2], hi4[3]};
          bf16* kd = (bf16*)(ws + WS_KR) + (size_t)krow * 64 + i0; PB_ST4(kd, lo); PB_ST4(kd + 32, hi4); } }
#undef PB_LD8
#undef PB_QROPE
#undef PB_ST4
}

__device__ __forceinline__ void pb_cache_row(const Args& a, int l, int cr, int lane) {
    unsigned char* ws = a.ws; const int b = cr >> 10, s = cr & 1023; const size_t krow = (size_t)MP + b * SKEYS + s; const size_t src = (size_t)(l * NBS + b) * PAST + s;
    float x[8];
    ld8f_nt(a.in[4] + src * 512 + 8 * lane, x); st16((bf16*)(ws + WS_KA) + krow * 512 + 8 * lane, pack8(x));
    ld8f_nt(a.in[7] + src * 512 + 8 * lane, x); st16((bf16*)(ws + WS_LAT) + krow * 512 + 8 * lane, pack8(x));
    if (lane < 8) { ld8f_nt(a.in[6] + src * 64 + 8 * lane, x); st16((bf16*)(ws + WS_KI) + krow * 64 + 8 * lane, pack8(x)); }
    else if (lane < 16) { ld8f_nt(a.in[8] + src * 64 + 8 * (lane - 8), x); st16((bf16*)(ws + WS_KR) + krow * 64 + 8 * (lane - 8), pack8(x)); }
}

__device__ __forceinline__ void pb_vat_prompt(const Args& a, int job, int lane) {
    unsigned char* ws = a.ws; const int rb = job >> 3, h = job & 7; const int krow0 = rb * 64, colv = h * 64 + lane;
    const bf16* src = (const bf16*)(ws + WS_PROJ) + (size_t)krow0 * NINP + C_VA + colv;
    unsigned pk[32];
#pragma unroll
    for (int i2 = 0; i2 < 32; ++i2) pk[i2] = (unsigned)src[(size_t)(2 * i2) * NINP] | ((unsigned)src[(size_t)(2 * i2 + 1) * NINP] << 16);
    bf16* dst = (bf16*)(ws + WS_VAT) + (size_t)colv * KROWS + krow0;
#pragma unroll
    for (int q = 0; q < 8; ++q) st16(dst + 8 * q, (u32x4){pk[4 * q], pk[4 * q + 1], pk[4 * q + 2], pk[4 * q + 3]});
}
__device__ __forceinline__ void pb_vat_cache(const Args& a, int l, int job, int lane) {
    unsigned char* ws = a.ws; const int b = job >> 7, j = (job >> 3) & 15, h = job & 7, colv = h * 64 + lane;
    const float* src = a.in[5] + ((size_t)(l * NBS + b) * PAST + 64 * j) * 512 + colv;
    unsigned pk[32];
#pragma unroll
    for (int i2 = 0; i2 < 32; ++i2) pk[i2] = cvtpk(__builtin_nontemporal_load(src + (size_t)(2 * i2) * 512), __builtin_nontemporal_load(src + (size_t)(2 * i2 + 1) * 512));
    bf16* dst = (bf16*)(ws + WS_VAT) + (size_t)colv * KROWS + MP + b * SKEYS + 64 * j;
#pragma unroll
    for (int q = 0; q < 8; ++q) st16(dst + 8 * q, (u32x4){pk[4 * q], pk[4 * q + 1], pk[4 * q + 2], pk[4 * q + 3]});
}
__device__ __forceinline__ void pb_vat_new(const Args& a, int job, int lane) {
    unsigned char* ws = a.ws; const int b = job >> 3, h = job & 7, colv = h * 64 + lane;
    const float* sp = (const float*)(ws + WS_SLAB) + (size_t)(b * TS) * NINP + C_VA + colv;
    unsigned pk[8];
#pragma unroll
    for (int i2 = 0; i2 < 8; ++i2) { float v[2];
#pragma unroll
        for (int e = 0; e < 2; ++e) { const float* q = sp + (size_t)(2 * i2 + e) * NINP; float acc = q[0];
#pragma unroll
            for (int pp = 1; pp < SP_A; ++pp) acc += q[(size_t)pp * 256 * NINP];
            v[e] = acc; }
        pk[i2] = cvtpk(v[0], v[1]); }
    bf16* dst = (bf16*)(ws + WS_VAT) + (size_t)colv * KROWS + MP + b * SKEYS + PAST;
    st16(dst, (u32x4){pk[0], pk[1], pk[2], pk[3]}); st16(dst + 8, (u32x4){pk[4], pk[5], pk[6], pk[7]});
}

__device__ __forceinline__ void pb_prompt_rows8(const Args& a, int l, int r0, int lane) {
    unsigned char* ws = a.ws; float* out = a.out;
    const int b = r0 >> 12, t0 = r0 & 4095, c = 8 * lane;
    const __amdgpu_buffer_rsrc_t rp = __builtin_amdgcn_make_buffer_rsrc((void*)((const bf16*)(ws + WS_PROJ) + (size_t)r0 * NINP), 0, 0x7fffffff, 0x00020000);
    const int vo = 16 * lane;
    float w0[8], w1[8], w2[8], kvn[8], u1[8], u2[8];
    { const float* cw = a.in[13] + (size_t)l * 3 * 512 + c; ld8f(cw, w0); ld8f(cw + 512, w1); ld8f(cw + 1024, w2); ld8f(a.in[14] + (size_t)l * 512 + c, kvn); }
    if (t0 > 0) { const bf16* Pm = (const bf16*)(ws + WS_PROJ) + (size_t)(r0 - 2) * NINP; float x[8], y[8];
        unpack8(ld16(Pm + C_CG + c), x); unpack8(ld16(Pm + C_XB + c), y);
#pragma unroll
        for (int i = 0; i < 8; ++i) u2[i] = x[i] * y[i];
        unpack8(ld16(Pm + NINP + C_CG + c), x); unpack8(ld16(Pm + NINP + C_XB + c), y);
#pragma unroll
        for (int i = 0; i < 8; ++i) u1[i] = x[i] * y[i]; }
    else {
#pragma unroll
        for (int i = 0; i < 8; ++i) { u1[i] = 0.f; u2[i] = 0.f; } }
    bf16* mix = (bf16*)(ws + WS_MIX) + (size_t)r0 * D + 512 + c; bf16* latb = (bf16*)(ws + WS_LAT) + (size_t)r0 * 512 + c; float* plat = out + O_PLAT + ((size_t)l * MP + r0) * 512 + c;
#define PB8_LOAD(S, row) do { S[0] = __builtin_amdgcn_raw_buffer_load_b128(rp, vo, (row) * (NINP * 2) + C_BG * 2, 0); S[1] = __builtin_amdgcn_raw_buffer_load_b128(rp, vo, (row) * (NINP * 2) + C_CG * 2, 0); \
        S[2] = __builtin_amdgcn_raw_buffer_load_b128(rp, vo, (row) * (NINP * 2) + C_XB * 2, 0); S[3] = __builtin_amdgcn_raw_buffer_load_b128(rp, vo, (row) * (NINP * 2) + C_LAT * 2, 0); } while (0)
#define PB8_ROW(S) do { float bgv[8], x[8], y[8], u0[8], z[8]; unpack8(S[0], bgv); unpack8(S[1], x); unpack8(S[2], y); \
        _Pragma("unroll") for (int i = 0; i < 8; ++i) { u0[i] = x[i] * y[i]; z[i] = bgv[i] * (u2[i] * w0[i] + u1[i] * w1[i] + u0[i] * w2[i]); u2[i] = u1[i]; u1[i] = u0[i]; } \
        st16(mix, pack8(z)); mix += D; \
        unpack8(S[3], x); float ss = 0.f; \
        _Pragma("unroll") for (int i = 0; i < 8; ++i) ss += x[i] * x[i]; \
        ss = wave_sum(ss); const float rsq = 1.0f / sqrtf(ss * (1.f / 512.f) + RMS_EPS); \
        _Pragma("unroll") for (int i = 0; i < 8; ++i) z[i] = x[i] * rsq * kvn[i]; \
        st8f_nt(plat, z); plat += 512; st16(latb, pack8(z)); latb += 512; } while (0)
    u32x4 A[4], B[4];
    PB8_LOAD(A, 0);
#pragma unroll 1
    for (int ii = 0; ii < 4; ++ii) {
        PB8_LOAD(B, 2 * ii + 1);
        PB8_ROW(A);
        { const int rn = (2 * ii + 2 < 8) ? 2 * ii + 2 : 7; PB8_LOAD(A, rn); }
        PB8_ROW(B);
    }
#undef PB8_LOAD
#undef PB8_ROW
    if (t0 == SEQ - 8) { float* so = out + O_PCB + ((size_t)(l * NBP + b) * 2) * 512 + c; st8f_nt(so, u2); st8f_nt(so + 512, u1); }
}

constexpr int PD_KEYS = 0, PD_TILE = 131072, PD_HIST = 147456;

__device__ __forceinline__ void radix_scan(const LAS unsigned* hist, unsigned need, int lane, unsigned& Tout, unsigned& above_out) {
    const u32x4 v = *(const LAS u32x4*)(hist + 4 * lane);
    const unsigned s = v.x + v.y + v.z + v.w;
    unsigned suf = s;
#pragma unroll
    for (int o = 1; o < 64; o <<= 1) { const unsigned t = __shfl_down(suf, o); suf += (lane + o < 64) ? t : 0u; }
    const unsigned above = suf - s;
    const bool hit = (above < need) && (above + s >= need);
    const unsigned long long bm = __ballot(hit);
    const int L = bm ? (int)__builtin_ctzll(bm) : 0;
    unsigned c = above, Tl, Al;
    if (c + v.w >= need) { Tl = 3u; Al = c; }
    else { c += v.w; if (c + v.z >= need) { Tl = 2u; Al = c; } else { c += v.z; if (c + v.y >= need) { Tl = 1u; Al = c; } else { c += v.y; Tl = 0u; Al = c; } } }
    Tout = (unsigned)__builtin_amdgcn_readlane((int)Tl, L) + 4u * (unsigned)L;
    above_out = (unsigned)__builtin_amdgcn_readlane((int)Al, L);
}

__device__ __forceinline__ void radix_scan3(const LAS unsigned* hist, unsigned need, int lane, unsigned& Tout, unsigned& above_out, unsigned& cnt_out) {
    const u32x4 v = *(const LAS u32x4*)(hist + 4 * lane);
    const unsigned s = v.x + v.y + v.z + v.w;
    unsigned suf = s;
#pragma unroll
    for (int o = 1; o < 64; o <<= 1) { const unsigned t = __shfl_down(suf, o); suf += (lane + o < 64) ? t : 0u; }
    const unsigned above = suf - s;
    const bool hit = (above < need) && (above + s >= need);
    const unsigned long long bm = __ballot(hit);
    const int L = bm ? (int)__builtin_ctzll(bm) : 0;
    unsigned c = above, Tl, Al, Cl;
    if (c + v.w >= need) { Tl = 3u; Al = c; Cl = v.w; }
    else { c += v.w; if (c + v.z >= need) { Tl = 2u; Al = c; Cl = v.z; } else { c += v.z; if (c + v.y >= need) { Tl = 1u; Al = c; Cl = v.y; } else { c += v.y; Tl = 0u; Al = c; Cl = v.x; } } }
    Tout = (unsigned)__builtin_amdgcn_readlane((int)Tl, L) + 4u * (unsigned)L;
    above_out = (unsigned)__builtin_amdgcn_readlane((int)Al, L);
    cnt_out = (unsigned)__builtin_amdgcn_readlane((int)Cl, L);
}

__device__ __forceinline__ float relu1(float x) { const int b = __float_as_int(x); return __int_as_float(b > 0 ? b : 0); }
__device__ __forceinline__ void pd_group(const Args& a, LAS unsigned char* lds, int q0, int tid) {
    unsigned char* ws = a.ws;
    const int lane = tid & 63, wid = __builtin_amdgcn_readfirstlane(tid >> 6);
    const int q = q0 + wid;
    unsigned long long* SEL = (unsigned long long*)(ws + WS_SEL) + (size_t)q * 64;
    int nsteps, nvalid; size_t krow0;
    if (q0 < MP) { const int t = q0 & 4095; nsteps = (t >> 6) + 1; nvalid = nsteps * 64; krow0 = (size_t)(q0 & ~4095); }
    else { const int b = (q0 - MP) >> 4; nsteps = 17; nvalid = SKEYS; krow0 = (size_t)MP + (size_t)b * SKEYS; }
    if (nsteps <= 4) { SEL[lane] = (lane < nsteps) ? ~0ull : 0ull; return; }
    const int kc = lane & 15, g = lane >> 4;
    bf16x8 af[2];
    { const bf16* qp = (const bf16*)(ws + WS_QI) + (size_t)q * 1024 + kc * 64 + 8 * g; af[0] = *(const bf16x8*)qp; af[1] = *(const bf16x8*)(qp + 32); }
    const f32x4 wv = *(const f32x4*)((const float*)(ws + WS_WI) + (size_t)q * 16 + 4 * g);
    LAS unsigned* keys = (LAS unsigned*)(lds + PD_KEYS + wid * 16384);
    LAS unsigned* hist = (LAS unsigned*)(lds + PD_HIST + wid * 1024);
    const bf16* ksrc = (const bf16*)(ws + WS_KI) + (krow0 + (tid >> 3)) * 64 + 8 * (tid & 7);
    const int sdst = PD_TILE + (tid >> 3) * 128 + (((tid & 7) ^ ((tid >> 4) & 7)) * 16);
    const int sw = (kc >> 1) & 7;
    const int boff0 = PD_TILE + kc * 128 + ((g ^ sw) * 16), boff1 = PD_TILE + kc * 128 + (((4 + g) ^ sw) * 16);
    constexpr int PFD = 8;
    u32x4 pf[PFD];
    for (int rr_ = 0; rr_ < 1 + (int)((MK_REP >> 16) & 1u); ++rr_) {
    __syncthreads();
    *(LAS u32x4*)(hist + 4 * lane) = (u32x4){0u, 0u, 0u, 0u};
    { const u32x4 t0 = ld16(ksrc);
#pragma unroll
      for (int i = 0; i < PFD; ++i) { const int ls = (1 + i < nsteps) ? 1 + i : nsteps - 1; pf[i] = ld16(ksrc + (size_t)ls * 4096); }
      *(LAS u32x4*)(lds + sdst) = t0; }
    __syncthreads();
    for (int st0 = 0; st0 < nsteps; st0 += PFD) {
#pragma unroll
      for (int j = 0; j < PFD; ++j) {
        const int st = st0 + j;
        if (st < nsteps) {
        const LAS unsigned char* tb = lds + (st & 1) * 8192;
        float pg[4];
        {
            bf16x8 bq[8];
#pragma unroll
            for (int grp = 0; grp < 4; ++grp) { bq[2 * grp] = *(const LAS bf16x8*)(tb + boff0 + grp * 2048); bq[2 * grp + 1] = *(const LAS bf16x8*)(tb + boff1 + grp * 2048); }
            __builtin_amdgcn_sched_barrier(0);
            f32x4 acc[4];
#pragma unroll
            for (int grp = 0; grp < 4; ++grp) acc[grp] = __builtin_amdgcn_mfma_f32_16x16x32_bf16(af[0], bq[2 * grp], (f32x4){0.f, 0.f, 0.f, 0.f}, 0, 0, 0);
#pragma unroll
            for (int grp = 0; grp < 4; ++grp) acc[grp] = __builtin_amdgcn_mfma_f32_16x16x32_bf16(af[1], bq[2 * grp + 1], acc[grp], 0, 0, 0);
            __builtin_amdgcn_sched_barrier(0);
#pragma unroll
            for (int grp = 0; grp < 4; ++grp) { float p = 0.f;
                p = fmaf(relu1(acc[grp].x), wv.x, p); p = fmaf(relu1(acc[grp].y), wv.y, p); p = fmaf(relu1(acc[grp].z), wv.z, p); p = fmaf(relu1(acc[grp].w), wv.w, p);
                pg[grp] = p; }
        }
        float mine;
        { const auto s02 = __builtin_amdgcn_permlane32_swap(__float_as_uint(pg[0]), __float_as_uint(pg[2]), false, false);
          const auto s13 = __builtin_amdgcn_permlane32_swap(__float_as_uint(pg[1]), __float_as_uint(pg[3]), false, false);
          const float e = __uint_as_float(s02[0]) + __uint_as_float(s02[1]);
          const float o = __uint_as_float(s13[0]) + __uint_as_float(s13[1]);
          const auto t = __builtin_amdgcn_permlane16_swap(__float_as_uint(e), __float_as_uint(o), false, false);
          mine = __uint_as_float(t[0]) + __uint_as_float(t[1]); }
        const unsigned u = __float_as_uint(mine); const unsigned ok = u ^ ((unsigned)((int)u >> 31) | 0x80000000u);
        const bool kvalid = 64 * st + lane < nvalid;
        keys[64 * st + lane] = kvalid ? ok : 0u;
        if (kvalid) __hip_atomic_fetch_add(hist + (ok >> 24), 1u, __ATOMIC_RELAXED, __HIP_MEMORY_SCOPE_WORKGROUP);
        *(LAS u32x4*)(lds + ((st + 1) & 1) * 8192 + sdst) = pf[j];
        { const int ls = (st + 1 + PFD < nsteps) ? st + 1 + PFD : nsteps - 1; pf[j] = ld16(ksrc + (size_t)ls * 4096); }
        __syncthreads();
        }
      }
    }
    }
    unsigned long long mymask = 0ull;
    for (int rr_ = 0; rr_ < 1 + (int)((MK_REP >> 17) & 1u); ++rr_) {
    if (rr_) { *(LAS u32x4*)(hist + 4 * lane) = (u32x4){0u, 0u, 0u, 0u}; for (int st = 0; st < nsteps; ++st) { const unsigned k = keys[64 * st + lane]; if (64 * st + lane < nvalid) __hip_atomic_fetch_add(hist + (k >> 24), 1u, __ATOMIC_RELAXED, __HIP_MEMORY_SCOPE_WORKGROUP); } }
    unsigned prefix = 0u, need = 256u;
    { unsigned T, ab; radix_scan(hist, need, lane, T, ab); prefix = T; need -= ab; }
#pragma unroll
    for (int pass = 1; pass < 4; ++pass) {
        const int sh = 24 - 8 * pass;
        *(LAS u32x4*)(hist + 4 * lane) = (u32x4){0u, 0u, 0u, 0u};
#pragma unroll 4
        for (int st = 0; st < nsteps; ++st) { const unsigned k = keys[64 * st + lane];
            if ((k >> (sh + 8)) == prefix) __hip_atomic_fetch_add(hist + ((k >> sh) & 0xffu), 1u, __ATOMIC_RELAXED, __HIP_MEMORY_SCOPE_WORKGROUP); }
        unsigned T, ab; radix_scan(hist, need, lane, T, ab);
        prefix = (prefix << 8) | T; need -= ab;
    }
    const unsigned tkey = prefix, take_eq = need;
    mymask = 0ull; unsigned run = 0u;
    const unsigned long long lt = (lane == 0) ? 0ull : (~0ull >> (64 - lane));
#pragma unroll 4
    for (int st = 0; st < nsteps; ++st) { const unsigned k = keys[64 * st + lane];
        const bool gt = k > tkey, eq = k == tkey;
        const unsigned long long em = __ballot(eq);
        const unsigned rank = run + (unsigned)__builtin_popcountll(em & lt);
        const bool sel = gt || (eq && rank < take_eq);
        run += (unsigned)__builtin_popcountll(em);
        const unsigned long long sm = __ballot(sel);
        mymask = (lane == st) ? sm : mymask;
    }
    }
    SEL[lane] = mymask;
}


constexpr int PD2_TILE = 0, PD2_TB = 32768, PD2_H8 = 65536;
__device__ __forceinline__ void pd_group256(const Args& a, LAS unsigned char* lds, int q0, int tid) {
    unsigned char* ws = a.ws;
    const int lane = tid & 63, wid = __builtin_amdgcn_readfirstlane(tid >> 6);
    const int q = q0 + wid;
    unsigned long long* SEL = (unsigned long long*)(ws + WS_SEL) + (size_t)q * 64;
    int nsteps, nvalid; size_t krow0;
    if (q0 < MP) { const int t = q0 & 4095; nsteps = (t >> 6) + 1; nvalid = nsteps * 64; krow0 = (size_t)(q0 & ~4095); }
    else { const int b = (q0 - MP) >> 4; nsteps = 17; nvalid = SKEYS; krow0 = (size_t)MP + (size_t)b * SKEYS; }
    if (nsteps <= 4) { SEL[lane] = (lane < nsteps) ? ~0ull : 0ull; return; }
    const int nbig = (nsteps + 3) >> 2;
    const int kc = lane & 15, g = lane >> 4;
    bf16x8 af[2];
    { const bf16* qp = (const bf16*)(ws + WS_QI) + (size_t)q * 1024 + kc * 64 + 8 * g; af[0] = *(const bf16x8*)qp; af[1] = *(const bf16x8*)(qp + 32); }
    const f32x4 wv = *(const f32x4*)((const float*)(ws + WS_WI) + (size_t)q * 16 + 4 * g);
    LAS unsigned* keys = (LAS unsigned*)(lds + PD_KEYS + wid * 16384);
    LAS unsigned* hist = (LAS unsigned*)(lds + PD_HIST + wid * 1024);
    LAS unsigned* hist8 = (LAS unsigned*)(lds + PD2_H8 + wid * (8 * 260 * 4)) + (lane & 7) * 260;
    const bf16* ksrc = (const bf16*)(ws + WS_KI) + (krow0 + (tid >> 3)) * 64 + 8 * (tid & 7);
    const int sdst = PD2_TILE + (tid >> 3) * 128 + (((tid & 7) ^ ((tid >> 4) & 7)) * 16);
    const int sw = (kc >> 1) & 7;
    const int boff0 = PD2_TILE + kc * 128 + ((g ^ sw) * 16), boff1 = PD2_TILE + kc * 128 + (((4 + g) ^ sw) * 16);
    constexpr int PFD = 2;
    u32x4 pf[PFD][4];
    unsigned key[64];
    __syncthreads();
    unsigned z0 = 0u; asm volatile("" : "+v"(z0));
    const u32x4 zz = (u32x4){z0, z0, z0, z0};
    { LAS unsigned* h8 = (LAS unsigned*)(lds + PD2_H8 + wid * (8 * 260 * 4));
#pragma unroll
      for (int c = 0; c < 8; ++c) *(LAS u32x4*)(h8 + c * 260 + 4 * lane) = zz;
      if (lane < 8) *(LAS u32x4*)(h8 + lane * 260 + 256) = zz; }
    { u32x4 t0[4];
#pragma unroll
      for (int i = 0; i < 4; ++i) t0[i] = ld16(ksrc + (size_t)i * 4096);
#pragma unroll
      for (int s = 0; s < PFD; ++s) { const int bl = (1 + s < nbig) ? 1 + s : nbig - 1;
#pragma unroll
          for (int i = 0; i < 4; ++i) pf[s][i] = ld16(ksrc + (size_t)bl * 16384 + (size_t)i * 4096); }
#pragma unroll
      for (int i = 0; i < 4; ++i) *(LAS u32x4*)(lds + sdst + i * 8192) = t0[i]; }
    __syncthreads();
#pragma unroll
    for (int bs = 0; bs < 16; ++bs) {
#pragma unroll
        for (int s4 = 0; s4 < 4; ++s4) key[4 * bs + s4] = 0u;
        if (bs < nbig) {
            const LAS unsigned char* tb = lds + (bs & 1) * PD2_TB;
#pragma unroll
            for (int s4 = 0; s4 < 4; ++s4) if (256 * bs + 64 * s4 < nvalid) {
                float pg[4];
                {   bf16x8 bq[8];
#pragma unroll
                    for (int grp = 0; grp < 4; ++grp) { bq[2 * grp] = *(const LAS bf16x8*)(tb + boff0 + s4 * 8192 + grp * 2048); bq[2 * grp + 1] = *(const LAS bf16x8*)(tb + boff1 + s4 * 8192 + grp * 2048); }
                    f32x4 acc[4];
#pragma unroll
                    for (int grp = 0; grp < 4; ++grp) acc[grp] = __builtin_amdgcn_mfma_f32_16x16x32_bf16(af[0], bq[2 * grp], (f32x4){0.f, 0.f, 0.f, 0.f}, 0, 0, 0);
#pragma unroll
                    for (int grp = 0; grp < 4; ++grp) acc[grp] = __builtin_amdgcn_mfma_f32_16x16x32_bf16(af[1], bq[2 * grp + 1], acc[grp], 0, 0, 0);
#pragma unroll
                    for (int grp = 0; grp < 4; ++grp) { float p = 0.f;
                        p = fmaf(relu1(acc[grp].x), wv.x, p); p = fmaf(relu1(acc[grp].y), wv.y, p); p = fmaf(relu1(acc[grp].z), wv.z, p); p = fmaf(relu1(acc[grp].w), wv.w, p);
                        pg[grp] = p; }
                }
                float mine;
                { const auto s02 = __builtin_amdgcn_permlane32_swap(__float_as_uint(pg[0]), __float_as_uint(pg[2]), false, false);
                  const auto s13 = __builtin_amdgcn_permlane32_swap(__float_as_uint(pg[1]), __float_as_uint(pg[3]), false, false);
                  const float e = __uint_as_float(s02[0]) + __uint_as_float(s02[1]);
                  const float o = __uint_as_float(s13[0]) + __uint_as_float(s13[1]);
                  const auto t = __builtin_amdgcn_permlane16_swap(__float_as_uint(e), __float_as_uint(o), false, false);
                  mine = __uint_as_float(t[0]) + __uint_as_float(t[1]); }
                const unsigned u = __float_as_uint(mine); const unsigned ok = u ^ ((unsigned)((int)u >> 31) | 0x80000000u);
                if (256 * bs + 64 * s4 + 64 <= nvalid) {
                    key[4 * bs + s4] = ok; __hip_atomic_fetch_add(hist8 + (ok >> 24), 1u, __ATOMIC_RELAXED, __HIP_MEMORY_SCOPE_WORKGROUP);
                } else { const bool kvalid = 256 * bs + 64 * s4 + lane < nvalid;
                    key[4 * bs + s4] = kvalid ? ok : 0u;
                    if (kvalid) __hip_atomic_fetch_add(hist8 + (ok >> 24), 1u, __ATOMIC_RELAXED, __HIP_MEMORY_SCOPE_WORKGROUP); }
            }
#pragma unroll
            for (int i = 0; i < 4; ++i) *(LAS u32x4*)(lds + ((bs + 1) & 1) * PD2_TB + sdst + i * 8192) = pf[bs % PFD][i];
            { const int bl = (bs + 1 + PFD < nbig) ? bs + 1 + PFD : nbig - 1;
#pragma unroll
              for (int i = 0; i < 4; ++i) pf[bs % PFD][i] = ld16(ksrc + (size_t)bl * 16384 + (size_t)i * 4096); }
            __syncthreads();
            __builtin_amdgcn_sched_barrier(0);
        }
    }
    { const LAS unsigned* h8 = (const LAS unsigned*)(lds + PD2_H8 + wid * (8 * 260 * 4)); u32x4 t = *(const LAS u32x4*)(h8 + 4 * lane);
#pragma unroll
      for (int c = 1; c < 8; ++c) { const u32x4 v = *(const LAS u32x4*)(h8 + c * 260 + 4 * lane); t.x += v.x; t.y += v.y; t.z += v.z; t.w += v.w; }
      *(LAS u32x4*)(hist + 4 * lane) = t; }
    __syncthreads();
#pragma unroll
    for (int J = 0; J < 16; ++J) *(LAS u32x4*)(keys + 256 * J + 4 * lane) = (u32x4){key[4 * J], key[4 * J + 1], key[4 * J + 2], key[4 * J + 3]};
    unsigned prefix = 0u, need = 256u, tkey = 0u, take_eq = 0u; bool done = false;
    { unsigned T, ab, cn; radix_scan3(hist, need, lane, T, ab, cn); prefix = T; need -= ab; if (cn == need && prefix != 0u) { tkey = (prefix << 24) - 1u; done = true; } }
#pragma unroll
    for (int pass = 1; pass < 4; ++pass) {
        if (!done) {
        const int sh = 24 - 8 * pass;
        *(LAS u32x4*)(hist + 4 * lane) = zz;
#pragma unroll 2
        for (int J = 0; J < nbig; ++J) { const u32x4 kk = *(const LAS u32x4*)(keys + 256 * J + 4 * lane);
            const bool m0 = (kk[0] >> (sh + 8)) == prefix, m1 = (kk[1] >> (sh + 8)) == prefix, m2 = (kk[2] >> (sh + 8)) == prefix, m3 = (kk[3] >> (sh + 8)) == prefix;
            if (__any(m0 | m1 | m2 | m3)) {
                if (m0) __hip_atomic_fetch_add(hist + ((kk[0] >> sh) & 0xffu), 1u, __ATOMIC_RELAXED, __HIP_MEMORY_SCOPE_WORKGROUP);
                if (m1) __hip_atomic_fetch_add(hist + ((kk[1] >> sh) & 0xffu), 1u, __ATOMIC_RELAXED, __HIP_MEMORY_SCOPE_WORKGROUP);
                if (m2) __hip_atomic_fetch_add(hist + ((kk[2] >> sh) & 0xffu), 1u, __ATOMIC_RELAXED, __HIP_MEMORY_SCOPE_WORKGROUP);
                if (m3) __hip_atomic_fetch_add(hist + ((kk[3] >> sh) & 0xffu), 1u, __ATOMIC_RELAXED, __HIP_MEMORY_SCOPE_WORKGROUP); } }
        unsigned T, ab, cn; radix_scan3(hist, need, lane, T, ab, cn);
        prefix = (prefix << 8) | T; need -= ab;
        if (pass < 3 && cn == need && prefix != 0u) { tkey = (prefix << sh) - 1u; done = true; }
        }
    }
    if (!done) { tkey = prefix; take_eq = need; }
    unsigned long long mymask = 0ull; unsigned run = 0u;
    const unsigned long long lt = (lane == 0) ? 0ull : (~0ull >> (64 - lane));
    if (take_eq == 0u) {
#pragma unroll 2
        for (int J = 0; J < nbig; ++J) { const u32x4 kk = *(const LAS u32x4*)(keys + 256 * J + 4 * lane);
#pragma unroll
            for (int c = 0; c < 4; ++c) { const unsigned long long sm = __ballot(kk[c] > tkey); mymask = (lane == 4 * J + c) ? sm : mymask; } }
    } else
#pragma unroll 2
    for (int J = 0; J < nbig; ++J) { const u32x4 kk = *(const LAS u32x4*)(keys + 256 * J + 4 * lane);
#pragma unroll
        for (int c = 0; c < 4; ++c) { const unsigned k = kk[c]; const int st = 4 * J + c;
            const bool gt = k > tkey, eq = k == tkey;
            const unsigned long long em = __ballot(eq);
            const unsigned rank = run + (unsigned)__builtin_popcountll(em & lt);
            const bool sel = gt || (eq && rank < take_eq);
            run += (unsigned)__builtin_popcountll(em);
            const unsigned long long sm = __ballot(sel);
            mymask = (lane == st) ? sm : mymask; }
    }
    SEL[lane] = mymask;
}

constexpr float ATT_THR = 8.0f, ATT_BIG = 4096.0f;
template <int DQK, int DK1, int DV, bool MASKED>
__device__ __forceinline__ void attn_unit(LAS unsigned char* lds, const bf16* Q, int qpitch, const bf16* K1, int k1p, const bf16* K2, int k2p, const bf16* Vt, int vp,
                                          const unsigned long long* SEL, bf16* O, int opitch, int qb, int tid) {
    constexpr int KP = DQK * 2 + 16, VP = 144, KBYTES = 64 * KP, VBYTES = DV * VP, BUF = KBYTES + VBYTES;
    constexpr int C1 = DK1 / 8, C2 = (DQK - DK1) / 8, NK1 = 64 * C1 / 512, NK2 = 64 * C2 / 512, NVC = DV * 8 / 512, NDS = DQK / 16, NDB = DV / 32;
    static_assert(64 * C1 % 512 == 0 && 64 * C2 % 512 == 0 && DV * 8 % 512 == 0 && 2 * BUF <= LDS_RING, "attention tile staging");
    const int lane = tid & 63, wid = __builtin_amdgcn_readfirstlane(tid >> 6), rho = lane & 31, hi = lane >> 5;
    const int prho = (rho & ~12) | ((rho & 8) >> 1) | ((rho & 4) << 1);
    const int NT = 4 * qb + 4, cw = 4 * qb + (wid >> 1);
    bf16x8 qf[NDS];
    { const bf16* qp = Q + (size_t)(32 * wid + rho) * qpitch + 8 * hi;
#pragma unroll
      for (int ds = 0; ds < NDS; ++ds) qf[ds] = *(const bf16x8*)(qp + 16 * ds); }
    const unsigned long long* selp = MASKED ? SEL + (size_t)(32 * wid + rho) * 64 : nullptr;
    const __amdgpu_buffer_rsrc_t r1 = __builtin_amdgcn_make_buffer_rsrc((void*)K1, 0, 0x7fffffff, 0x00020000);
    const __amdgpu_buffer_rsrc_t r2 = __builtin_amdgcn_make_buffer_rsrc((void*)(C2 ? K2 : K1), 0, 0x7fffffff, 0x00020000);
    const __amdgpu_buffer_rsrc_t rv = __builtin_amdgcn_make_buffer_rsrc((void*)Vt, 0, 0x7fffffff, 0x00020000);
    int ko1[NK1], kl1[NK1], ko2[NK2 ? NK2 : 1], kl2[NK2 ? NK2 : 1], vo[NVC], vl[NVC];
#pragma unroll
    for (int i = 0; i < NK1; ++i) { const int cid = tid + 512 * i, row = cid / C1, ch = cid % C1; ko1[i] = (row * k1p + 8 * ch) * 2; kl1[i] = row * KP + ch * 16; }
#pragma unroll
    for (int i = 0; i < NK2; ++i) { const int cid = tid + 512 * i, row = cid / (C2 ? C2 : 1), ch = cid % (C2 ? C2 : 1); ko2[i] = (row * k2p + 8 * ch) * 2; kl2[i] = row * KP + (C1 + ch) * 16; }
#pragma unroll
    for (int i = 0; i < NVC; ++i) { const int cid = tid + 512 * i, d = cid >> 3, ch = cid & 7; vo[i] = (d * vp + 8 * ch) * 2; vl[i] = KBYTES + d * VP + ch * 16; }
    u32x4 kreg1[NK1], kreg2[NK2 ? NK2 : 1], vreg[NVC];
#define AT_LOAD(t) do { \
        _Pragma("unroll") for (int i = 0; i < NK1; ++i) kreg1[i] = __builtin_amdgcn_raw_buffer_load_b128(r1, ko1[i], (t) * 64 * k1p * 2, 0); \
        _Pragma("unroll") for (int i = 0; i < NK2; ++i) kreg2[i] = __builtin_amdgcn_raw_buffer_load_b128(r2, ko2[i], (t) * 64 * k2p * 2, 0); \
        _Pragma("unroll") for (int i = 0; i < NVC; ++i) vreg[i] = __builtin_amdgcn_raw_buffer_load_b128(rv, vo[i], (t) * 128, 0); } while (0)
#define AT_STORE(buf) do { \
        _Pragma("unroll") for (int i = 0; i < NK1; ++i) *(LAS u32x4*)(lds + (buf) * BUF + kl1[i]) = kreg1[i]; \
        _Pragma("unroll") for (int i = 0; i < NK2; ++i) *(LAS u32x4*)(lds + (buf) * BUF + kl2[i]) = kreg2[i]; \
        _Pragma("unroll") for (int i = 0; i < NVC; ++i) *(LAS u32x4*)(lds + (buf) * BUF + vl[i]) = vreg[i]; } while (0)
    f32x16 o[NDB];
#pragma unroll
    for (int db = 0; db < NDB; ++db)
#pragma unroll
        for (int r = 0; r < 16; ++r) o[db][r] = 0.f;
    float m = -1e30f, l = 0.f;
    __syncthreads();
    AT_LOAD(0); AT_STORE(0);
    __syncthreads();
    for (int t = 0; t < NT; ++t) {
        const int buf = t & 1;
        if (t + 1 < NT) AT_LOAD(t + 1);
        if (t <= cw) {
            const LAS unsigned char* kb = lds + buf * BUF; const LAS unsigned char* vb = kb + KBYTES;
            unsigned long long sw = 0ull; if (MASKED) sw = selp[t];
            f32x16 sb[2];

#pragma unroll
            for (int kbk = 0; kbk < 2; ++kbk) {
#pragma unroll
                for (int r = 0; r < 16; ++r) sb[kbk][r] = 0.f;
                constexpr int PF = (NDS < 6) ? NDS : 6;
                const LAS unsigned char* kr = kb + (32 * kbk + prho) * KP + 16 * hi;
                bf16x8 af[PF];
#pragma unroll
                for (int i = 0; i < PF; ++i) af[i] = *(const LAS bf16x8*)(kr + 32 * i);
#pragma unroll
                for (int ds = 0; ds < NDS; ++ds) {
                    const bf16x8 a0 = af[ds % PF];
                    if (ds + PF < NDS) af[ds % PF] = *(const LAS bf16x8*)(kr + 32 * (ds + PF));
                    sb[kbk] = __builtin_amdgcn_mfma_f32_32x32x16_bf16(a0, qf[ds], sb[kbk], 0, 0, 0);
                }
            }

#pragma unroll
            for (int kbk = 0; kbk < 2; ++kbk) {
                f32x16 s0 = sb[kbk];
                bf16x8 vfr[2 * NDB];
#pragma unroll
                for (int db = 0; db < NDB; ++db) { vfr[2 * db] = *(const LAS bf16x8*)(vb + (32 * db + rho) * VP + (32 * kbk + 8 * hi) * 2); vfr[2 * db + 1] = *(const LAS bf16x8*)(vb + (32 * db + rho) * VP + (32 * kbk + 16 + 8 * hi) * 2); }
                asm volatile("" ::: "memory");
                if (MASKED) {
                    const unsigned w0 = (unsigned)(sw >> (32 * kbk)) >> (8 * hi);
#pragma unroll
                    for (int r = 0; r < 16; ++r) { const unsigned bit = 1u << (16 * (r >> 3) + (r & 7)); s0[r] = (w0 & bit) ? s0[r] : -INFINITY; }
                }
                float mx = s0[0];
#pragma unroll
                for (int r = 1; r < 16; ++r) mx = fmaxf(mx, s0[r]);
                { const auto rr = __builtin_amdgcn_permlane32_swap(__float_as_uint(mx), __float_as_uint(mx), false, false); mx = fmaxf(__uint_as_float(rr[0]), __uint_as_float(rr[1])); }
                if (__any(mx > m + ATT_THR)) {
                    const float mn = fmaxf(m, mx), alpha = __builtin_amdgcn_exp2f(m - mn); m = mn; l *= alpha;
#pragma unroll
                    for (int db = 0; db < NDB; ++db)
#pragma unroll
                        for (int r = 0; r < 16; ++r) o[db][r] *= alpha;
                }
                float ps = 0.f;
#pragma unroll
                for (int r = 0; r < 16; ++r) { s0[r] = __builtin_amdgcn_exp2f(s0[r] - m); ps += s0[r]; }
                l += ps;
                bf16x8 pf[2];
#pragma unroll
                for (int s = 0; s < 2; ++s) { u32x4 p0;
                    p0.x = cvtpk(s0[8 * s], s0[8 * s + 1]); p0.y = cvtpk(s0[8 * s + 2], s0[8 * s + 3]); p0.z = cvtpk(s0[8 * s + 4], s0[8 * s + 5]); p0.w = cvtpk(s0[8 * s + 6], s0[8 * s + 7]);
                    pf[s] = __builtin_bit_cast(bf16x8, p0); }

#pragma unroll
                for (int db = 0; db < NDB; ++db) {
                    o[db] = __builtin_amdgcn_mfma_f32_32x32x16_bf16(vfr[2 * db], pf[0], o[db], 0, 0, 0);
                    o[db] = __builtin_amdgcn_mfma_f32_32x32x16_bf16(vfr[2 * db + 1], pf[1], o[db], 0, 0, 0);
                }

            }
        }
        if (t + 1 < NT) AT_STORE(buf ^ 1);
        __syncthreads();
    }
#undef AT_LOAD
#undef AT_STORE
    const float lt = l + __shfl_xor(l, 32); const float inv = 1.0f / lt;
    bf16* op = O + (size_t)(32 * wid + rho) * opitch + 4 * hi;
#pragma unroll
    for (int db = 0; db < NDB; ++db)
#pragma unroll
        for (int g4 = 0; g4 < 4; ++g4) { u32x2 w; w.x = cvtpk(o[db][4 * g4] * inv, o[db][4 * g4 + 1] * inv); w.y = cvtpk(o[db][4 * g4 + 2] * inv, o[db][4 * g4 + 3] * inv);
            *(u32x2*)(op + 32 * db + 8 * g4) = w; }
}

template <int DQK, int DK1, int DV, bool MASKED>
__device__ __forceinline__ void attn_unit_deep(LAS unsigned char* lds, const bf16* Q, int qpitch, const bf16* K1, int k1p, const bf16* K2, int k2p, const bf16* Vt, int vp,
                                          const unsigned long long* SEL, bf16* O, int opitch, int qb, int tid) {
    constexpr int KP = DQK * 2 + 16, VP = 144, KBYTES = 64 * KP, VBYTES = DV * VP, BUF = KBYTES + VBYTES;
    constexpr int C1 = DK1 / 8, C2 = (DQK - DK1) / 8, NK1 = 64 * C1 / 512, NK2 = 64 * C2 / 512, NVC = DV * 8 / 512, NDS = DQK / 16, NDB = DV / 32;
    static_assert(64 * C1 % 512 == 0 && 64 * C2 % 512 == 0 && DV * 8 % 512 == 0 && 2 * BUF <= LDS_RING, "attention tile staging");
    const int lane = tid & 63, wid = __builtin_amdgcn_readfirstlane(tid >> 6), rho = lane & 31, hi = lane >> 5;
    const int prho = (rho & ~12) | ((rho & 8) >> 1) | ((rho & 4) << 1);
    const int NT = 4 * qb + 4, cw = 4 * qb + (wid >> 1);
    bf16x8 qf[NDS];
    { const bf16* qp = Q + (size_t)(32 * wid + rho) * qpitch + 8 * hi;
#pragma unroll
      for (int ds = 0; ds < NDS; ++ds) qf[ds] = *(const bf16x8*)(qp + 16 * ds); }
    const unsigned long long* selp = MASKED ? SEL + (size_t)(32 * wid + rho) * 64 : nullptr;
    const __amdgpu_buffer_rsrc_t r1 = __builtin_amdgcn_make_buffer_rsrc((void*)K1, 0, 0x7fffffff, 0x00020000);
    const __amdgpu_buffer_rsrc_t r2 = __builtin_amdgcn_make_buffer_rsrc((void*)(C2 ? K2 : K1), 0, 0x7fffffff, 0x00020000);
    const __amdgpu_buffer_rsrc_t rv = __builtin_amdgcn_make_buffer_rsrc((void*)Vt, 0, 0x7fffffff, 0x00020000);
    int ko1[NK1], kl1[NK1], ko2[NK2 ? NK2 : 1], kl2[NK2 ? NK2 : 1], vo[NVC], vl[NVC];
#pragma unroll
    for (int i = 0; i < NK1; ++i) { const int cid = tid + 512 * i, row = cid / C1, ch = cid % C1; ko1[i] = (row * k1p + 8 * ch) * 2; kl1[i] = row * KP + ch * 16; }
#pragma unroll
    for (int i = 0; i < NK2; ++i) { const int cid = tid + 512 * i, row = cid / (C2 ? C2 : 1), ch = cid % (C2 ? C2 : 1); ko2[i] = (row * k2p + 8 * ch) * 2; kl2[i] = row * KP + (C1 + ch) * 16; }
#pragma unroll
    for (int i = 0; i < NVC; ++i) { const int cid = tid + 512 * i, d = cid >> 3, ch = cid & 7; vo[i] = (d * vp + 8 * ch) * 2; vl[i] = KBYTES + d * VP + ch * 16; }
    u32x4 kreg1[4][NK1], kreg2[4][NK2 ? NK2 : 1], vreg[4][NVC];
#define AT_LOAD(t, S) do { \
        _Pragma("unroll") for (int i = 0; i < NK1; ++i) kreg1[S][i] = __builtin_amdgcn_raw_buffer_load_b128(r1, ko1[i], (t) * 64 * k1p * 2, 0); \
        _Pragma("unroll") for (int i = 0; i < NK2; ++i) kreg2[S][i] = __builtin_amdgcn_raw_buffer_load_b128(r2, ko2[i], (t) * 64 * k2p * 2, 0); \
        _Pragma("unroll") for (int i = 0; i < NVC; ++i) vreg[S][i] = __builtin_amdgcn_raw_buffer_load_b128(rv, vo[i], (t) * 128, 0); } while (0)
#define AT_STORE(buf, S) do { \
        _Pragma("unroll") for (int i = 0; i < NK1; ++i) *(LAS u32x4*)(lds + (buf) * BUF + kl1[i]) = kreg1[S][i]; \
        _Pragma("unroll") for (int i = 0; i < NK2; ++i) *(LAS u32x4*)(lds + (buf) * BUF + kl2[i]) = kreg2[S][i]; \
        _Pragma("unroll") for (int i = 0; i < NVC; ++i) *(LAS u32x4*)(lds + (buf) * BUF + vl[i]) = vreg[S][i]; } while (0)
    f32x16 o[NDB];
#pragma unroll
    for (int db = 0; db < NDB; ++db)
#pragma unroll
        for (int r = 0; r < 16; ++r) o[db][r] = 0.f;
    float m = -1e30f, l = 0.f;
    __syncthreads();
    AT_LOAD(0, 0); AT_STORE(0, 0);
    AT_LOAD(1, 1); AT_LOAD(2, 2);
    unsigned long long swn = 0ull; if (MASKED) swn = selp[0];
    __syncthreads();
    for (int t0 = 0; t0 < NT; t0 += 4) {
#pragma unroll
      for (int u = 0; u < 4; ++u) {
        const int t = t0 + u, buf = u & 1;
        { const int tl = (t + 3 < NT) ? t + 3 : NT - 1; AT_LOAD(tl, (u + 3) & 3); }
        const unsigned long long sw = swn; if (MASKED) swn = selp[(t + 1 < NT) ? t + 1 : NT - 1];
        if (t <= cw) {
            const LAS unsigned char* kb = lds + buf * BUF; const LAS unsigned char* vb = kb + KBYTES;
            f32x16 sb[2];

#pragma unroll
            for (int kbk = 0; kbk < 2; ++kbk) {
#pragma unroll
                for (int r = 0; r < 16; ++r) sb[kbk][r] = 0.f;
                constexpr int PF = (NDS < 6) ? NDS : 6;
                const LAS unsigned char* kr = kb + (32 * kbk + prho) * KP + 16 * hi;
                bf16x8 af[PF];
#pragma unroll
                for (int i = 0; i < PF; ++i) af[i] = *(const LAS bf16x8*)(kr + 32 * i);
#pragma unroll
                for (int ds = 0; ds < NDS; ++ds) {
                    const bf16x8 a0 = af[ds % PF];
                    if (ds + PF < NDS) af[ds % PF] = *(const LAS bf16x8*)(kr + 32 * (ds + PF));
                    sb[kbk] = __builtin_amdgcn_mfma_f32_32x32x16_bf16(a0, qf[ds], sb[kbk], 0, 0, 0);
                }
            }

#pragma unroll
            for (int kbk = 0; kbk < 2; ++kbk) {
                f32x16 s0 = sb[kbk];
                bf16x8 vfr[2 * NDB];
#pragma unroll
                for (int db = 0; db < NDB; ++db) { vfr[2 * db] = *(const LAS bf16x8*)(vb + (32 * db + rho) * VP + (32 * kbk + 8 * hi) * 2); vfr[2 * db + 1] = *(const LAS bf16x8*)(vb + (32 * db + rho) * VP + (32 * kbk + 16 + 8 * hi) * 2); }
                asm volatile("" ::: "memory");
                if (MASKED) {
                    const unsigned w0 = (unsigned)(sw >> (32 * kbk)) >> (8 * hi);
#pragma unroll
                    for (int r = 0; r < 16; ++r) { const unsigned mk = (unsigned)((int)(w0 << (31 - (16 * (r >> 3) + (r & 7)))) >> 31);
                        s0[r] = __uint_as_float((mk & __float_as_uint(s0[r])) | (~mk & 0xff800000u)); }
                }
                f32x16 pe; float ps = 0.f;
#pragma unroll
                for (int r = 0; r < 16; ++r) { pe[r] = __builtin_amdgcn_exp2f(s0[r] - m); ps += pe[r]; }
                if (__any(!(ps <= ATT_BIG))) {
                    float mx = s0[0];
#pragma unroll
                    for (int r = 1; r < 16; ++r) mx = fmaxf(mx, s0[r]);
                    { const auto rr = __builtin_amdgcn_permlane32_swap(__float_as_uint(mx), __float_as_uint(mx), false, false); mx = fmaxf(__uint_as_float(rr[0]), __uint_as_float(rr[1])); }
                    const float mn = fmaxf(m, mx), alpha = __builtin_amdgcn_exp2f(m - mn); m = mn; l *= alpha;
#pragma unroll
                    for (int db = 0; db < NDB; ++db)
#pragma unroll
                        for (int r = 0; r < 16; ++r) o[db][r] *= alpha;
                    ps = 0.f;
#pragma unroll
                    for (int r = 0; r < 16; ++r) { pe[r] = __builtin_amdgcn_exp2f(s0[r] - m); ps += pe[r]; }
                }
                l += ps;
                bf16x8 pf[2];
#pragma unroll
                for (int s = 0; s < 2; ++s) { u32x4 p0;
                    p0.x = cvtpk(pe[8 * s], pe[8 * s + 1]); p0.y = cvtpk(pe[8 * s + 2], pe[8 * s + 3]); p0.z = cvtpk(pe[8 * s + 4], pe[8 * s + 5]); p0.w = cvtpk(pe[8 * s + 6], pe[8 * s + 7]);
                    pf[s] = __builtin_bit_cast(bf16x8, p0); }

#pragma unroll
                for (int db = 0; db < NDB; ++db) {
                    o[db] = __builtin_amdgcn_mfma_f32_32x32x16_bf16(vfr[2 * db], pf[0], o[db], 0, 0, 0);
                    o[db] = __builtin_amdgcn_mfma_f32_32x32x16_bf16(vfr[2 * db + 1], pf[1], o[db], 0, 0, 0);
                }

            }
        }
        if (t + 1 < NT) AT_STORE(buf ^ 1, (u + 1) & 3);
        __syncthreads();
      }
    }
#undef AT_LOAD
#undef AT_STORE
    const float lt = l + __shfl_xor(l, 32); const float inv = 1.0f / lt;
    bf16* op = O + (size_t)(32 * wid + rho) * opitch + 4 * hi;
#pragma unroll
    for (int db = 0; db < NDB; ++db)
#pragma unroll
        for (int g4 = 0; g4 < 4; ++g4) { u32x2 w; w.x = cvtpk(o[db][4 * g4] * inv, o[db][4 * g4 + 1] * inv); w.y = cvtpk(o[db][4 * g4 + 2] * inv, o[db][4 * g4 + 3] * inv);
            *(u32x2*)(op + 32 * db + 8 * g4) = w; }
}

template <int DQK, int DK1, int DV, bool MASKED, bool QLDS>
__device__ __forceinline__ void attn_unit_pipe(LAS unsigned char* lds, const bf16* Q, int qpitch, const bf16* K1, int k1p, const bf16* K2, int k2p, const bf16* Vt, int vp,
                                          const unsigned long long* SEL, bf16* O, int opitch, int qb, int tid) {
    constexpr int KP = DQK * 2 + 16, VP = 144, KBYTES = 64 * KP, VBYTES = DV * VP, VOFF = 2 * KBYTES;
    constexpr int C1 = DK1 / 8, C2 = (DQK - DK1) / 8, NK1 = 64 * C1 / 512, NK2 = 64 * C2 / 512, NVC = DV * 8 / 512, NDS = DQK / 16, NDB = DV / 32;
    static_assert(64 * C1 % 512 == 0 && 64 * C2 % 512 == 0 && DV * 8 % 512 == 0 && 2 * KBYTES + 3 * VBYTES <= LDS_RING, "attention tile staging");
    const int lane = tid & 63, wid = __builtin_amdgcn_readfirstlane(tid >> 6), rho = lane & 31, hi = lane >> 5;
    const int prho = (rho & ~12) | ((rho & 8) >> 1) | ((rho & 4) << 1);
    const int NT = 4 * qb + 4, cw = 4 * qb + (wid >> 1);
    constexpr int NQR = QLDS ? DK1 / 16 : NDS, QOFF = VOFF + 3 * VBYTES;
    static_assert(!QLDS || QOFF + 8 * 32 * 144 <= LDS_BYTES - 8192, "Q image");
    bf16x8 qf[NQR];
    LAS unsigned char* const qlds = lds + QOFF + (32 * wid + rho) * 144 + 16 * hi;
    { const bf16* qp = Q + (size_t)(32 * wid + rho) * qpitch + 8 * hi;
#pragma unroll
      for (int ds = 0; ds < NDS; ++ds) { const bf16x8 v = *(const bf16x8*)(qp + 16 * ds); if (ds < NQR) qf[ds] = v; else *(LAS bf16x8*)(qlds + 32 * (ds - NQR)) = v; } }
    const unsigned long long* selp = MASKED ? SEL + (size_t)(32 * wid + rho) * 64 : nullptr;
    const __amdgpu_buffer_rsrc_t r1 = __builtin_amdgcn_make_buffer_rsrc((void*)K1, 0, 0x7fffffff, 0x00020000);
    const __amdgpu_buffer_rsrc_t r2 = __builtin_amdgcn_make_buffer_rsrc((void*)(C2 ? K2 : K1), 0, 0x7fffffff, 0x00020000);
    const __amdgpu_buffer_rsrc_t rv = __builtin_amdgcn_make_buffer_rsrc((void*)Vt, 0, 0x7fffffff, 0x00020000);
#define AT_OFFS() int tq_ = tid; asm volatile("" : "+v"(tq_)); int ko1[NK1], kl1[NK1], ko2[NK2 ? NK2 : 1], kl2[NK2 ? NK2 : 1], vo[NVC], vl[NVC]; \
        _Pragma("unroll") for (int i = 0; i < NK1; ++i) { const int cid = tq_ + 512 * i, row = cid / C1, ch = cid % C1; ko1[i] = (row * k1p + 8 * ch) * 2; kl1[i] = row * KP + ch * 16; } \
        _Pragma("unroll") for (int i = 0; i < NK2; ++i) { const int cid = tq_ + 512 * i, row = cid / (C2 ? C2 : 1), ch = cid % (C2 ? C2 : 1); ko2[i] = (row * k2p + 8 * ch) * 2; kl2[i] = row * KP + (C1 + ch) * 16; } \
        _Pragma("unroll") for (int i = 0; i < NVC; ++i) { const int cid = tq_ + 512 * i, d = cid >> 3, ch = cid & 7; vo[i] = (d * vp + 8 * ch) * 2; vl[i] = VOFF + d * VP + ch * 16; } \
        (void)ko1; (void)kl1; (void)ko2; (void)kl2; (void)vo; (void)vl
    u32x4 kreg1[NK1], kreg2[NK2 ? NK2 : 1], vreg[NVC];
#define AT_LOADK(t) do { AT_OFFS(); \
        _Pragma("unroll") for (int i = 0; i < NK1; ++i) kreg1[i] = __builtin_amdgcn_raw_buffer_load_b128(r1, ko1[i], (t) * 64 * k1p * 2, 0); \
        _Pragma("unroll") for (int i = 0; i < NK2; ++i) kreg2[i] = __builtin_amdgcn_raw_buffer_load_b128(r2, ko2[i], (t) * 64 * k2p * 2, 0); } while (0)
#define AT_LOADV(t) do { AT_OFFS(); \
        _Pragma("unroll") for (int i = 0; i < NVC; ++i) vreg[i] = __builtin_amdgcn_raw_buffer_load_b128(rv, vo[i], (t) * 128, 0); } while (0)
#define AT_STOREK(buf) do { AT_OFFS(); \
        _Pragma("unroll") for (int i = 0; i < NK1; ++i) *(LAS u32x4*)(lds + (buf) * KBYTES + kl1[i]) = kreg1[i]; \
        _Pragma("unroll") for (int i = 0; i < NK2; ++i) *(LAS u32x4*)(lds + (buf) * KBYTES + kl2[i]) = kreg2[i]; } while (0)
#define AT_STOREV(buf) do { AT_OFFS(); \
        _Pragma("unroll") for (int i = 0; i < NVC; ++i) *(LAS u32x4*)(lds + (buf) * VBYTES + vl[i]) = vreg[i]; } while (0)
    f32x16 o[NDB];
#pragma unroll
    for (int db = 0; db < NDB; ++db)
#pragma unroll
        for (int r = 0; r < 16; ++r) o[db][r] = 0.f;
    float m = -1e30f, l = 0.f;
    f32x16 sc;
    constexpr int PF = (NDS < 2) ? NDS : 2;
    constexpr int NCH = 12, CPM = NCH / NDS;
    static_assert(NCH % NDS == 0, "softmax chunking");
#define AT_QK_PLAIN(kbase) do { \
        _Pragma("unroll") for (int r = 0; r < 16; ++r) sc[r] = 0.f; \
        const LAS unsigned char* kr_ = (kbase) + prho * KP + 16 * hi; bf16x8 af_[PF]; \
        _Pragma("unroll") for (int i = 0; i < PF; ++i) af_[i] = *(const LAS bf16x8*)(kr_ + 32 * i); \
        _Pragma("unroll") for (int ds = 0; ds < NDS; ++ds) { const bf16x8 a0 = af_[ds % PF]; if (ds + PF < NDS) af_[ds % PF] = *(const LAS bf16x8*)(kr_ + 32 * (ds + PF)); \
            const bf16x8 qv = (ds < NQR) ? qf[ds < NQR ? ds : 0] : *(const LAS bf16x8*)(qlds + 32 * (ds - NQR)); \
            sc = __builtin_amdgcn_mfma_f32_32x32x16_bf16(a0, qv, sc, 0, 0, 0); } } while (0)
#define AT_STEP(HAVE_NEXT, knext, vbase, koff, mw) do { \
        f32x16 sn; \
        _Pragma("unroll") for (int r = 0; r < 16; ++r) sn[r] = 0.f; \
        const LAS unsigned char* kr_ = (knext) + prho * KP + 16 * hi; bf16x8 af_[PF]; \
        if (HAVE_NEXT) { _Pragma("unroll") for (int i = 0; i < PF; ++i) af_[i] = *(const LAS bf16x8*)(kr_ + 32 * i); } \
        bf16x8 va0 = *(const LAS bf16x8*)((vbase) + rho * VP + ((koff) + 8 * hi) * 2), va1 = *(const LAS bf16x8*)((vbase) + rho * VP + ((koff) + 16 + 8 * hi) * 2);     \
        float mx = 0.f, alpha = 1.f, ps = 0.f; u32x4 pw0, pw1; bf16x8 qn = af_[0]; \
        _Pragma("unroll") for (int c = 0; c < NCH; ++c) { \
            if (c == 0) { if (MASKED) { const unsigned w0_ = (mw) >> (8 * hi); \
                    _Pragma("unroll") for (int r = 0; r < 16; ++r) { const unsigned bit = 1u << (16 * (r >> 3) + (r & 7)); sc[r] = (w0_ & bit) ? sc[r] : -INFINITY; } } \
                mx = fmaxf(fmaxf(fmaxf(sc[0], sc[1]), fmaxf(sc[2], sc[3])), fmaxf(fmaxf(sc[4], sc[5]), fmaxf(sc[6], sc[7]))); } \
            else if (c == 1) { mx = fmaxf(mx, fmaxf(fmaxf(fmaxf(sc[8], sc[9]), fmaxf(sc[10], sc[11])), fmaxf(fmaxf(sc[12], sc[13]), fmaxf(sc[14], sc[15])))); \
                const auto rr = __builtin_amdgcn_permlane32_swap(__float_as_uint(mx), __float_as_uint(mx), false, false); mx = fmaxf(__uint_as_float(rr[0]), __uint_as_float(rr[1])); \
                const float mn = fmaxf(m, mx); alpha = __builtin_amdgcn_exp2f(m - mn); m = mn; l *= alpha; } \
            else if (c < 10) { const int e = 2 * (c - 2); sc[e] = __builtin_amdgcn_exp2f(sc[e] - m); sc[e + 1] = __builtin_amdgcn_exp2f(sc[e + 1] - m); ps += sc[e] + sc[e + 1]; } \
            else if (c == 10) { pw0.x = cvtpk(sc[0], sc[1]); pw0.y = cvtpk(sc[2], sc[3]); pw0.z = cvtpk(sc[4], sc[5]); pw0.w = cvtpk(sc[6], sc[7]); } \
            else { pw1.x = cvtpk(sc[8], sc[9]); pw1.y = cvtpk(sc[10], sc[11]); pw1.z = cvtpk(sc[12], sc[13]); pw1.w = cvtpk(sc[14], sc[15]); l += ps; } \
            if (HAVE_NEXT && (c % CPM) == 0) { const int ds = c / CPM; const bf16x8 a0 = af_[ds % PF]; if (ds + PF < NDS) af_[ds % PF] = *(const LAS bf16x8*)(kr_ + 32 * (ds + PF)); \
                const bf16x8 qv = (ds < NQR) ? qf[ds < NQR ? ds : 0] : qn; if (QLDS && ds + 1 >= NQR && ds + 1 < NDS) qn = *(const LAS bf16x8*)(qlds + 32 * (ds + 1 - NQR)); \
                sn = __builtin_amdgcn_mfma_f32_32x32x16_bf16(a0, qv, sn, 0, 0, 0); } \
            __builtin_amdgcn_sched_barrier(0); } \
        const bf16x8 pf0 = __builtin_bit_cast(bf16x8, pw0), pf1 = __builtin_bit_cast(bf16x8, pw1); \
        _Pragma("unroll") for (int r = 0; r < 16; ++r) o[0][r] *= alpha; \
        __builtin_amdgcn_sched_barrier(0); \
        _Pragma("unroll") for (int db = 0; db < NDB; ++db) { \
            bf16x8 vb0 = va0, vb1 = va1; \
            if (db + 1 < NDB) { vb0 = *(const LAS bf16x8*)((vbase) + (32 * (db + 1) + rho) * VP + ((koff) + 8 * hi) * 2); vb1 = *(const LAS bf16x8*)((vbase) + (32 * (db + 1) + rho) * VP + ((koff) + 16 + 8 * hi) * 2); } \
            o[db] = __builtin_amdgcn_mfma_f32_32x32x16_bf16(va0, pf0, o[db], 0, 0, 0); \
            if (db + 1 < NDB) { _Pragma("unroll") for (int r = 0; r < 8; ++r) o[db + 1][r] *= alpha; } \
            __builtin_amdgcn_sched_barrier(0); \
            o[db] = __builtin_amdgcn_mfma_f32_32x32x16_bf16(va1, pf1, o[db], 0, 0, 0); \
            if (db + 1 < NDB) { _Pragma("unroll") for (int r = 8; r < 16; ++r) o[db + 1][r] *= alpha; } \
            __builtin_amdgcn_sched_barrier(0); \
            va0 = vb0; va1 = vb1; } \
        if (HAVE_NEXT) sc = sn; } while (0)
    __syncthreads();
    AT_LOADK(0); AT_LOADV(0); AT_STOREK(0); AT_STOREV(0);
    __syncthreads();
    unsigned long long swp = 0ull;
    int v3 = 0;
    unsigned long long swn = 0ull; if (MASKED) swn = selp[0];
    for (int t = 0; t < NT; ++t) {
        const int buf = t & 1, v3n = (v3 == 2) ? 0 : v3 + 1, v3p = (v3 == 0) ? 2 : v3 - 1; const bool more = t + 1 < NT;
        if (more) AT_LOADK(t + 1);
        const LAS unsigned char* kb = lds + buf * KBYTES; const LAS unsigned char* vb = lds + VOFF + v3 * VBYTES; const LAS unsigned char* vbp = lds + VOFF + v3p * VBYTES;
        const unsigned long long sw = swn; if (MASKED && t + 1 <= cw) swn = selp[t + 1];
        if (t <= cw) {
            if (t == 0) AT_QK_PLAIN(kb);
            else AT_STEP(true, kb, vbp, 32, (unsigned)(swp >> 32));
        }
        if (more) { AT_STOREK(buf ^ 1); AT_LOADV(t + 1); }
        if (t <= cw) {
            AT_STEP(true, kb + 32 * KP, vb, 0, (unsigned)sw);
            if (t == cw) AT_STEP(false, kb, vb, 32, (unsigned)(sw >> 32));
            swp = sw;
        }
        if (more) AT_STOREV(v3n);
        v3 = v3n;
        __syncthreads();
    }
#undef AT_QK_PLAIN
#undef AT_STEP
#undef AT_LOAD
#undef AT_STORE
#undef AT_LOADK
#undef AT_LOADV
#undef AT_STOREK
#undef AT_STOREV
#undef AT_OFFS
    const float lt = l + __shfl_xor(l, 32); const float inv = 1.0f / lt;
    bf16* op = O + (size_t)(32 * wid + rho) * opitch + 4 * hi;
#pragma unroll
    for (int db = 0; db < NDB; ++db)
#pragma unroll
        for (int g4 = 0; g4 < 4; ++g4) { u32x2 w; w.x = cvtpk(o[db][4 * g4] * inv, o[db][4 * g4 + 1] * inv); w.y = cvtpk(o[db][4 * g4 + 2] * inv, o[db][4 * g4 + 3] * inv);
            *(u32x2*)(op + 32 * db + 8 * g4) = w; }
}

template <int DQK, int DK1, int DV, bool MASKED>
__device__ __forceinline__ void sattn_block(LAS unsigned char* lds, const bf16* Q, int qpitch, const bf16* K1, int k1p, const bf16* K2, int k2p, const bf16* Vt, int vp,
                                            const unsigned long long* SEL, bf16* O, int opitch, int tid) {
    constexpr int NDS = DQK / 16, NDS1 = DK1 / 16, NDB = DV / 32, NT = (SKEYS + 63) / 64;
    const int lane = tid & 63, wid = __builtin_amdgcn_readfirstlane(tid >> 6), rho = lane & 31, hi = lane >> 5, qr = rho & 15;
    const int prho = (rho & ~12) | ((rho & 8) >> 1) | ((rho & 4) << 1);
    bf16x8 qf[NDS];
    { const bf16* qp = Q + (size_t)qr * qpitch + 8 * hi;
#pragma unroll
      for (int ds = 0; ds < NDS; ++ds) qf[ds] = *(const bf16x8*)(qp + 16 * ds); }
    const unsigned long long* selp = MASKED ? SEL + (size_t)qr * 64 : nullptr;
    f32x16 o[NDB];
#pragma unroll
    for (int db = 0; db < NDB; ++db)
#pragma unroll
        for (int r = 0; r < 16; ++r) o[db][r] = 0.f;
    float m = -1e30f, l = 0.f;
    for (int t = wid; t < NT; t += 8) {
        unsigned long long sw = 0ull; if (MASKED) sw = selp[t];
#pragma unroll
        for (int kbk = 0; kbk < 2; ++kbk) {
            const int kb0 = 64 * t + 32 * kbk;
            if (kb0 < SKEYS) {
                const int krow = (kb0 + prho < SKEYS) ? kb0 + prho : 0;
                const bf16* k1 = K1 + (size_t)krow * k1p + 8 * hi; const bf16* k2 = (NDS > NDS1) ? K2 + (size_t)krow * k2p + 8 * hi : K1;
                bf16x8 af[NDS];
#pragma unroll
                for (int ds = 0; ds < NDS; ++ds) af[ds] = (ds < NDS1) ? *(const bf16x8*)(k1 + 16 * ds) : *(const bf16x8*)(k2 + 16 * (ds - NDS1));
                bf16x8 vf[2][NDB];
#pragma unroll
                for (int s = 0; s < 2; ++s)
#pragma unroll
                    for (int db = 0; db < NDB; ++db) vf[s][db] = *(const bf16x8*)(Vt + (size_t)(32 * db + rho) * vp + kb0 + ((kb0 + 16 * s < SKEYS) ? 16 * s : 0) + 8 * hi);
                f32x16 s0;
#pragma unroll
                for (int r = 0; r < 16; ++r) s0[r] = 0.f;
#pragma unroll
                for (int ds = 0; ds < NDS; ++ds) s0 = __builtin_amdgcn_mfma_f32_32x32x16_bf16(af[ds], qf[ds], s0, 0, 0, 0);
                const unsigned w0 = MASKED ? ((unsigned)(sw >> (32 * kbk)) >> (8 * hi)) : 0xffffffffu;
#pragma unroll
                for (int r = 0; r < 16; ++r) { const int kl = 16 * (r >> 3) + (r & 7); const bool on = (w0 & (1u << kl)) && (kb0 + kl + 8 * hi < SKEYS); s0[r] = on ? s0[r] : -INFINITY; }
                float mx = s0[0];
#pragma unroll
                for (int r = 1; r < 16; ++r) mx = fmaxf(mx, s0[r]);
                mx = fmaxf(mx, __shfl_xor(mx, 32));
                if (__any(mx > m + ATT_THR)) {
                  const float mn = fmaxf(m, mx), alpha = __builtin_amdgcn_exp2f(m - mn); m = mn; l *= alpha;
#pragma unroll
                  for (int db = 0; db < NDB; ++db)
#pragma unroll
                      for (int r = 0; r < 16; ++r) o[db][r] *= alpha; }
                float ps = 0.f;
#pragma unroll
                for (int r = 0; r < 16; ++r) { s0[r] = __builtin_amdgcn_exp2f(s0[r] - m); ps += s0[r]; }
                l += ps;
#pragma unroll
                for (int s = 0; s < 2; ++s) {
                    if (kb0 + 16 * s < SKEYS) {
                        u32x4 p0;
                        p0.x = cvtpk(s0[8 * s], s0[8 * s + 1]); p0.y = cvtpk(s0[8 * s + 2], s0[8 * s + 3]); p0.z = cvtpk(s0[8 * s + 4], s0[8 * s + 5]); p0.w = cvtpk(s0[8 * s + 6], s0[8 * s + 7]);
                        const bf16x8 pf = __builtin_bit_cast(bf16x8, p0);
#pragma unroll
                        for (int db = 0; db < NDB; ++db) o[db] = __builtin_amdgcn_mfma_f32_32x32x16_bf16(vf[s][db], pf, o[db], 0, 0, 0);
                    }
                }
            }
        }
    }
    LAS float* ML = (LAS float*)lds; LAS float* OS = (LAS float*)(lds + 1024);
    const float lt = l + __shfl_xor(l, 32);
    __syncthreads();
    if (lane < 16) { ML[(wid * 16 + lane) * 2] = m; ML[(wid * 16 + lane) * 2 + 1] = lt; }
    if (rho < 16) {
#pragma unroll
        for (int db = 0; db < NDB; ++db)
#pragma unroll
            for (int r = 0; r < 16; ++r) { const int d = 32 * db + (r & 3) + 8 * (r >> 2) + 4 * hi; OS[(wid * DV + d) * 16 + rho] = o[db][r]; }
    }
    __syncthreads();
    { const int q = tid & 15, d0 = tid >> 4;
      float mw[8], mm = -1e30f;
#pragma unroll
      for (int w = 0; w < 8; ++w) { mw[w] = ML[(w * 16 + q) * 2]; mm = fmaxf(mm, mw[w]); }
      float den = 0.f;
#pragma unroll
      for (int w = 0; w < 8; ++w) { mw[w] = __builtin_amdgcn_exp2f(mw[w] - mm); den += ML[(w * 16 + q) * 2 + 1] * mw[w]; }
      const float inv = 1.0f / den;
#pragma unroll
      for (int j = 0; j < DV / 32; ++j) { const int d = d0 + 32 * j; float num = 0.f;
#pragma unroll
          for (int w = 0; w < 8; ++w) num += OS[(w * DV + d) * 16 + q] * mw[w];
          O[(size_t)q * opitch + d] = (bf16)(cvtpk(num * inv, 0.f) & 0xffffu); } }
    __syncthreads();
}

template <int P> __device__ __forceinline__ void ln_row(const bf16* xin, const bf16* trow, const float* slab  , const float* gate, const float* lng, const float* lnb, bf16* xout, float* yout  , const float* sc, const float* sh, bf16* hrow, int lane) {
    f32x4 y[8]; float s = 0.f;
#pragma unroll
    for (int j = 0; j < 8; ++j) { const int col = 4 * lane + 256 * j; const u32x2 xw = *(const u32x2*)(xin + col); const f32x4 x = (f32x4){bflo(xw.x), bfhi(xw.x), bflo(xw.y), bfhi(xw.y)}, g = *(const f32x4*)(gate + col);
        f32x4 tv;
        if (!slab) { const u32x2 tw = *(const u32x2*)(trow + col); tv = (f32x4){bflo(tw.x), bfhi(tw.x), bflo(tw.y), bfhi(tw.y)}; }
        else { tv = *(const f32x4*)(slab + col);
#pragma unroll
            for (int pp = 1; pp < P; ++pp) tv += *(const f32x4*)(slab + (size_t)pp * 256 * D + col); }
        y[j] = x * ALPHA_RES + (1.f + g) * tv; s += (y[j].x + y[j].y) + (y[j].z + y[j].w); }
    const float mean = wave_sum(s) * (1.f / D); float s2 = 0.f;
#pragma unroll
    for (int j = 0; j < 8; ++j) { y[j] = y[j] - mean; s2 += (y[j].x * y[j].x + y[j].y * y[j].y) + (y[j].z * y[j].z + y[j].w * y[j].w); }
    const float rstd = 1.0f / sqrtf(wave_sum(s2) * (1.f / D) + LN_EPS);
#pragma unroll
    for (int j = 0; j < 8; ++j) { const int col = 4 * lane + 256 * j; const f32x4 g = *(const f32x4*)(lng + col), b = *(const f32x4*)(lnb + col);
        const f32x4 xn = y[j] * rstd * g + b;
        if (yout) *(f32x4*)(yout + col) = xn; else { u32x2 xo; xo.x = cvtpk(xn.x, xn.y); xo.y = cvtpk(xn.z, xn.w); *(u32x2*)(xout + col) = xo; }
        if (sc) { const f32x4 c = *(const f32x4*)(sc + col), h = *(const f32x4*)(sh + col); const f32x4 o = xn * (1.f + c) + h; u32x2 w; w.x = cvtpk(o.x, o.y); w.y = cvtpk(o.z, o.w); *(u32x2*)(hrow + col) = w; } }
}

__device__ __forceinline__ void ln_row2(const bf16* xin0, const bf16* xin1, const bf16* trow0, const bf16* trow1, const float* gate0, const float* gate1, const float* lng, const float* lnb,
                                        bf16* xout0, bf16* xout1, float* yout0, float* yout1, const float* sc0, const float* sc1, const float* sh0, const float* sh1, bf16* hrow0, bf16* hrow1, int lane) {
    f32x4 y0[8], y1[8]; float s0 = 0.f, s1 = 0.f;
#pragma unroll
    for (int j = 0; j < 8; ++j) { const int col = 4 * lane + 256 * j;
        const u32x2 xwa = *(const u32x2*)(xin0 + col), xwb = *(const u32x2*)(xin1 + col); const f32x4 xa = (f32x4){bflo(xwa.x), bfhi(xwa.x), bflo(xwa.y), bfhi(xwa.y)}, xb = (f32x4){bflo(xwb.x), bfhi(xwb.x), bflo(xwb.y), bfhi(xwb.y)};
        const f32x4 ga = *(const f32x4*)(gate0 + col), gb = *(const f32x4*)(gate1 + col);
        const u32x2 ta = *(const u32x2*)(trow0 + col), tb = *(const u32x2*)(trow1 + col);
        y0[j] = xa * ALPHA_RES + (1.f + ga) * (f32x4){bflo(ta.x), bfhi(ta.x), bflo(ta.y), bfhi(ta.y)}; s0 += (y0[j].x + y0[j].y) + (y0[j].z + y0[j].w);
        y1[j] = xb * ALPHA_RES + (1.f + gb) * (f32x4){bflo(tb.x), bfhi(tb.x), bflo(tb.y), bfhi(tb.y)}; s1 += (y1[j].x + y1[j].y) + (y1[j].z + y1[j].w); }
#pragma unroll
    for (int o = 1; o < 64; o <<= 1) { s0 += __shfl_xor(s0, o); s1 += __shfl_xor(s1, o); }
    const float mean0 = s0 * (1.f / D), mean1 = s1 * (1.f / D); float q0 = 0.f, q1 = 0.f;
#pragma unroll
    for (int j = 0; j < 8; ++j) { y0[j] = y0[j] - mean0; q0 += (y0[j].x * y0[j].x + y0[j].y * y0[j].y) + (y0[j].z * y0[j].z + y0[j].w * y0[j].w);
        y1[j] = y1[j] - mean1; q1 += (y1[j].x * y1[j].x + y1[j].y * y1[j].y) + (y1[j].z * y1[j].z + y1[j].w * y1[j].w); }
#pragma unroll
    for (int o = 1; o < 64; o <<= 1) { q0 += __shfl_xor(q0, o); q1 += __shfl_xor(q1, o); }
    const float r0 = 1.0f / sqrtf(q0 * (1.f / D) + LN_EPS), r1 = 1.0f / sqrtf(q1 * (1.f / D) + LN_EPS);
#pragma unroll
    for (int j = 0; j < 8; ++j) { const int col = 4 * lane + 256 * j; const f32x4 g = *(const f32x4*)(lng + col), b = *(const f32x4*)(lnb + col);
        const f32x4 xa = y0[j] * r0 * g + b, xb = y1[j] * r1 * g + b;
        if (yout0) { *(f32x4*)(yout0 + col) = xa; *(f32x4*)(yout1 + col) = xb; }
        else { u32x2 pa, pb; pa.x = cvtpk(xa.x, xa.y); pa.y = cvtpk(xa.z, xa.w); pb.x = cvtpk(xb.x, xb.y); pb.y = cvtpk(xb.z, xb.w); *(u32x2*)(xout0 + col) = pa; *(u32x2*)(xout1 + col) = pb; }
        if (sc0) { const f32x4 ca = *(const f32x4*)(sc0 + col), ha = *(const f32x4*)(sh0 + col), cb = *(const f32x4*)(sc1 + col), hb = *(const f32x4*)(sh1 + col);
            const f32x4 oa = xa * (1.f + ca) + ha, ob = xb * (1.f + cb) + hb; u32x2 wa, wb; wa.x = cvtpk(oa.x, oa.y); wa.y = cvtpk(oa.z, oa.w); wb.x = cvtpk(ob.x, ob.y); wb.y = cvtpk(ob.z, ob.w);
            *(u32x2*)(hrow0 + col) = wa; *(u32x2*)(hrow1 + col) = wb; } }
}

__device__ __forceinline__ void pi_row(const Args& a, int l, int r, int lane, int s_lo, int s_hi) {
    unsigned char* ws = a.ws;
    const bf16* G0 = (const bf16*)(ws + WS_GU) + (size_t)r * NGU;
    const bool smp = r >= MP; int b, t, T;
    if (!smp) { b = r >> 12; t = r & 4095; T = SEQ; } else { const int rs = r - MP; b = rs >> 4; t = rs & 15; T = TS; }
    const float* st = a.in[10] + ((size_t)(l * NBS + b) * 2) * DFF;
    const float* cw = a.in[24] + (size_t)l * 3 * DFF;
    bf16* arow = (bf16*)(ws + WS_ACT) + (size_t)r * DFF;
    float* so = (t >= T - 2) ? a.out + (smp ? O_SCF + ((size_t)(l * NBS + b) * 2 + (t - (T - 2))) * DFF : O_PCF + ((size_t)(l * NBP + b) * 2 + (t - (T - 2))) * DFF) : nullptr;
    const float* SH = (const float*)(ws + WS_SLAB); const int rs = r - MP;
#define PI_LD8(dr, col, dst) do { const int c_ = (col) < DFF ? (col) : (col) - DFF; slab_ld8<SP_H>(SH, NGU, rs + (dr), 256 * (c_ / 128) + c_ % 128 + ((col) < DFF ? 0 : 128), dst); } while (0)
    for (int s = s_lo; s < s_hi; ++s) {
        const int c = 8 * (lane + 64 * s);
        float g0[8], g1[8], g2[8], up[8], w0[8], w1[8], w2[8], z[8];
        PI_LD8(0, c, g0); PI_LD8(0, DFF + c, up);
        if (t >= 1) PI_LD8(-1, c, g1); else if (smp) ld8f(st + DFF + c, g1); else {
#pragma unroll
            for (int i = 0; i < 8; ++i) g1[i] = 0.f; }
        if (t >= 2) PI_LD8(-2, c, g2); else if (smp) ld8f(st + (size_t)t * DFF + c, g2); else {
#pragma unroll
            for (int i = 0; i < 8; ++i) g2[i] = 0.f; }
        ld8f(cw + c, w0); ld8f(cw + DFF + c, w1); ld8f(cw + 2 * DFF + c, w2);
#pragma unroll
        for (int i = 0; i < 8; ++i) { const float gc = g2[i] * w0[i] + g1[i] * w1[i] + g0[i] * w2[i]; z[i] = gc / (1.f + __expf(-gc)) * up[i]; }
        st16(arow + c, pack8(z));
        if (so) st8f_nt(so + c, g0);
    }
#undef PI_LD8
}

__device__ __forceinline__ void pi_block(const Args& a, int l, int item, int lane) {
    unsigned char* ws = a.ws;
    const int rb = item / 11, strip = item - rb * 11, r0 = rb * 16, c = 512 * strip + 8 * lane;
    const int b = r0 >> 12, t0 = r0 & 4095;
    const bf16* G0 = (const bf16*)(ws + WS_GU) + (size_t)r0 * NGU + c;
    bf16* arow = (bf16*)(ws + WS_ACT) + (size_t)r0 * DFF + c;
    float w0[8], w1[8], w2[8], g1[8], g2[8];
    { const float* cw = a.in[24] + (size_t)l * 3 * DFF + c; ld8f(cw, w0); ld8f(cw + DFF, w1); ld8f(cw + 2 * DFF, w2); }
    if (t0 > 0) { unpack8(ld16(G0 - NGU), g1); unpack8(ld16(G0 - 2 * NGU), g2); }
    else {
#pragma unroll
        for (int i = 0; i < 8; ++i) { g1[i] = 0.f; g2[i] = 0.f; } }
#pragma unroll
    for (int hb = 0; hb < 2; ++hb) {
        u32x4 gq[8], uq[8];
#pragma unroll
        for (int i = 0; i < 8; ++i) { gq[i] = ld16(G0 + (size_t)(8 * hb + i) * NGU); uq[i] = ld16(G0 + (size_t)(8 * hb + i) * NGU + DFF); }
#pragma unroll
        for (int i = 0; i < 8; ++i) { float g0[8], up[8], z[8]; unpack8(gq[i], g0); unpack8(uq[i], up);
#pragma unroll
            for (int e = 0; e < 8; ++e) { const float gc = g2[e] * w0[e] + g1[e] * w1[e] + g0[e] * w2[e]; z[e] = gc / (1.f + __expf(-gc)) * up[e]; }
            st16(arow + (size_t)(8 * hb + i) * DFF, pack8(z));
            const int t = t0 + 8 * hb + i;
            if (t >= SEQ - 2) st8f(a.out + O_PCF + ((size_t)(l * NBP + b) * 2 + (t - (SEQ - 2))) * DFF + c, g0);
#pragma unroll
            for (int e = 0; e < 8; ++e) { g2[e] = g1[e]; g1[e] = g0[e]; } }
    }
}

__device__ __forceinline__ void pi_fix(const Args& a, int l, int item, int lane) {
    unsigned char* ws = a.ws; const int pm = item / 11, strip = item - pm * 11, c = 512 * strip + 8 * lane;
    const float* GH = (const float*)(ws + WS_GH); const float* G01 = (const float*)(ws + WS_G01) + (size_t)pm * 4 * DFF + c;
    float w0[8], w1[8], w2[8], ga[8], gb[8], ua[8], ub[8], p14[8], p15[8], z[8];
    { const float* cw = a.in[24] + (size_t)l * 3 * DFF + c; ld8f(cw, w0); ld8f(cw + DFF, w1); ld8f(cw + 2 * DFF, w2); }
    ld8f(G01, ga); ld8f(G01 + DFF, ua); ld8f(G01 + 2 * DFF, gb); ld8f(G01 + 3 * DFF, ub);
    if (pm & 15) { ld8f(GH + ((size_t)(pm - 1) * 2) * DFF + c, p14); ld8f(GH + ((size_t)(pm - 1) * 2 + 1) * DFF + c, p15); }
    else {
#pragma unroll
        for (int i = 0; i < 8; ++i) { p14[i] = 0.f; p15[i] = 0.f; } }
    bf16* arow = (bf16*)(ws + WS_ACT) + (size_t)pm * 256 * DFF + c;
#pragma unroll
    for (int i = 0; i < 8; ++i) { const float gc = p14[i] * w0[i] + p15[i] * w1[i] + ga[i] * w2[i]; z[i] = gc / (1.f + __expf(-gc)) * ua[i]; }
    st16(arow, pack8(z));
#pragma unroll
    for (int i = 0; i < 8; ++i) { const float gc = p15[i] * w0[i] + ga[i] * w1[i] + gb[i] * w2[i]; z[i] = gc / (1.f + __expf(-gc)) * ub[i]; }
    st16(arow + DFF, pack8(z));
    if ((pm & 15) == 15) { const int b = pm >> 4; float* so = a.out + O_PCF + ((size_t)(l * NBP + b) * 2) * DFF + c;
        float g[8]; ld8f(GH + ((size_t)pm * 2) * DFF + c, g); st8f_nt(so, g); ld8f(GH + ((size_t)pm * 2 + 1) * DFF + c, g); st8f_nt(so + DFF, g); }
}


constexpr int LNV_G1 = 0, LNV_LG = 8192, LNV_LB = 16384, LNV_S1 = 24576, LNV_SH = 32768, LNV_RED = 40960;
template <bool HOUT> __device__ __forceinline__ void ln_stage_vectors(LAS unsigned char* lds, const float* gate, const float* lng, const float* lnb, const float* sc, const float* sh, int tid) {
    const int c = 4 * tid, p = (((c >> 9) * 2 + ((c >> 2) & 1)) * 64 + ((c & 511) >> 3)) * 16;
    const f32x4 g = *(const f32x4*)(gate + c), a = *(const f32x4*)(lng + c), b = *(const f32x4*)(lnb + c);
    *(LAS f32x4*)(lds + LNV_G1 + p) = 1.f + g; *(LAS f32x4*)(lds + LNV_LG + p) = a; *(LAS f32x4*)(lds + LNV_LB + p) = b;
    if constexpr (HOUT) { const f32x4 s = *(const f32x4*)(sc + c), h = *(const f32x4*)(sh + c); *(LAS f32x4*)(lds + LNV_S1 + p) = 1.f + s; *(LAS f32x4*)(lds + LNV_SH + p) = h; }
}
__device__ __forceinline__ void lnv_ld8(const LAS unsigned char* lds, int base, int j, int lane, float (&f)[8]) {
    const f32x4 a = *(const LAS f32x4*)(lds + base + ((2 * j) * 64 + lane) * 16), b = *(const LAS f32x4*)(lds + base + ((2 * j + 1) * 64 + lane) * 16);
    f[0] = a.x; f[1] = a.y; f[2] = a.z; f[3] = a.w; f[4] = b.x; f[5] = b.y; f[6] = b.z; f[7] = b.w;
}
#ifdef LNV_GLOBAL
struct LnVec { const float* v[5]; };
__device__ __forceinline__ void lnv_gl8(const float* base, int j, int lane, float (&f)[8]) {
    const __amdgpu_buffer_rsrc_t r = __builtin_amdgcn_make_buffer_rsrc((void*)base, 0, 0x7fffffff, 0x00020000);
    const u32x4 a = __builtin_amdgcn_raw_buffer_load_b128(r, 32 * lane, 2048 * j, 0), b = __builtin_amdgcn_raw_buffer_load_b128(r, 32 * lane, 2048 * j + 16, 0);
    f[0] = __uint_as_float(a.x); f[1] = __uint_as_float(a.y); f[2] = __uint_as_float(a.z); f[3] = __uint_as_float(a.w); f[4] = __uint_as_float(b.x); f[5] = __uint_as_float(b.y); f[6] = __uint_as_float(b.z); f[7] = __uint_as_float(b.w);
}
#define LNV(idx, base, j, ll, dst) do { lnv_gl8(lv.v[idx], j, ll, dst); if ((idx) == 0 || (idx) == 3) { _Pragma("unroll") for (int e_ = 0; e_ < 8; ++e_) dst[e_] += 1.f; } } while (0)
#define LNV_PARAM , const LnVec lv
#else
#define LNV(idx, base, j, ll, dst) lnv_ld8(lds, base, j, ll, dst)
#define LNV_PARAM
#endif
template <bool YOUT, bool HOUT>
__device__ __forceinline__ void ln_rows8(const LAS unsigned char* lds, const bf16* Xi, const bf16* Ti, bf16* Xo, float* Yo, bf16* Ho, size_t row0, int lane LNV_PARAM) {
    const __amdgpu_buffer_rsrc_t rx = __builtin_amdgcn_make_buffer_rsrc((void*)(Xi + row0 * D), 0, 0x7fffffff, 0x00020000), rt = __builtin_amdgcn_make_buffer_rsrc((void*)(Ti + row0 * D), 0, 0x7fffffff, 0x00020000);
    const __amdgpu_buffer_rsrc_t ro = __builtin_amdgcn_make_buffer_rsrc(YOUT ? (void*)(Yo + row0 * D) : (void*)(Xo + row0 * D), 0, 0x7fffffff, 0x00020000);
    const __amdgpu_buffer_rsrc_t rh = __builtin_amdgcn_make_buffer_rsrc(HOUT ? (void*)(Ho + row0 * D) : (void*)(Ti + row0 * D), 0, 0x7fffffff, 0x00020000);
    const int vo = 16 * lane;
#ifdef LN_GLOBAL
#define LN_LDX(o) ld16((const char*)(Xi + row0 * D) + vo + (o))
#define LN_LDT(o) ld16((const char*)(Ti + row0 * D) + vo + (o))
#define LN_STX(v, o) st16((char*)(Xo + row0 * D) + vo + (o), v)
#define LN_STH(v, o) st16((char*)(Ho + row0 * D) + vo + (o), v)
#else
#define LN_LDX(o) __builtin_amdgcn_raw_buffer_load_b128(rx, vo + ((o) & 4095), (o) & ~4095, 0)
#define LN_LDT(o) __builtin_amdgcn_raw_buffer_load_b128(rt, vo + ((o) & 4095), (o) & ~4095, 0)
#define LN_STX(v, o) __builtin_amdgcn_raw_buffer_store_b128(v, ro, vrow + ((o) & 4095), 0, 0)
#define LN_STH(v, o) __builtin_amdgcn_raw_buffer_store_b128(v, rh, vrow + ((o) & 4095), 0, 0)
#endif
    u32x4 xr[2][4], tr[2][4];
#pragma unroll
    for (int rr = 0; rr < 2; ++rr)
#pragma unroll
        for (int j = 0; j < 4; ++j) { xr[rr][j] = LN_LDX((rr * D + 512 * j) * 2); tr[rr][j] = LN_LDT((rr * D + 512 * j) * 2); }
#pragma unroll
    for (int p = 0; p < 4; ++p) {
        float y[2][32]; float s[2] = {0.f, 0.f};
        int ll = lane; asm volatile("" : "+v"(ll));
#pragma unroll
        for (int j = 0; j < 4; ++j) { float g[8]; LNV(0, LNV_G1, j, ll, g);
#pragma unroll
            for (int rr = 0; rr < 2; ++rr) { float xf[8], tf[8]; unpack8(xr[rr][j], xf); unpack8(tr[rr][j], tf);
#pragma unroll
                for (int e = 0; e < 8; ++e) { const float v = xf[e] * ALPHA_RES + g[e] * tf[e]; y[rr][8 * j + e] = v; s[rr] += v; } } }
        __builtin_amdgcn_sched_barrier(0);
        if (p < 3) {
#pragma unroll
            for (int rr = 0; rr < 2; ++rr)
#pragma unroll
                for (int j = 0; j < 4; ++j) { xr[rr][j] = LN_LDX(((2 * (p + 1) + rr) * D + 512 * j) * 2); tr[rr][j] = LN_LDT(((2 * (p + 1) + rr) * D + 512 * j) * 2); }
        }
        __builtin_amdgcn_sched_barrier(0);
#pragma unroll
        for (int o = 1; o < 64; o <<= 1) { s[0] += __shfl_xor(s[0], o); s[1] += __shfl_xor(s[1], o); }
        const float m0 = s[0] * (1.f / D), m1 = s[1] * (1.f / D); float q0 = 0.f, q1 = 0.f;
#pragma unroll
        for (int e = 0; e < 32; ++e) { y[0][e] -= m0; q0 += y[0][e] * y[0][e]; y[1][e] -= m1; q1 += y[1][e] * y[1][e]; }
#pragma unroll
        for (int o = 1; o < 64; o <<= 1) { q0 += __shfl_xor(q0, o); q1 += __shfl_xor(q1, o); }
        const float r[2] = {1.0f / sqrtf(q0 * (1.f / D) + LN_EPS), 1.0f / sqrtf(q1 * (1.f / D) + LN_EPS)};
#pragma unroll
        for (int j = 0; j < 4; ++j) { float lg[8], lb[8], s1[8], sh[8]; LNV(1, LNV_LG, j, ll, lg); LNV(2, LNV_LB, j, ll, lb);
            if constexpr (HOUT) { LNV(3, LNV_S1, j, ll, s1); LNV(4, LNV_SH, j, ll, sh); }
#pragma unroll
            for (int rr = 0; rr < 2; ++rr) { const int off = (2 * p + rr) * D + 512 * j; float xn[8]; const int vrow = vo + (2 * p + rr) * D * 2, vrow4 = 2 * vo + (2 * p + rr) * D * 4; (void)vrow; (void)vrow4;
#pragma unroll
                for (int e = 0; e < 8; ++e) xn[e] = y[rr][8 * j + e] * r[rr] * lg[e] + lb[e];
                if constexpr (YOUT) { __builtin_amdgcn_raw_buffer_store_b128((u32x4){__float_as_uint(xn[0]), __float_as_uint(xn[1]), __float_as_uint(xn[2]), __float_as_uint(xn[3])}, ro, vrow4 + 2048 * j, 0, 0);
                                      __builtin_amdgcn_raw_buffer_store_b128((u32x4){__float_as_uint(xn[4]), __float_as_uint(xn[5]), __float_as_uint(xn[6]), __float_as_uint(xn[7])}, ro, vrow4 + 2048 * j + 16, 0, 0); }
                else LN_STX(pack8(xn), off * 2);
                if constexpr (HOUT) { float h[8];
#pragma unroll
                    for (int e = 0; e < 8; ++e) h[e] = xn[e] * s1[e] + sh[e];
                    LN_STH(pack8(h), off * 2); } } }
    }
#undef LN_LDX
#undef LN_LDT
#undef LN_STX
#undef LN_STH
}
template <int P, bool YOUT, bool HOUT>
__device__ __forceinline__ void ln_sample_coop(LAS unsigned char* lds, const bf16* xin, const float* slab, const float* gate, const float* lng, const float* lnb, bf16* xout, float* yout, const float* sc, const float* sh, bf16* hrow, int tid) {
    const int col = 4 * tid, lane = tid & 63, w = tid >> 6; LAS float* red = (LAS float*)(lds + LNV_RED);
    const u32x2 xw = *(const u32x2*)(xin + col); const f32x4 g = *(const f32x4*)(gate + col);
    f32x4 tv = *(const f32x4*)(slab + col);
#pragma unroll
    for (int pp = 1; pp < P; ++pp) tv += *(const f32x4*)(slab + (size_t)pp * 256 * D + col);
    const f32x4 a = *(const f32x4*)(lng + col), b = *(const f32x4*)(lnb + col);
    f32x4 y = (f32x4){bflo(xw.x), bfhi(xw.x), bflo(xw.y), bfhi(xw.y)} * ALPHA_RES + (1.f + g) * tv;
    const float s = wave_sum((y.x + y.y) + (y.z + y.w));
    if (lane == 0) red[w] = s;
    __syncthreads();
    float m = 0.f;
#pragma unroll
    for (int i = 0; i < 8; ++i) m += red[i];
    y = y - m * (1.f / D);
    const float q = wave_sum((y.x * y.x + y.y * y.y) + (y.z * y.z + y.w * y.w));
    if (lane == 0) red[8 + w] = q;
    __syncthreads();
    float v = 0.f;
#pragma unroll
    for (int i = 0; i < 8; ++i) v += red[8 + i];
    const float rstd = 1.0f / sqrtf(v * (1.f / D) + LN_EPS);
    const f32x4 xn = y * rstd * a + b;
    if constexpr (YOUT) *(f32x4*)(yout + col) = xn; else { u32x2 xo; xo.x = cvtpk(xn.x, xn.y); xo.y = cvtpk(xn.z, xn.w); *(u32x2*)(xout + col) = xo; }
    if constexpr (HOUT) { const f32x4 c = *(const f32x4*)(sc + col), h = *(const f32x4*)(sh + col); const f32x4 o = xn * (1.f + c) + h; u32x2 wv; wv.x = cvtpk(o.x, o.y); wv.y = cvtpk(o.z, o.w); *(u32x2*)(hrow + col) = wv; }
}

constexpr int N_PHASES = 2 + 10 * NL;
#ifndef MK_PHMASK
#define MK_PHMASK 0xFFFFu
#endif
#define EN(k) (((MK_PHMASK) >> (k)) & 1u)
#ifndef MK_REP
#define MK_REP 0u
#endif
#define REP(k) for (int rep_ = 0; rep_ < 1 + (int)(((MK_REP) >> (k)) & 1u); ++rep_)
__global__ void __launch_bounds__(512, 2) mk_fwd(Args args) {
    extern __shared__ __attribute__((aligned(16))) unsigned char lds_raw[];
    LAS unsigned char* lds = (LAS unsigned char*)lds_raw;
    const int tid = threadIdx.x, lane = tid & 63, wave = __builtin_amdgcn_readfirstlane(tid >> 6);
    const int G = gridDim.x, bx = blockIdx.x; const int vcu = (G % 8 == 0) ? (bx % 8) * (G / 8) + bx / 8 : bx;
    const int gw = vcu * 8 + wave, NGW = G * 8;
    for (int u = tid; u < (LDS_BYTES - LDS_CTL) / 4; u += 512) ((LAS unsigned*)(lds + LDS_CTL))[u] = 0u;
    __syncthreads();
#if !MK_MULTI
    XcdBarrier bar = xcd_barrier_post((unsigned*)(args.ws + WS_CTL) + CW_BAR, (volatile LAS unsigned*)(lds + LDS_MISC) + 8);
#define GRID_BAR() do { xcd_barrier(bar, wave); if ((MK_REP >> 19) & 1u) xcd_barrier(bar, wave); } while (0)
#else
#define GRID_BAR() do { } while (0)
#endif
    const int lo = args.ph_lo, hi = args.ph_hi;
#define IN(k) (lo <= (k) && (k) < hi)
#define SEAM(k) do { if (IN(k) && IN((k) + 1)) GRID_BAR(); } while (0)
#define GEMM_PHASE(Ap, Bp, Mv, Nv, Kv, Op, ldcv) do { pg8::Gemm g_{(const bf16*)(Ap), (const bf16*)(Bp), (Mv), (Nv), (Kv), (Kv)}; pg8::StaticOrder S_; S_.init((Mv), (Nv), G, bx); \
        pg8::EpiStoreBf16 E_{(bf16*)(Op), (ldcv)}; pg8::gemm_phase<pg8::EpiStoreBf16, pg8::StaticOrder, true, true>(lds, g_, S_, E_, wave); } while (0)
#define FRESH() const int lane_p = fresh_lane(); const int tid_p = wave * 64 + lane_p; (void)lane_p
#define GEMM_RESID(Ap, Bp, Kv, gatep) do { pg8::Gemm g_{(const bf16*)(Ap), (const bf16*)(Bp), MP, D, (Kv), (Kv)}; pg8::StaticOrder S_; S_.init(MP, D, G, bx); \
        pg8::EpiResid E_{(bf16*)(ws + WS_X), D, (gatep), NMOD, ALPHA_RES}; pg8::gemm_phase<pg8::EpiResid, pg8::StaticOrder, true, true>(lds, g_, S_, E_, wave); } while (0)
#define GEMM_SPLIT(Ap, Bp, Nv, Klen, ldv, Pv) for (int rs_ = 0; rs_ < 1 + (int)((MK_REP >> 18) & 1u); ++rs_) { pg8::Gemm g_{(const bf16*)(Ap), (const bf16*)(Bp), 256, (Nv), (Klen), (ldv)}; pg8::SplitOrder S_; S_.init((Pv), (Nv), G, bx); \
        pg8::EpiSlabF32 E_{(float*)(ws + WS_SLAB), (Nv)}; pg8::gemm_phase<pg8::EpiSlabF32, pg8::SplitOrder, true, true, true>(lds, g_, S_, E_, wave); }
    unsigned char* ws = args.ws;
    const float* MOD = (const float*)(ws + WS_MOD);
    float* Y = args.out + O_Y; bf16* X = (bf16*)(ws + WS_X);

    if (EN(0) && IN(0)) REP(0) p0a_prologue(args, lds, tid, lane, wave, vcu, G);
    SEAM(0);
    if (EN(1) && IN(1)) p0b_h0(args, lane, gw, NGW);
    SEAM(1);
    for (int l = 0; l < NL; ++l) {
        const int pb = 2 + 10 * l;
        unsigned char* wl = ws + WS_W + (size_t)l * W_LAYER;
        if (EN(2) && IN(pb)) { { { pg8::Gemm g_{(const bf16*)(ws + WS_H), (const bf16*)(wl + WO_IN), MP, NINP, D, D}; pg8::StaticOrder S_; S_.init(MP, NINP, G, bx);
              pg8::EpiProj E_{(bf16*)(ws + WS_PROJ), NINP, (bf16*)(ws + WS_QA), (bf16*)(ws + WS_QI), (bf16*)(ws + WS_QC), (bf16*)(ws + WS_KA), (bf16*)(ws + WS_KI), (bf16*)(ws + WS_KR), (float*)(ws + WS_WI),
                                 (const float*)(ws + WS_ROPE), QS_A, QS_C, WI_SCALE,
                                 args.out + O_PAK + (size_t)l * MP * 512, args.out + O_PAV + (size_t)l * MP * 512, args.out + O_PIK + (size_t)l * MP * 64, args.out + O_PKR + (size_t)l * MP * 64};
              pg8::gemm_phase<pg8::EpiProj, pg8::StaticOrder, true, true>(lds, g_, S_, E_, wave); }
            GEMM_SPLIT(ws + WS_H + (size_t)MP * D * 2, wl + WO_IN, NINP, D / SP_A, D, SP_A); }
            { FRESH(); unsigned* tk = (unsigned*)(ws + WS_CTL) + CW_TICKET + 64 * l;
              for (;;) { unsigned j = 0u; if (lane_p == 0) j = __hip_atomic_fetch_add(tk, 1u, __ATOMIC_RELAXED, __HIP_MEMORY_SCOPE_AGENT); j = (unsigned)__builtin_amdgcn_readfirstlane((int)j);
                  if (j >= 4096u) break;
                  if (j < 2048u) { for (int i = 0; i < 8; ++i) pb_cache_row(args, l, (int)j * 8 + i, lane_p); } else pb_vat_cache(args, l, (int)j - 2048, lane_p); } } }
        SEAM(pb);
        if (EN(3) && IN(pb + 1)) REP(3) { FRESH();
            for (int blk = vcu; blk < MP / 64; blk += G) pb_prompt_rows8(args, l, blk * 64 + 8 * wave, lane_p);
            for (int i = gw; i < MS * 9; i += NGW) pb_token_row(args, l, MP + i / 9, lane_p, 1u << (i % 9));
            for (int jv = gw; jv < (MP / 64) * 8; jv += NGW) pb_vat_prompt(args, jv, lane_p);
            for (int jv = gw; jv < NBS * 8; jv += NGW) pb_vat_new(args, jv, lane_p);
        }
        SEAM(pb + 1);
        if (IN(pb + 2)) {
            if (EN(4)) REP(4) { { pg8::Gemm g_{(const bf16*)(ws + WS_LAT), (const bf16*)(wl + WO_UK), KROWS, 1024, 512, 512}; pg8::StaticOrder S_; S_.init(KROWS, 1024, G, (bx + G - 8) % G);
              pg8::EpiStoreBf16 E_{(bf16*)(ws + WS_KN), 1024}; pg8::gemm_phase<pg8::EpiStoreBf16, pg8::StaticOrder, true, true>(lds, g_, S_, E_, wave); }
            { pg8::Gemm g_{(const bf16*)(wl + WO_UV), (const bf16*)(ws + WS_LAT), 1024, KROWS, 512, 512}; pg8::StaticOrder S_; S_.init(1024, KROWS, G, (bx + G / 2 - 8) % G);
              pg8::EpiStoreBf16 E_{(bf16*)(ws + WS_VCT), KROWS}; pg8::gemm_phase<pg8::EpiStoreBf16, pg8::StaticOrder, true, true>(lds, g_, S_, E_, wave); } }
            if (EN(5)) REP(5) { FRESH();
            for (int i = vcu; i < 2048 + 256; i += G) { int q0;
                if (i < 2048) { const int b = i >> 9, r = i & 511, j = (r < 256) ? r : 767 - r; q0 = b * SEQ + 8 * j; }
                else { if ((i - 2048) & 7) continue; q0 = MP + 8 * ((i - 2048) >> 3); }
                pd_group256(args, lds, q0, tid_p); } }
        }
        SEAM(pb + 2);
        if (IN(pb + 3)) { FRESH();
            const bf16* QC = (const bf16*)(ws + WS_QC); const bf16* KN = (const bf16*)(ws + WS_KN); const bf16* KR = (const bf16*)(ws + WS_KR); const bf16* VCT = (const bf16*)(ws + WS_VCT);
            const bf16* QA = (const bf16*)(ws + WS_QA); const bf16* KA = (const bf16*)(ws + WS_KA); const bf16* VAT = (const bf16*)(ws + WS_VAT);
            const unsigned long long* SEL = (const unsigned long long*)(ws + WS_SEL); bf16* MIX = (bf16*)(ws + WS_MIX);
            if (EN(6)) REP(6) { FRESH(); for (int u = vcu; u < 256; u += G) { const int bh = u >> 3, s = u & 7, b = bh >> 3, h = bh & 7;
                for (int k = 0; k < 2; ++k) { const int qb = k ? 15 - s : s; const size_t row0 = (size_t)b * SEQ + 256 * qb;
                    attn_unit<192, 128, 128, false>(lds, QC + row0 * 1536 + h * 192, 1536, KN + (size_t)b * SEQ * 1024 + h * 128, 1024, KR + (size_t)b * SEQ * 64, 64,
                                                    VCT + (size_t)(h * 128) * KROWS + (size_t)b * SEQ, KROWS, nullptr, MIX + row0 * D + 1024 + h * 128, D, qb, tid_p); } } }
            if (EN(7)) REP(7) { FRESH(); for (int u = vcu; u < 256; u += G) { const int bh = u >> 3, s = u & 7, b = bh >> 3, h = bh & 7;
                for (int k = 0; k < 2; ++k) { const int qb = k ? 15 - s : s; const size_t row0 = (size_t)b * SEQ + 256 * qb;
                    attn_unit_deep<64, 64, 64, true>(lds, QA + row0 * 512 + h * 64, 512, KA + (size_t)b * SEQ * 512 + h * 64, 512, nullptr, 0,
                                                VAT + (size_t)(h * 64) * KROWS + (size_t)b * SEQ, KROWS, SEL + row0 * 64, MIX + row0 * D + h * 64, D, qb, tid_p); } } }
            if (EN(8)) REP(8) { FRESH(); for (int u = vcu; u < 2 * NBS * 8; u += G) { const int b = (u >> 3) & 15, h = u & 7; const size_t r0 = (size_t)MP + b * TS, kr0 = (size_t)MP + (size_t)b * SKEYS;
                if (u < NBS * 8) sattn_block<192, 128, 128, false>(lds, QC + r0 * 1536 + h * 192, 1536, KN + kr0 * 1024 + h * 128, 1024, KR + kr0 * 64, 64, VCT + (size_t)(h * 128) * KROWS + kr0, KROWS, nullptr, MIX + r0 * D + 1024 + h * 128, D, tid_p);
                else sattn_block<64, 64, 64, true>(lds, QA + r0 * 512 + h * 64, 512, KA + kr0 * 512 + h * 64, 512, nullptr, 0, VAT + (size_t)(h * 64) * KROWS + kr0, KROWS, SEL + r0 * 64, MIX + r0 * D + h * 64, D, tid_p); } }
        }
        SEAM(pb + 3);
        if (EN(9) && IN(pb + 4)) REP(9) { GEMM_PHASE(ws + WS_MIX, wl + WO_OUT, MP, D, D, ws + WS_T, D); GEMM_SPLIT(ws + WS_MIX + (size_t)MP * D * 2, wl + WO_OUT, D, D / SP_F, D, SP_F); }
        SEAM(pb + 4);
        if (EN(10) && IN(pb + 5)) REP(10) { FRESH();
            const bool dry = ((MK_REP >> 10) & 1u) && rep_ == 0;
            const bf16* Tb = (const bf16*)(ws + WS_T); bf16* Hb = dry ? (bf16*)(ws + WS_PROJ + 70 * MiB) : (bf16*)(ws + WS_H); bf16* Xo = dry ? (bf16*)(ws + WS_PROJ) : X;
            const float* lng = args.in[19] + (size_t)l * D; const float* lnb = args.in[20] + (size_t)l * D;
            for (int rs = vcu; rs < MS; rs += G) { const int r = MP + rs; const float* mod = MOD + ((size_t)l * NCOND + cond_idx(r)) * NMOD;
                if (rs != vcu) __syncthreads();
                ln_sample_coop<SP_F, false, true>(lds, X + (size_t)r * D, (const float*)(ws + WS_SLAB) + (size_t)rs * D, mod + 2 * D, lng, lnb, Xo + (size_t)r * D, nullptr, mod + 4 * D, mod + 3 * D, Hb + (size_t)r * D, tid_p); }
            for (int blk = vcu; blk < MP / 64; blk += G) { const int r0 = blk * 64; const float* mod = MOD + ((size_t)l * NCOND + cond_idx(r0)) * NMOD;
                __syncthreads(); ln_stage_vectors<true>(lds, mod + 2 * D, lng, lnb, mod + 4 * D, mod + 3 * D, tid_p); __syncthreads();
                ln_rows8<false, true>(lds, X, Tb, Xo, nullptr, Hb, (size_t)r0 + 8 * wave, lane_p); }
        }
        SEAM(pb + 5);
        if (EN(11) && IN(pb + 6)) REP(11) {
            { pg8::Gemm g_{(const bf16*)(ws + WS_H), (const bf16*)(wl + WO_GU), MP, NGU, D, D}; pg8::StaticOrder S_; S_.init(MP, NGU, G, bx);
              pg8::EpiAct E_{(bf16*)(ws + WS_ACT), DFF, (float*)(ws + WS_GH), (float*)(ws + WS_G01), args.in[24] + (size_t)l * 3 * DFF, (PG8_LAS float*)(lds + LDS_HALO)};
              pg8::gemm_phase<pg8::EpiAct, pg8::StaticOrder, true, true>(lds, g_, S_, E_, wave); }
            GEMM_SPLIT(ws + WS_H + (size_t)MP * D * 2, wl + WO_GU, NGU, D / SP_H, D, SP_H); }
        SEAM(pb + 6);
        if (EN(12) && IN(pb + 7)) REP(12) { FRESH(); for (int it = gw; it < (MP / 256) * 11; it += NGW) pi_fix(args, l, it, lane_p); for (int i = NGW - 1 - gw; i < MS * 11; i += NGW) pi_row(args, l, MP + i / 11, lane_p, i % 11, i % 11 + 1); }
        SEAM(pb + 7);
        if (EN(13) && IN(pb + 8)) REP(13) { GEMM_PHASE(ws + WS_ACT, wl + WO_DN, MP, D, DFF, ws + WS_T, D); GEMM_SPLIT(ws + WS_ACT + (size_t)MP * DFF * 2, wl + WO_DN, D, DFF / SP_J, DFF, SP_J); }
        SEAM(pb + 8);
        if (EN(14) && IN(pb + 9)) { FRESH();
            const bf16* Tb = (const bf16*)(ws + WS_T); bf16* Hb = (bf16*)(ws + WS_H); const bool more = l + 1 < NL;
            const float* lng = args.in[21] + (size_t)l * D; const float* lnb = args.in[22] + (size_t)l * D;
            for (int rs = vcu; rs < MS; rs += G) { const int r = MP + rs, m = cond_idx(r); const float* mod = MOD + ((size_t)l * NCOND + m) * NMOD; const float* modn = MOD + ((size_t)(more ? l + 1 : l) * NCOND + m) * NMOD;
                if (rs != vcu) __syncthreads();
                const float* sl = (const float*)(ws + WS_SLAB) + (size_t)rs * D;
                if (more) ln_sample_coop<SP_J, false, true>(lds, X + (size_t)r * D, sl, mod + 5 * D, lng, lnb, X + (size_t)r * D, nullptr, modn + D, modn, Hb + (size_t)r * D, tid_p);
                else ln_sample_coop<SP_J, true, false>(lds, X + (size_t)r * D, sl, mod + 5 * D, lng, lnb, nullptr, Y + (size_t)r * D, nullptr, nullptr, nullptr, tid_p); }
            for (int blk = vcu; blk < MP / 64; blk += G) { const int r0 = blk * 64, m = cond_idx(r0); const float* mod = MOD + ((size_t)l * NCOND + m) * NMOD; const float* modn = MOD + ((size_t)(more ? l + 1 : l) * NCOND + m) * NMOD;
                __syncthreads();
                if (more) { ln_stage_vectors<true>(lds, mod + 5 * D, lng, lnb, modn + D, modn, tid_p); __syncthreads(); ln_rows8<false, true>(lds, X, Tb, X, nullptr, Hb, (size_t)r0 + 8 * wave, lane_p); }
                else { ln_stage_vectors<false>(lds, mod + 5 * D, lng, lnb, nullptr, nullptr, tid_p); __syncthreads(); ln_rows8<true, false>(lds, X, Tb, nullptr, Y, nullptr, (size_t)r0 + 8 * wave, lane_p); } }
        }
        SEAM(pb + 9);
    }
#undef IN
#undef SEAM
#undef GEMM_PHASE
#undef GEMM_SPLIT
#undef GRID_BAR
}

extern "C" void kernel_launch(void* const* d_in, const int* in_sizes, int n_in, void* d_out, int out_size, void* d_ws, size_t ws_size, hipStream_t stream) {
    static int grid = 0;
    if (grid == 0) {
        if (n_in != 26 || (size_t)out_size != O_END || ws_size < WS_END || in_sizes[0] != MP * D || in_sizes[11] != NL * D * NIN) {
            fprintf(stderr, "kernel_launch: unexpected shapes (n_in %d, out %d, ws %zu); nothing launched\n", n_in, out_size, ws_size); grid = -1; return; }
        int dev = 0, cus = 0, per_cu = 0;
        if (hipGetDevice(&dev) != hipSuccess || hipDeviceGetAttribute(&cus, hipDeviceAttributeMultiprocessorCount, dev) != hipSuccess) { grid = -1; return; }
        if (hipFuncSetAttribute((const void*)mk_fwd, hipFuncAttributeMaxDynamicSharedMemorySize, LDS_BYTES) != hipSuccess) { fprintf(stderr, "kernel_launch: hipFuncSetAttribute failed\n"); grid = -1; return; }
        if (hipOccupancyMaxActiveBlocksPerMultiprocessor(&per_cu, (const void*)mk_fwd, 512, LDS_BYTES) != hipSuccess || per_cu < 1) fprintf(stderr, "kernel_launch: occupancy query reports %d\n", per_cu);
        (void)hipGetLastError();
        grid = cus;
    }
    if (grid < 0) return;
    if (hipMemsetAsync((char*)d_ws + WS_CTL, 0, CTL_ZERO_BYTES, stream) != hipSuccess) { fprintf(stderr, "kernel_launch: memset failed\n"); return; }
    Args a{};
    for (int i = 0; i < 26; ++i) a.in[i] = (const float*)d_in[i];
    a.out = (float*)d_out; a.ws = (unsigned char*)d_ws;
#if !MK_MULTI
    a.ph_lo = 0; a.ph_hi = N_PHASES;
    hipLaunchKernelGGL(mk_fwd, dim3(grid), dim3(512), LDS_BYTES, stream, a);
#else
    for (int p = 0; p < N_PHASES; ++p) { a.ph_lo = p; a.ph_hi = p + 1; hipLaunchKernelGGL(mk_fwd, dim3(grid), dim3(512), LDS_BYTES, stream, a); }
#endif
    const hipError_t le = hipPeekAtLastError();
    if (le != hipSuccess) fprintf(stderr, "kernel_launch: launch failed: %s\n", hipGetErrorName(le));
}
```
